# Optimizing an MI355X kernel written in HIP

```python
import jax, jax.numpy as jnp
from jax import lax
import numpy as np


D_MODEL = 1024
BATCH = 4
SEQ = 4096
DEPTH = 4

CTX_LEN = 256
GRID_W = 64
N_Q_HEADS = 8
N_KV_HEADS = 2
HEAD_DIM = 64
WINDOW = 128
ATT_BLOCK = 128
ROPE_BASE = 10000.0
ATT_Q = N_Q_HEADS * HEAD_DIM
ATT_KV = N_KV_HEADS * HEAD_DIM
CONV_DIM = 512
CONV_WIDTH = 31
M_HEADS = 4
M_HEAD_DIM = 128
M_WIDTH = M_HEADS * M_HEAD_DIM
M_CHUNK = 64
M_SHORT_CONV = 3
N_GATE_COLS = 4 * M_HEADS
N_BRANCHES = 3
D_FF = -(-8 * D_MODEL // (3 * 256)) * 256

SPLIT_SIZES = (ATT_Q, ATT_KV, ATT_KV, 2 * CONV_DIM, 2 * M_WIDTH, M_WIDTH, M_WIDTH, N_GATE_COLS, N_BRANCHES * D_MODEL)
SPLIT_POINTS = tuple(sum(SPLIT_SIZES[:i + 1]) for i in range(len(SPLIT_SIZES) - 1))
D_IN = sum(SPLIT_SIZES)

EPS = 1e-6
NEG_INF = -1e30

kernel_name = 'hybrid_gated_swa_conformer_mlstm_dit'


def rms_norm(x, g):
    xf = x.astype(jnp.float32)
    y = xf * lax.rsqrt(jnp.mean(xf * xf, axis=-1, keepdims=True) + EPS)
    return (y * g.astype(jnp.float32)).astype(x.dtype)


def layer_norm(x, g, b):
    xf = x.astype(jnp.float32)
    mu = jnp.mean(xf, axis=-1, keepdims=True)
    var = jnp.mean(jnp.square(xf - mu), axis=-1, keepdims=True)
    y = (xf - mu) * lax.rsqrt(var + EPS)
    return (y * g.astype(jnp.float32) + b.astype(jnp.float32)).astype(x.dtype)


def modulate(h, shift, scale):
    return h * (1.0 + scale) + shift


def to_heads(a, n):
    B, T, _ = a.shape
    return a.reshape(B, T, n, -1).transpose(0, 2, 1, 3)


def from_heads(a):
    B, n, T, d = a.shape
    return a.transpose(0, 2, 1, 3).reshape(B, T, n * d)


def rope_tables(n_tokens):
    rows = n_tokens // GRID_W
    row = jnp.repeat(jnp.arange(rows, dtype=jnp.float32), GRID_W)
    col = jnp.tile(jnp.arange(GRID_W, dtype=jnp.float32), rows)
    n_freq = HEAD_DIM // 4
    inv_freq = ROPE_BASE ** (-jnp.arange(n_freq, dtype=jnp.float32) / n_freq)
    ang_r = row[:, None] * inv_freq
    ang_c = col[:, None] * inv_freq
    ang = jnp.concatenate([ang_r, ang_r, ang_c, ang_c], axis=-1)
    return jnp.cos(ang), jnp.sin(ang)


def rotate_half(h):
    a, b = jnp.split(h, 2, axis=-1)
    return jnp.concatenate([-b, a], axis=-1)


def apply_rope(x, cos, sin):
    half = HEAD_DIM // 2
    xr = jnp.concatenate([rotate_half(x[..., :half]), rotate_half(x[..., half:])], axis=-1)
    return x * cos.astype(x.dtype) + xr * sin.astype(x.dtype)


def depthwise_conv(x, w):
    pad = w.shape[0] // 2
    return lax.conv_general_dilated(
        x, w[:, None, :].astype(x.dtype), window_strides=(1,), padding=[(pad, pad)],
        dimension_numbers=('NWC', 'WIO', 'NWC'), feature_group_count=x.shape[-1])


def window_attention(q, k, v, k_ctx, v_ctx, sink):
    B, _, S, d = q.shape
    nb = S // ATT_BLOCK
    G = N_Q_HEADS // N_KV_HEADS
    qb = (q * d ** -0.5).reshape(B, N_KV_HEADS, G, nb, ATT_BLOCK, d)

    def band(a):
        ap = jnp.pad(a, ((0, 0), (0, 0), (ATT_BLOCK, ATT_BLOCK), (0, 0))).reshape(B, N_KV_HEADS, nb + 2, ATT_BLOCK, d)
        return jnp.concatenate([ap[:, :, :-2], ap[:, :, 1:-1], ap[:, :, 2:]], axis=3)

    kb, vb = band(k), band(v)
    s_loc = jnp.einsum('bhgnqd,bhnkd->bhgnqk', qb, kb).astype(jnp.float32)
    s_ctx = jnp.einsum('bhgnqd,bhkd->bhgnqk', qb, k_ctx).astype(jnp.float32)
    blk = jnp.arange(nb)[:, None, None]
    q_pos = blk * ATT_BLOCK + jnp.arange(ATT_BLOCK)[None, :, None]
    key_pos = (blk - 1) * ATT_BLOCK + jnp.arange(3 * ATT_BLOCK)[None, None, :]
    valid = (jnp.abs(key_pos - q_pos) <= WINDOW) & (key_pos >= 0) & (key_pos < S)
    s_loc = jnp.where(valid, s_loc, NEG_INF)
    sk = jnp.broadcast_to(sink.astype(jnp.float32).reshape(1, N_KV_HEADS, G, 1, 1, 1), s_loc.shape[:-1] + (1,))
    p = jax.nn.softmax(jnp.concatenate([s_loc, s_ctx, sk], axis=-1), axis=-1).astype(v.dtype)
    n_loc = 3 * ATT_BLOCK
    n_ctx = k_ctx.shape[2]
    o = (jnp.einsum('bhgnqk,bhnkd->bhgnqd', p[..., :n_loc], vb)
         + jnp.einsum('bhgnqk,bhkd->bhgnqd', p[..., n_loc:n_loc + n_ctx], v_ctx))
    return o.reshape(B, N_Q_HEADS, S, d)


def context_attention(q, k, v, sink):
    B, _, L, d = q.shape
    G = N_Q_HEADS // N_KV_HEADS
    qg = (q * d ** -0.5).reshape(B, N_KV_HEADS, G, L, d)
    s = jnp.einsum('bhgqd,bhkd->bhgqk', qg, k).astype(jnp.float32)
    sk = jnp.broadcast_to(sink.astype(jnp.float32).reshape(1, N_KV_HEADS, G, 1, 1), s.shape[:-1] + (1,))
    p = jax.nn.softmax(jnp.concatenate([s, sk], axis=-1), axis=-1)[..., :L].astype(v.dtype)
    o = jnp.einsum('bhgqk,bhkd->bhgqd', p, v)
    return o.reshape(B, N_Q_HEADS, L, d)


def conformer_conv(u, w_dw, b_dw, g_ln, b_ln, w_pw):
    val, gate = jnp.split(u, 2, axis=-1)
    y = depthwise_conv(val * jax.nn.sigmoid(gate), w_dw) + b_dw
    y = jax.nn.silu(layer_norm(y, g_ln, b_ln))
    return y @ w_pw


def mlstm_chunkwise(q, k, v, log_i, log_f, state):
    B, H, T, dk = q.shape
    dv = v.shape[-1]
    L = M_CHUNK
    nc = T // L

    def chunks(a):
        return jnp.moveaxis(a.reshape(a.shape[:2] + (nc, L) + a.shape[3:]), 2, 0)

    tril = jnp.tril(jnp.ones((L, L), dtype=bool))

    def step(carry, xs):
        C, n, m = carry
        qc, kc, vc, ic, fc = xs
        b = jnp.cumsum(fc, axis=-1)
        a = b + m[..., None]
        dmat = jnp.where(tril, b[..., :, None] - b[..., None, :] + ic[..., None, :], NEG_INF)
        mt = jnp.maximum(a, dmat.max(axis=-1))
        w_inter = jnp.exp(a - mt)
        s = jnp.einsum('bhtd,bhsd->bhts', qc, kc) * jnp.exp(dmat - mt[..., None])
        num = w_inter[..., None] * jnp.einsum('bhtd,bhde->bhte', qc, C) + jnp.einsum('bhts,bhse->bhte', s, vc)
        den = w_inter * jnp.einsum('bhtd,bhd->bht', qc, n) + s.sum(axis=-1)
        h = num / jnp.maximum(jnp.abs(den), jnp.exp(-mt))[..., None]
        b_end = b[..., -1]
        g = b_end[..., None] - b + ic
        m_new = jnp.maximum(b_end + m, g.max(axis=-1))
        decay = jnp.exp(b_end + m - m_new)
        wk = jnp.exp(g - m_new[..., None])
        C_new = decay[..., None, None] * C + jnp.einsum('bhs,bhsd,bhse->bhde', wk, kc, vc)
        n_new = decay[..., None] * n + jnp.einsum('bhs,bhsd->bhd', wk, kc)
        return (C_new, n_new, m_new), h

    state, h = lax.scan(step, state, (chunks(q), chunks(k), chunks(v), chunks(log_i), chunks(log_f)))
    h = jnp.moveaxis(h, 0, 2).reshape(B, H, T, dv)
    return h, state


def mlstm_branch(qk, v, o, gates, qk_c, v_c, o_c, gates_c, b_mgate, w_mconv, g_mnorm, w_mout, with_ctx_out):
    def prep(qk, v, gates):
        q, k = jnp.split(jax.nn.silu(depthwise_conv(qk, w_mconv)), 2, axis=-1)
        q = to_heads(q, M_HEADS).astype(jnp.float32)
        k = to_heads(k, M_HEADS).astype(jnp.float32) * M_HEAD_DIM ** -0.5
        v = to_heads(v, M_HEADS).astype(jnp.float32)
        g = jnp.moveaxis((gates + b_mgate).astype(jnp.float32), -1, 1)
        i_fw, i_bw, f_fw, f_bw = jnp.split(g, 4, axis=1)
        fwd = (q, k, v, i_fw, jax.nn.log_sigmoid(f_fw))
        bwd = tuple(jnp.flip(a, axis=2) for a in (q, k, v, i_bw, jax.nn.log_sigmoid(f_bw)))
        return fwd, bwd

    lat_f, lat_b = prep(qk, v, gates)
    ctx_f, ctx_b = prep(qk_c, v_c, gates_c)
    B = qk.shape[0]
    init = (jnp.zeros((B, M_HEADS, M_HEAD_DIM, M_HEAD_DIM), jnp.float32),
            jnp.zeros((B, M_HEADS, M_HEAD_DIM), jnp.float32),
            jnp.full((B, M_HEADS), NEG_INF, jnp.float32))
    hc_f, st_f = mlstm_chunkwise(*ctx_f, init)
    hc_b, st_b = mlstm_chunkwise(*ctx_b, init)
    hl_f, _ = mlstm_chunkwise(*lat_f, st_f)
    hl_b, _ = mlstm_chunkwise(*lat_b, st_b)

    def readout(h_f, h_b_rev, o):
        h = jax.nn.sigmoid(to_heads(o, M_HEADS).astype(jnp.float32)) * (h_f + jnp.flip(h_b_rev, axis=2))
        mu = jnp.mean(h, axis=-1, keepdims=True)
        var = jnp.mean(jnp.square(h - mu), axis=-1, keepdims=True)
        h = from_heads((h - mu) * lax.rsqrt(var + EPS)) * g_mnorm.astype(jnp.float32)
        return h.astype(o.dtype) @ w_mout

    y = readout(hl_f, hl_b, o)
    y_ctx = readout(hc_f, hc_b, o_c) if with_ctx_out else None
    return y, y_ctx


def gated_merge(gate_logits, ya, yb, yc):
    ga, gb, gc = jnp.split(jax.nn.sigmoid(gate_logits), N_BRANCHES, axis=-1)
    return ga * ya + gb * yb + gc * yc


def hybrid_mixer(h, hc, w_in, b_mgate, sink, w_att_out, w_dw, b_dw, g_cln, b_cln, w_pw,
                 w_mconv, g_mnorm, w_mout, w_out, cos, sin, with_ctx_out):
    qa, ka, va, glu, qk_m, v_m, o_m, gate_m, br = jnp.split(h @ w_in, SPLIT_POINTS, axis=-1)
    qac, kac, vac, gluc, qk_mc, v_mc, o_mc, gate_mc, brc = jnp.split(hc @ w_in, SPLIT_POINTS, axis=-1)
    k_ctx = to_heads(kac, N_KV_HEADS)
    v_ctx = to_heads(vac, N_KV_HEADS)
    q = apply_rope(to_heads(qa, N_Q_HEADS), cos, sin)
    k = apply_rope(to_heads(ka, N_KV_HEADS), cos, sin)
    ya = from_heads(window_attention(q, k, to_heads(va, N_KV_HEADS), k_ctx, v_ctx, sink)) @ w_att_out
    yb = conformer_conv(glu, w_dw, b_dw, g_cln, b_cln, w_pw)
    yc, yc_ctx = mlstm_branch(qk_m, v_m, o_m, gate_m, qk_mc, v_mc, o_mc, gate_mc,
                              b_mgate, w_mconv, g_mnorm, w_mout, with_ctx_out)
    y = gated_merge(br, ya, yb, yc) @ w_out
    if not with_ctx_out:
        return y, None
    ya_c = from_heads(context_attention(to_heads(qac, N_Q_HEADS), k_ctx, v_ctx, sink)) @ w_att_out
    yb_c = conformer_conv(gluc, w_dw, b_dw, g_cln, b_cln, w_pw)
    y_ctx = gated_merge(brc, ya_c, yb_c, yc_ctx) @ w_out
    return y, y_ctx


def swiglu(h, w_gate, w_up, w_down):
    return (jax.nn.silu(h @ w_gate) * (h @ w_up)) @ w_down


def setup_inputs(seed: int = 0) -> dict:
    key = jax.random.key(seed)
    ks = jax.random.split(key, 27)
    f32 = jnp.float32

    def nrm(k, shape):
        return jax.random.normal(k, shape, f32)

    def w(k, shape, fan_in):
        return nrm(k, shape) * fan_in ** -0.5

    def gain(k, shape):
        return 1.0 + 0.05 * nrm(k, shape)

    def small(k, shape):
        return 0.02 * nrm(k, shape)

    b_mgate = jnp.concatenate([0.1 * nrm(ks[9], (DEPTH, 2 * M_HEADS)),
                               3.0 + 0.5 * nrm(ks[25], (DEPTH, 2 * M_HEADS))], axis=-1)
    return {
        'x': nrm(ks[0], (BATCH, SEQ, D_MODEL)),
        'c': nrm(ks[1], (BATCH, D_MODEL)),
        'ctx': nrm(ks[2], (BATCH, CTX_LEN, D_MODEL)),
        'c_ctx': nrm(ks[3], (D_MODEL,)),
        'w_ada': 0.5 * w(ks[4], (DEPTH, D_MODEL, 6 * D_MODEL), D_MODEL),
        'b_ada': small(ks[5], (DEPTH, 6 * D_MODEL)),
        'g_norm_mix': gain(ks[6], (DEPTH, D_MODEL)),
        'g_norm_ffn': gain(ks[7], (DEPTH, D_MODEL)),
        'w_in': w(ks[8], (DEPTH, D_MODEL, D_IN), D_MODEL),
        'b_mgate': b_mgate,
        'att_sink': 0.5 * nrm(ks[10], (DEPTH, N_Q_HEADS)),
        'w_att_out': w(ks[11], (DEPTH, ATT_Q, D_MODEL), ATT_Q),
        'w_conv_dw': w(ks[12], (DEPTH, CONV_WIDTH, CONV_DIM), CONV_WIDTH),
        'b_conv_dw': small(ks[13], (DEPTH, CONV_DIM)),
        'g_conv_ln': gain(ks[14], (DEPTH, CONV_DIM)),
        'b_conv_ln': small(ks[15], (DEPTH, CONV_DIM)),
        'w_conv_pw': w(ks[16], (DEPTH, CONV_DIM, D_MODEL), CONV_DIM),
        'w_mconv': w(ks[17], (DEPTH, M_SHORT_CONV, 2 * M_WIDTH), M_SHORT_CONV),
        'g_mlstm_norm': gain(ks[18], (DEPTH, M_WIDTH)),
        'w_mlstm_out': w(ks[19], (DEPTH, M_WIDTH, D_MODEL), M_WIDTH),
        'w_out': w(ks[20], (DEPTH, D_MODEL, D_MODEL), D_MODEL),
        'w_ff_gate': w(ks[21], (DEPTH, D_MODEL, D_FF), D_MODEL),
        'w_ff_up': w(ks[22], (DEPTH, D_MODEL, D_FF), D_MODEL),
        'w_ff_down': w(ks[23], (DEPTH, D_FF, D_MODEL), D_FF),
        'g_final': gain(ks[24], (D_MODEL,)),
    }


def reference(x, c, ctx, c_ctx, w_ada, b_ada, g_norm_mix, g_norm_ffn, w_in, b_mgate, att_sink,
              w_att_out, w_conv_dw, b_conv_dw, g_conv_ln, b_conv_ln, w_conv_pw, w_mconv,
              g_mlstm_norm, w_mlstm_out, w_out, w_ff_gate, w_ff_up, w_ff_down, g_final):
    cos, sin = rope_tables(x.shape[1])
    for l in range(DEPTH):
        with_ctx_out = l < DEPTH - 1
        mod = jax.nn.silu(c) @ w_ada[l] + b_ada[l]
        sh1, sc1, gt1, sh2, sc2, gt2 = jnp.split(mod[:, None, :], 6, axis=-1)
        mod_c = jax.nn.silu(c_ctx) @ w_ada[l] + b_ada[l]
        csh1, csc1, cgt1, csh2, csc2, cgt2 = jnp.split(mod_c, 6, axis=-1)
        h = modulate(rms_norm(x, g_norm_mix[l]), sh1, sc1)
        hc = modulate(rms_norm(ctx, g_norm_mix[l]), csh1, csc1)
        y, y_ctx = hybrid_mixer(h, hc, w_in[l], b_mgate[l], att_sink[l], w_att_out[l],
                                w_conv_dw[l], b_conv_dw[l], g_conv_ln[l], b_conv_ln[l], w_conv_pw[l],
                                w_mconv[l], g_mlstm_norm[l], w_mlstm_out[l], w_out[l],
                                cos, sin, with_ctx_out)
        x = x + gt1 * y
        x = x + gt2 * swiglu(modulate(rms_norm(x, g_norm_ffn[l]), sh2, sc2), w_ff_gate[l], w_ff_up[l], w_ff_down[l])
        if with_ctx_out:
            ctx = ctx + cgt1 * y_ctx
            ctx = ctx + cgt2 * swiglu(modulate(rms_norm(ctx, g_norm_ffn[l]), csh2, csc2), w_ff_gate[l], w_ff_up[l], w_ff_down[l])
    return rms_norm(x, g_final)
```

```cpp
#include <hip/hip_runtime.h>
#include <hip/hip_cooperative_groups.h>
#include <cstdio>
#include <cstdint>
namespace cg = cooperative_groups;
namespace pg8 {
#define PG8_LAS __attribute__((address_space(3)))
typedef unsigned short bf16_t;
typedef short bf16x8 __attribute__((ext_vector_type(8)));
typedef float f32x4 __attribute__((ext_vector_type(4)));
typedef unsigned u32x4 __attribute__((ext_vector_type(4)));
constexpr int BM = 256, BK = 64, HALF = 128, HTB = HALF * BK * 2  , STAGE_BYTES = 8 * HTB, NXCD = 8, WGM = 8;

__host__ __device__ __forceinline__ int lds_byte(int r, int c) { const int st = (r >> 4) * 2 + (c >> 5), rr = r & 15, cc = c & 31, ob = rr * 64 + cc * 2; return st * 1024 + (ob ^ (((ob >> 9) & 1) << 5)); }
__host__ __device__ __forceinline__ void stage_rc(int b, int& R, int& C) { const int st = b / 1024, sb = b % 1024, swz = sb ^ (((sb >> 9) & 1) << 5); R = (st >> 1) * 16 + swz / 64; C = (st & 1) * 32 + (swz % 64) / 2; }
__host__ __device__ __forceinline__ int perm32(int rho) { const int n = rho >> 4, i = rho & 15; return 8 * (i >> 2) + 4 * n + (i & 3); }

struct Unit { int pm, pn, z; };
struct Gemm { const bf16_t* A; const bf16_t* Bt; int M, N, K, lda, ldb, mode; };
__device__ __forceinline__ size_t op_aoff(const Gemm& g, const Unit& u, size_t tstepA) { size_t o = (size_t)u.pm * tstepA; if (g.mode == 1) o += (size_t)(u.pn >> 2) * 1024; else if (g.mode == 2) o += (size_t)u.z * 1024; else if (g.mode == 3) o += (size_t)(u.pn >> 2) * 512; return o; }
__device__ __forceinline__ size_t op_boff(const Gemm& g, const Unit& u, size_t tstepB) { if (g.mode == 2) return (size_t)(u.z * 4 + u.pn) * tstepB; if (g.mode == 3) return (size_t)(u.pn & 3) * tstepB + (size_t)(u.pn >> 2) * 512; return (size_t)u.pn * tstepB; }

struct StaticOrder {
    int nM, nN, nwg, G, c;
    __host__ __device__ void init(int M, int N, int G_, int c_) { nM = M / BM; nN = N / BM; nwg = nM * nN; G = G_; c = c_; }
    __host__ __device__ bool next(int i, Unit& u) const {
        const long L = (long)i * G + c; if (L >= nwg) return false;
        int wgid = (int)L; { const int q = nwg / NXCD, r = nwg % NXCD, xcd = wgid % NXCD, off = wgid / NXCD; wgid = (xcd < r ? xcd * (q + 1) : r * (q + 1) + (xcd - r) * q) + off; }
        const int nig = WGM * nN, gid = wgid / nig, fm = gid * WGM, gsz = (nM - fm) < WGM ? (nM - fm) : WGM;
        u.pm = fm + ((wgid % nig) % gsz); u.pn = (wgid % nig) / gsz; u.z = 0; return true;
    }
    __device__ __forceinline__ void a_ready(const Unit&) const {}
    __device__ __forceinline__ void done(const Unit&) const {}
};

struct Merge3Order { StaticOrder base;
    __device__ void init(int M, int N, int G_, int c_) { base.init(M, N, G_, c_); }
    __device__ bool next(int i, Unit& u) const { const int r = i / 3; if (!base.next(r, u)) return false; u.z = i - 3 * r; return true; }
    __device__ __forceinline__ void a_ready(const Unit&) const {}
    __device__ __forceinline__ void done(const Unit&) const {}
};
__device__ __forceinline__ unsigned cvt_pk_bf16(float lo, float hi) { unsigned r; asm volatile("v_cvt_pk_bf16_f32 %0, %1, %2" : "=v"(r) : "v"(lo), "v"(hi)); return r; }
typedef float f32x2 __attribute__((ext_vector_type(2)));
template <class Epi, class Sched, bool ALIGN_EPI = false, bool SP2 = false>
__device__ __forceinline__ void gemm_phase(PG8_LAS unsigned char* lds, const Gemm g, const Sched& S, const Epi& E) {
    int tid = threadIdx.x; asm volatile("" : "+v"(tid));
    const int wid = __builtin_amdgcn_readfirstlane(tid >> 6), lane = tid & 63, wr = wid >> 2, wc = wid & 3, fr = lane & 15, fq = lane >> 4;
    const int K = g.K, nt = K / BK;
    unsigned voffA[2], voffB[2];
#pragma unroll
    for (int i = 0; i < 2; ++i) { int R, C; stage_rc(tid * 16 + i * 8192, R, C); const int Rb = Epi::PERM ? ((R & ~31) + perm32(R & 31)) : R;
        voffA[i] = (unsigned)(R * g.lda + C) * 2u; voffB[i] = (unsigned)(Rb * g.ldb + C) * 2u; }
    const size_t kstep = (size_t)(BK * 2);
    const size_t hstepA = (size_t)HALF * g.lda * 2, hstepB = (size_t)HALF * g.ldb * 2;
    const size_t tstepA = 2 * hstepA, tstepB = 2 * hstepB;
    const unsigned ldsw = (unsigned)wid * 1024u;
    const int aoff = lds_byte(wr * 64 + fr, fq * 8), boff = lds_byte(wc * 32 + fr, fq * 8);
#define PG8_SA(b, h) (((b) * 2 + (h)) * HTB)
#define PG8_SB(b, h) ((4 + (b) * 2 + (h)) * HTB)
#define PG8_STAGE(bufoff, gbase, voff) do { _Pragma("unroll") for (int _i = 0; _i < 2; ++_i) \
        __builtin_amdgcn_global_load_lds((const unsigned*)((const char*)(gbase) + (voff)[_i]), (PG8_LAS unsigned*)(lds + (bufoff) + ldsw + _i * 8192), 16, 0, 0); } while (0)
#define PG8_LDA(dst, b, h) do { _Pragma("unroll") for (int m = 0; m < 4; ++m) _Pragma("unroll") for (int k = 0; k < 2; ++k) dst[m][k] = *(const PG8_LAS bf16x8*)(lds + PG8_SA(b, h) + aoff + m * 2048 + k * 1024); } while (0)
#define PG8_LDB(dst, b, h) do { _Pragma("unroll") for (int n = 0; n < 2; ++n) _Pragma("unroll") for (int k = 0; k < 2; ++k) dst[n][k] = *(const PG8_LAS bf16x8*)(lds + PG8_SB(b, h) + boff + n * 2048 + k * 1024); } while (0)
#define PG8_MMA(ai, bj, At, Bt) do { __builtin_amdgcn_s_setprio(1); _Pragma("unroll") for (int m = 0; m < 4; ++m) _Pragma("unroll") for (int n = 0; n < 2; ++n) _Pragma("unroll") for (int k = 0; k < 2; ++k) \
        acc[ai][bj][m][n] = __builtin_amdgcn_mfma_f32_16x16x32_bf16(Bt[n][k], At[m][k], acc[ai][bj][m][n], 0, 0, 0); __builtin_amdgcn_s_setprio(0); } while (0)
#define PG8_WAIT_V(n) asm volatile("s_waitcnt vmcnt(" #n ")" ::: "memory")
#define PG8_WAIT_L(n) asm volatile("s_waitcnt lgkmcnt(" #n ")" ::: "memory")
#define PG8_BAR __builtin_amdgcn_s_barrier()
#define PG8_SCHED __builtin_amdgcn_sched_barrier(0)
    Unit cur, nxt; int ui = 0;
    if (!S.next(0, cur)) return;
    f32x4 acc[2][2][4][2];
#pragma unroll
    for (int a = 0; a < 2; ++a)
#pragma unroll
        for (int b = 0; b < 2; ++b)
#pragma unroll
            for (int m = 0; m < 4; ++m)
#pragma unroll
                for (int n = 0; n < 2; ++n) { float z0, z1, z2, z3; asm volatile("v_mov_b32 %0, 0\n\tv_mov_b32 %1, 0\n\tv_mov_b32 %2, 0\n\tv_mov_b32 %3, 0" : "=v"(z0), "=v"(z1), "=v"(z2), "=v"(z3)); acc[a][b][m][n] = (f32x4){z0, z1, z2, z3}; }
    bf16x8 At[4][2], B0[2][2], B1[2][2];
    const char* cA = (const char*)g.A + op_aoff(g, cur, tstepA); const char* cB = (const char*)g.Bt + op_boff(g, cur, tstepB);
    S.a_ready(cur);
    if constexpr (SP2) {
        PG8_STAGE(PG8_SB(0, 0), cB, voffB); PG8_STAGE(PG8_SB(0, 1), cB + hstepB, voffB); PG8_STAGE(PG8_SA(0, 0), cA, voffA); PG8_STAGE(PG8_SA(0, 1), cA + hstepA, voffA);
        if (wr == 1) PG8_BAR;
        PG8_WAIT_V(2); PG8_BAR;
        PG8_STAGE(PG8_SB(1, 0), cB + kstep, voffB); PG8_STAGE(PG8_SA(1, 0), cA + kstep, voffA); PG8_STAGE(PG8_SB(1, 1), cB + hstepB + kstep, voffB);
        PG8_WAIT_V(6); PG8_BAR;
    } else {
        PG8_STAGE(PG8_SB(0, 0), cB, voffB); PG8_STAGE(PG8_SA(0, 0), cA, voffA); PG8_STAGE(PG8_SB(0, 1), cB + hstepB, voffB); PG8_STAGE(PG8_SA(0, 1), cA + hstepA, voffA);
        if (wr == 1) PG8_BAR;
        PG8_WAIT_V(4); PG8_BAR;
        PG8_STAGE(PG8_SB(1, 0), cB + kstep, voffB); PG8_STAGE(PG8_SA(1, 0), cA + kstep, voffA); PG8_STAGE(PG8_SB(1, 1), cB + hstepB + kstep, voffB);
        PG8_WAIT_V(6); PG8_BAR;
    }
    for (;;) {
        const bool has_next = S.next(ui + 1, nxt);
        const char* nA = has_next ? (const char*)g.A + op_aoff(g, nxt, tstepA) : cA; const char* nB = has_next ? (const char*)g.Bt + op_boff(g, nxt, tstepB) : cB;
        for (int t = 0; t < nt; t += 2) {
            const bool last = (t == nt - 2);
            const char* a1 = cA + (size_t)(t + 1) * kstep;
            const char* a2 = last ? nA : cA + (size_t)(t + 2) * kstep; const char* b2 = last ? nB : cB + (size_t)(t + 2) * kstep;
            const char* a3 = a2 + kstep; const char* b3 = b2 + kstep;
            if (last && has_next) S.a_ready(nxt);
            if constexpr (SP2) {
            PG8_LDB(B0, 0, 0); PG8_LDB(B1, 0, 1); PG8_SCHED; PG8_LDA(At, 0, 0); PG8_STAGE(PG8_SA(1, 1), a1 + hstepA, voffA);
            PG8_WAIT_V(8); PG8_WAIT_L(0); PG8_BAR; PG8_MMA(0, 0, At, B0); PG8_MMA(0, 1, At, B1); PG8_BAR; PG8_SCHED;
            PG8_LDA(At, 0, 1); PG8_STAGE(PG8_SB(0, 0), b2, voffB); PG8_STAGE(PG8_SB(0, 1), b2 + hstepB, voffB); PG8_STAGE(PG8_SA(0, 0), a2, voffA);
            PG8_WAIT_V(8); PG8_WAIT_L(0); PG8_BAR; PG8_MMA(1, 0, At, B0); PG8_MMA(1, 1, At, B1); PG8_BAR; PG8_SCHED;
            PG8_LDB(B0, 1, 0); PG8_LDB(B1, 1, 1); PG8_SCHED; PG8_LDA(At, 1, 0); PG8_STAGE(PG8_SA(0, 1), a2 + hstepA, voffA);
            PG8_WAIT_V(8); PG8_WAIT_L(0); PG8_BAR; PG8_MMA(0, 0, At, B0); PG8_MMA(0, 1, At, B1); PG8_BAR; PG8_SCHED;
            PG8_LDA(At, 1, 1); PG8_STAGE(PG8_SB(1, 0), b3, voffB); PG8_STAGE(PG8_SB(1, 1), b3 + hstepB, voffB); PG8_STAGE(PG8_SA(1, 0), a3, voffA);
            PG8_WAIT_V(8); PG8_WAIT_L(0); PG8_BAR; PG8_MMA(1, 0, At, B0); PG8_MMA(1, 1, At, B1); PG8_BAR; PG8_SCHED;
            } else {
            PG8_LDB(B0, 0, 0); PG8_SCHED; PG8_LDA(At, 0, 0); PG8_STAGE(PG8_SA(1, 1), a1 + hstepA, voffA);
            PG8_WAIT_L(8); PG8_BAR; PG8_WAIT_L(0); PG8_MMA(0, 0, At, B0); PG8_BAR; PG8_SCHED;
            PG8_LDB(B1, 0, 1); PG8_STAGE(PG8_SB(0, 0), b2, voffB);
            PG8_BAR; PG8_WAIT_L(0); PG8_MMA(0, 1, At, B1); PG8_BAR;
            PG8_LDA(At, 0, 1); PG8_STAGE(PG8_SA(0, 0), a2, voffA);
            PG8_BAR; PG8_WAIT_L(0); PG8_MMA(1, 0, At, B0); PG8_BAR; PG8_SCHED;
            PG8_STAGE(PG8_SB(0, 1), b2 + hstepB, voffB);
            PG8_WAIT_V(6); PG8_BAR; PG8_MMA(1, 1, At, B1); PG8_BAR;
            PG8_LDB(B0, 1, 0); PG8_SCHED; PG8_LDA(At, 1, 0); PG8_STAGE(PG8_SA(0, 1), a2 + hstepA, voffA);
            PG8_WAIT_L(8); PG8_BAR; PG8_WAIT_L(0); PG8_MMA(0, 0, At, B0); PG8_BAR; PG8_SCHED;
            PG8_LDB(B1, 1, 1); PG8_STAGE(PG8_SB(1, 0), b3, voffB);
            PG8_BAR; PG8_WAIT_L(0); PG8_MMA(0, 1, At, B1); PG8_BAR;
            PG8_LDA(At, 1, 1); PG8_STAGE(PG8_SA(1, 0), a3, voffA);
            PG8_BAR; PG8_WAIT_L(0); PG8_MMA(1, 0, At, B0); PG8_BAR; PG8_SCHED;
            PG8_STAGE(PG8_SB(1, 1), b3 + hstepB, voffB);
            PG8_WAIT_V(6); PG8_BAR; PG8_MMA(1, 1, At, B1); PG8_BAR;
            }
        }
        if constexpr (ALIGN_EPI) { if (wr == 0) PG8_BAR; }
        if constexpr (!Epi::AFTER_DRAIN) { E(acc, cur, wr, wc, fr, fq); S.done(cur); }
        if (!has_next) break;
#pragma unroll
        for (int a = 0; a < 2; ++a)
#pragma unroll
        for (int b = 0; b < 2; ++b)
#pragma unroll
            for (int m = 0; m < 4; ++m)
#pragma unroll
                for (int n = 0; n < 2; ++n) { float z0, z1, z2, z3; asm volatile("v_mov_b32 %0, 0\n\tv_mov_b32 %1, 0\n\tv_mov_b32 %2, 0\n\tv_mov_b32 %3, 0" : "=v"(z0), "=v"(z1), "=v"(z2), "=v"(z3)); acc[a][b][m][n] = (f32x4){z0, z1, z2, z3}; }
        cur = nxt; cA = nA; cB = nB; ++ui;
        if constexpr (ALIGN_EPI) { if (wr == 1) PG8_BAR; }
    }
    PG8_WAIT_V(0);
    if constexpr (!ALIGN_EPI) { if (wr == 0) PG8_BAR; }
    PG8_BAR;
    if constexpr (Epi::AFTER_DRAIN) { E.fused(acc, cur, wr, wc, fr, fq, lds, wid, lane); S.done(cur); }
#undef PG8_SA
#undef PG8_SB
#undef PG8_STAGE
#undef PG8_LDA
#undef PG8_LDB
#undef PG8_MMA
#undef PG8_WAIT_V
#undef PG8_WAIT_L
#undef PG8_BAR
#undef PG8_SCHED
}
}

#define LAS __attribute__((address_space(3)))
typedef unsigned short bf16;
typedef unsigned char uchar;
typedef short bf16x8 __attribute__((ext_vector_type(8)));
typedef float f32x4 __attribute__((ext_vector_type(4)));
typedef unsigned v4u __attribute__((ext_vector_type(4)));
typedef unsigned v2u __attribute__((ext_vector_type(2)));

constexpr int DM = 1024, NBATCH = 4, SEQ = 4096, DEPTH = 4, CTXL = 256;
constexpr int ML = NBATCH * SEQ, MC = NBATCH * CTXL, MT = ML + MC;
constexpr int LP = 4096, NG = 3072, DFF = 2816, NIN = 6928, NINP = 7168, LBO = 1536;
constexpr int C_Q = 0, C_K = 512, C_V = 640, C_GLU = 768, C_QKM = 1792, C_VM = 2816, C_OM = 3328, C_GM = 3840;
constexpr int NCHUNK = 68;
constexpr float EPS = 1e-6f;
constexpr size_t MiB = 1u << 20;
constexpr size_t WS_MOD = 0, WS_ROPE = 512 * 1024, WS_BEND = 1 * MiB, WS_MU = WS_BEND + 16384, WS_MS = WS_MU + 16384, WS_NS = 2 * MiB;
constexpr size_t WS_XC = 4 * MiB, WS_WIN = 8 * MiB, WS_WP = 22 * MiB, WS_WO3 = 25 * MiB, WS_WGU = 31 * MiB, WS_WD = 42 * MiB;
constexpr size_t WS_BO = 48 * MiB, WS_P1 = 99 * MiB, WS_G = 235 * MiB, WS_ST = 337 * MiB, WS_END = 405 * MiB;
constexpr size_t WS_DBG = 768 * 1024, WS_BAR = 3 * MiB + 512 * 1024, BAR_BYTES = 16384;
constexpr int MISC_OFF = 155136;
constexpr int LDS_BYTES = 155648;
constexpr int NPHASE = 2 + 10 * DEPTH;

struct Params { const float* in[25]; float* out; uchar* ws; int ph_lo, ph_hi; };
enum { I_X = 0, I_C, I_CTX, I_CCTX, I_WADA, I_BADA, I_GMIX, I_GFFN, I_WIN, I_BMG, I_SINK, I_WATT, I_WDW, I_BDW, I_GCLN, I_BCLN, I_WPW, I_WMCONV, I_GMN, I_WMOUT, I_WOUT, I_WFG, I_WFU, I_WFD, I_GFIN };

__device__ __forceinline__ float bf2f(unsigned h) { return __uint_as_float(h << 16); }
typedef __bf16 bf16x2_t __attribute__((ext_vector_type(2)));
typedef float f32x2_t __attribute__((ext_vector_type(2)));
__device__ __forceinline__ unsigned pk2(float lo, float hi) { f32x2_t v = {lo, hi}; bf16x2_t b = __builtin_convertvector(v, bf16x2_t); return __builtin_bit_cast(unsigned, b); }
__device__ __forceinline__ float sigmoidf_(float x) { return __builtin_amdgcn_rcpf(1.0f + __expf(-x)); }
__device__ __forceinline__ float siluf_(float x) { return x * __builtin_amdgcn_rcpf(1.0f + __expf(-x)); }
__device__ __forceinline__ float logsigf_(float x) { return fminf(x, 0.f) - __logf(1.0f + __expf(-fabsf(x))); }
__device__ __forceinline__ int olane() { int l = __builtin_amdgcn_mbcnt_hi(-1, __builtin_amdgcn_mbcnt_lo(-1, 0)); asm volatile("" : "+v"(l)); return l; }
__device__ __forceinline__ float shi(float v, int src) { return __builtin_bit_cast(float, __builtin_amdgcn_ds_bpermute(src << 2, __builtin_bit_cast(int, v))); }
__device__ __forceinline__ float shx(float v, int o) { return shi(v, olane() ^ o); }
__device__ __forceinline__ float wave_sum(float v) {
    const int l = olane();
#pragma unroll
    for (int o = 1; o < 64; o <<= 1) v += shi(v, l ^ o);
    return v;
}
#define DPPF(v, ctrl) __builtin_bit_cast(float, __builtin_amdgcn_update_dpp(0, __builtin_bit_cast(int, (v)), (ctrl), 0xf, 0xf, false))
__device__ __forceinline__ void wave_sum8(float (&v)[8]) {
#pragma unroll
    for (int t = 0; t < 8; ++t) { v[t] += DPPF(v[t], 0x128); v[t] += DPPF(v[t], 0x124); v[t] += DPPF(v[t], 0x122); v[t] += DPPF(v[t], 0x121); }
    const int l = olane();
#pragma unroll
    for (int t = 0; t < 8; ++t) v[t] += shi(v[t], l ^ 16);
#pragma unroll
    for (int t = 0; t < 8; ++t) v[t] += shi(v[t], l ^ 32);
}
__device__ __forceinline__ float wave_max(float v) {
    const int l = olane();
#pragma unroll
    for (int o = 1; o < 64; o <<= 1) v = fmaxf(v, shi(v, l ^ o));
    return v;
}
__device__ __forceinline__ float scan_add(float v, int lane) {
#pragma unroll
    for (int o = 1; o < 64; o <<= 1) { const float t = shi(v, lane >= o ? lane - o : lane); if (lane >= o) v += t; }
    return v;
}
__device__ __forceinline__ float scan_max(float v, int lane) {
#pragma unroll
    for (int o = 1; o < 64; o <<= 1) { const float t = shi(v, lane >= o ? lane - o : lane); if (lane >= o) v = fmaxf(v, t); }
    return v;
}
__device__ __forceinline__ void unpack8(v4u w, float (&f)[8]) {
    f[0] = bf2f(w.x & 0xffffu); f[1] = bf2f(w.x >> 16); f[2] = bf2f(w.y & 0xffffu); f[3] = bf2f(w.y >> 16);
    f[4] = bf2f(w.z & 0xffffu); f[5] = bf2f(w.z >> 16); f[6] = bf2f(w.w & 0xffffu); f[7] = bf2f(w.w >> 16);
}
__device__ __forceinline__ v4u pack8(const float (&f)[8]) { v4u w; w.x = pk2(f[0], f[1]); w.y = pk2(f[2], f[3]); w.z = pk2(f[4], f[5]); w.w = pk2(f[6], f[7]); return w; }
#define LDS_FENCE() asm volatile("s_waitcnt lgkmcnt(0)" ::: "memory")
#define MFMA16(a, b, c) __builtin_amdgcn_mfma_f32_16x16x32_bf16((a), (b), (c), 0, 0, 0)
#define DBGF(cond, code) do { if (cond) atomicMin((int*)(c.ws + WS_DBG), (code)); } while (0)

__device__ __forceinline__ int otid() { int t = threadIdx.x; asm volatile("" : "+v"(t)); return t; }
#define TLW const int tid_ = otid(), lane_ = tid_ & 63, wave_ = __builtin_amdgcn_readfirstlane(tid_ >> 6); (void)lane_; (void)wave_
__device__ __forceinline__ f32x4 zero4() { float z0, z1, z2, z3; asm volatile("v_mov_b32 %0, 0\n\tv_mov_b32 %1, 0\n\tv_mov_b32 %2, 0\n\tv_mov_b32 %3, 0" : "=v"(z0), "=v"(z1), "=v"(z2), "=v"(z3)); return (f32x4){z0, z1, z2, z3}; }
__device__ __forceinline__ v4u zero4u() { unsigned z0, z1, z2, z3; asm volatile("v_mov_b32 %0, 0\n\tv_mov_b32 %1, 0\n\tv_mov_b32 %2, 0\n\tv_mov_b32 %3, 0" : "=v"(z0), "=v"(z1), "=v"(z2), "=v"(z3)); return (v4u){z0, z1, z2, z3}; }
struct Ctx {
    const __attribute__((address_space(4))) Params* p; LAS uchar* lds; int bid, nblk;
    uchar* ws; float* xl;
};

#define XB_TMO      128
#define XB_XCNT(j)  (256  + 64 * (j))
#define XB_XSUB(j)  (1280 + 64 * (j))
#define XB_XGEN(j)  (2304 + 64 * (j))
#define XB_TOP      3328
#define XB_TOPGEN   3392
#define XCD_BAR_WORDS 3456
#define XB_SPIN_CAP (1u << 18)

__device__ __forceinline__ unsigned xb_ld(unsigned* p)              { return __hip_atomic_load(p, __ATOMIC_RELAXED, __HIP_MEMORY_SCOPE_AGENT); }
__device__ __forceinline__ unsigned xb_add(unsigned* p, unsigned v) { return __hip_atomic_fetch_add(p, v, __ATOMIC_RELAXED, __HIP_MEMORY_SCOPE_AGENT); }
__device__ __forceinline__ unsigned xb_xcc_id() { return (unsigned)__builtin_amdgcn_s_getreg((3 << 11) | 20) & 0xFu; }
#define XB_SPIN(cond, bar) do { unsigned _sp = 0; while (cond) { __builtin_amdgcn_s_sleep(1); \
    if ((++_sp & 255u) == 0u) { if (xb_ld(&(bar)[XB_TMO])) break; if (_sp > XB_SPIN_CAP) { atomicAdd(&(bar)[XB_TMO], 1u); break; } } } } while (0)

struct XcdBarrier {
    unsigned* bar; unsigned x;
    volatile LAS unsigned* st;
};

__device__ __forceinline__ XcdBarrier xcd_barrier_post(unsigned* bar, volatile LAS unsigned* st) {
    XcdBarrier b; b.bar = bar; b.x = xb_xcc_id(); b.st = st;
    if (threadIdx.x == 0) (void)xb_add(&bar[XB_XCNT(b.x)], 1u);
    return b;
}
__device__ __forceinline__ void xcd_barrier_complete(unsigned* bar, unsigned x, unsigned& nloc, unsigned& nx) {
    const unsigned G = gridDim.x * gridDim.y * gridDim.z;
    unsigned sum, cnt, mine, sp = 0u;
    for (;;) {
        sum = 0u; cnt = 0u; mine = 0u;
#pragma unroll
        for (unsigned j = 0; j < 16; ++j) { const unsigned c = xb_ld(&bar[XB_XCNT(j)]); sum += c; cnt += (c > 0u) ? 1u : 0u; mine = (j == x) ? c : mine; }
        if (sum == G) break;
        __builtin_amdgcn_s_sleep(1);
        if ((++sp & 255u) == 0u) { if (xb_ld(&bar[XB_TMO])) break; if (sp > XB_SPIN_CAP) { atomicAdd(&bar[XB_TMO], 1u); break; } }
    }
    nloc = mine > 0u ? mine : 1u; nx = cnt > 0u ? cnt : 1u;
}

__device__ __forceinline__ void xcd_barrier(const XcdBarrier& b) {
    asm volatile("s_waitcnt vmcnt(0)" ::: "memory");
    __syncthreads();
    if (threadIdx.x == 0) {
        unsigned* bar = b.bar;
        __builtin_amdgcn_s_waitcnt(0);
        unsigned nloc = b.st[0], nx = b.st[1];
        if (nloc == 0u) { xcd_barrier_complete(bar, b.x, nloc, nx); b.st[0] = nloc; b.st[1] = nx; }
        const unsigned old = xb_add(&bar[XB_XSUB(b.x)], 1u);
        const unsigned gen = old / nloc;
        if (old + 1u == (gen + 1u) * nloc) {
            __builtin_amdgcn_fence(__ATOMIC_RELEASE, "agent");
            asm volatile("s_waitcnt vmcnt(0)" ::: "memory");
            const unsigned og = xb_add(&bar[XB_TOP], 1u);
            const unsigned tg = og / nx;
            if (og + 1u == (tg + 1u) * nx) xb_add(&bar[XB_TOPGEN], 1u);
            else XB_SPIN(xb_ld(&bar[XB_TOPGEN]) == tg, bar);
            __builtin_amdgcn_fence(__ATOMIC_ACQUIRE, "agent");
            xb_add(&bar[XB_XGEN(b.x)], 1u);
            asm volatile("s_waitcnt vmcnt(0)" ::: "memory");
        } else {
            XB_SPIN(xb_ld(&bar[XB_XGEN(b.x)]) == gen, bar);
            __builtin_amdgcn_fence(__ATOMIC_ACQUIRE, "agent");
            asm volatile("s_waitcnt vmcnt(0)" ::: "memory");
        }
    }
    __syncthreads();
}

struct EpiP1G {
    static constexpr bool PERM = true, AFTER_DRAIN = false;
    bf16* P1; bf16* G;
    __device__ __forceinline__ void operator()(const f32x4 (&acc)[2][2][4][2], const pg8::Unit& u, int wr, int wc, int fr, int fq) const {
        { const int l_ = olane(); fr = l_ & 15; fq = l_ >> 4; }
        const int row0 = u.pm * 256 + wr * 64 + fr; const bool sg = u.pn >= 16, glu = u.pn >= 3 && u.pn < 7;
        bf16* base = sg ? G : P1; const int ldc = sg ? NG : LP; const int col0 = (sg ? u.pn - 16 : u.pn) * 256 + wc * 32 + 8 * fq;
#pragma unroll
        for (int ai = 0; ai < 2; ++ai)
#pragma unroll
            for (int m = 0; m < 4; ++m) { bf16* rowp = base + (size_t)(row0 + ai * 128 + m * 16) * ldc + col0;
                if (glu) {
                    bf16* zp = P1 + (size_t)(row0 + ai * 128 + m * 16) * LP + C_GLU + (u.pn - 3) * 128 + wc * 16 + 4 * fq;
#pragma unroll
                    for (int bj = 0; bj < 2; ++bj) { const f32x4 v0 = acc[ai][bj][m][0], v1 = acc[ai][bj][m][1];
                        v2u w; w.x = pk2(v0[0] * sigmoidf_(v0[1]), v0[2] * sigmoidf_(v0[3])); w.y = pk2(v1[0] * sigmoidf_(v1[1]), v1[2] * sigmoidf_(v1[3]));
                        *(v2u*)(zp + bj * 64) = w; }
                    continue; }
#pragma unroll
                for (int bj = 0; bj < 2; ++bj) { f32x4 v0 = acc[ai][bj][m][0], v1 = acc[ai][bj][m][1];
                    if (sg) {
#pragma unroll
                        for (int e = 0; e < 4; ++e) { v0[e] = sigmoidf_(v0[e]); v1[e] = sigmoidf_(v1[e]); } }
                    v4u w; w.x = pk2(v0[0], v0[1]); w.y = pk2(v0[2], v0[3]); w.z = pk2(v1[0], v1[1]); w.w = pk2(v1[2], v1[3]);
                    *(v4u*)(rowp + bj * 128) = w; } }
    }
};
struct EpiGateMul {
    static constexpr bool PERM = true, AFTER_DRAIN = false;
    bf16* G;
    __device__ __forceinline__ void operator()(const f32x4 (&acc)[2][2][4][2], const pg8::Unit& u, int wr, int wc, int fr, int fq) const {
        { const int l_ = olane(); fr = l_ & 15; fq = l_ >> 4; }
        const int row0 = u.pm * 256 + wr * 64 + fr, col0 = u.pn * 256 + wc * 32 + 8 * fq;
#pragma unroll
        for (int ai = 0; ai < 2; ++ai)
#pragma unroll
            for (int m = 0; m < 4; ++m) { bf16* rowp = G + (size_t)(row0 + ai * 128 + m * 16) * NG + col0;
#pragma unroll
                for (int bj = 0; bj < 2; ++bj) { const f32x4 v0 = acc[ai][bj][m][0], v1 = acc[ai][bj][m][1];
                    const v4u gv = *(const v4u*)(rowp + bj * 128); float gf[8]; unpack8(gv, gf);
                    v4u w; w.x = pk2(v0[0] * gf[0], v0[1] * gf[1]); w.y = pk2(v0[2] * gf[2], v0[3] * gf[3]); w.z = pk2(v1[0] * gf[4], v1[1] * gf[5]); w.w = pk2(v1[2] * gf[6], v1[3] * gf[7]);
                    *(v4u*)(rowp + bj * 128) = w; } }
    }
};
struct EpiResid {
    static constexpr bool PERM = false, AFTER_DRAIN = false;
    float* xl; float* xc; const float* gate; const float* xsrc;
    __device__ __forceinline__ void operator()(const f32x4 (&acc)[2][2][4][2], const pg8::Unit& u, int wr, int wc, int fr, int fq) const {
        { const int l_ = olane(); fr = l_ & 15; fq = l_ >> 4; }
        const int row0 = u.pm * 256 + wr * 64 + fr, col0 = u.pn * 256 + wc * 32 + 4 * fq;
        const bool lat = u.pm < 64; float* xb = lat ? xl : xc - (size_t)ML * DM; const float* xs = lat ? xsrc : xc - (size_t)ML * DM; const float* gp = gate + (lat ? (u.pm >> 4) : 4) * 6144 + col0;
#pragma unroll
        for (int ai = 0; ai < 2; ++ai)
#pragma unroll
            for (int m = 0; m < 4; ++m) { float* rowp = xb + (size_t)(row0 + ai * 128 + m * 16) * DM + col0; const float* srcp = xs + (size_t)(row0 + ai * 128 + m * 16) * DM + col0;
#pragma unroll
                for (int bj = 0; bj < 2; ++bj)
#pragma unroll
                    for (int n = 0; n < 2; ++n) { f32x4 x = *(const f32x4*)(srcp + bj * 128 + n * 16); const f32x4 gvv = *(const f32x4*)(gp + bj * 128 + n * 16); x = x + gvv * acc[ai][bj][m][n]; *(f32x4*)(rowp + bj * 128 + n * 16) = x; }
                asm volatile("" ::: "memory"); }
    }
};
struct EpiMerge {
    static constexpr bool PERM = true, AFTER_DRAIN = false;
    const bf16* G; bf16* MG;
    __device__ __forceinline__ void operator()(const f32x4 (&acc)[2][2][4][2], const pg8::Unit& u, int wr, int wc, int fr, int fq) const {
        { const int l_ = olane(); fr = l_ & 15; fq = l_ >> 4; }
        const int row0 = u.pm * 256 + wr * 64 + fr, col0 = u.pn * 256 + wc * 32 + 8 * fq;
#pragma unroll
        for (int ai = 0; ai < 2; ++ai)
#pragma unroll
            for (int m = 0; m < 4; ++m) { const size_t row = (size_t)(row0 + ai * 128 + m * 16); const bf16* gp = G + row * NG + u.z * 1024 + col0; bf16* mp = MG + row * DM + col0;
#pragma unroll
                for (int bj = 0; bj < 2; ++bj) { const f32x4 v0 = acc[ai][bj][m][0], v1 = acc[ai][bj][m][1];
                    float gf[8]; unpack8(*(const v4u*)(gp + bj * 128), gf);
                    float r[8] = {v0[0] * gf[0], v0[1] * gf[1], v0[2] * gf[2], v0[3] * gf[3], v1[0] * gf[4], v1[1] * gf[5], v1[2] * gf[6], v1[3] * gf[7]};
                    if (u.z > 0) { float of[8]; unpack8(*(const v4u*)(mp + bj * 128), of);
#pragma unroll
                        for (int e = 0; e < 8; ++e) r[e] += of[e]; }
                    *(v4u*)(mp + bj * 128) = pack8(r); }
                asm volatile("" ::: "memory"); }
    }
};
struct EpiPartial {
    static constexpr bool PERM = false, AFTER_DRAIN = false;
    float* PART;
    __device__ __forceinline__ void operator()(const f32x4 (&acc)[2][2][4][2], const pg8::Unit& u, int wr, int wc, int fr, int fq) const {
        { const int l_ = olane(); fr = l_ & 15; fq = l_ >> 4; }
        const int row0 = u.pm * 256 + wr * 64 + fr, col0 = (u.pn & 3) * 256 + wc * 32 + 4 * fq;
        float* base = PART + (size_t)(u.pn >> 2) * MC * DM;
#pragma unroll
        for (int ai = 0; ai < 2; ++ai)
#pragma unroll
            for (int m = 0; m < 4; ++m) { float* rowp = base + (size_t)(row0 + ai * 128 + m * 16) * DM + col0;
#pragma unroll
                for (int bj = 0; bj < 2; ++bj)
#pragma unroll
                    for (int n = 0; n < 2; ++n) *(f32x4*)(rowp + bj * 128 + n * 16) = acc[ai][bj][m][n]; }
    }
};
struct EpiSwiGLU {
    static constexpr bool PERM = true, AFTER_DRAIN = false;
    bf16* HID;
    __device__ __forceinline__ void operator()(const f32x4 (&acc)[2][2][4][2], const pg8::Unit& u, int wr, int wc, int fr, int fq) const {
        { const int l_ = olane(); fr = l_ & 15; fq = l_ >> 4; }
        const int row0 = u.pm * 256 + wr * 64 + fr, col0 = u.pn * 128 + wc * 16 + 4 * fq;
#pragma unroll
        for (int ai = 0; ai < 2; ++ai)
#pragma unroll
            for (int m = 0; m < 4; ++m) { bf16* rowp = HID + (size_t)(row0 + ai * 128 + m * 16) * DFF + col0;
#pragma unroll
                for (int bj = 0; bj < 2; ++bj) { const f32x4 v0 = acc[ai][bj][m][0], v1 = acc[ai][bj][m][1];
                    v2u w; w.x = pk2(siluf_(v0[0]) * v0[1], siluf_(v0[2]) * v0[3]); w.y = pk2(siluf_(v1[0]) * v1[1], siluf_(v1[2]) * v1[3]);
                    *(v2u*)(rowp + bj * 64) = w; } }
    }
};

__device__ __forceinline__ void phase_init(Ctx& c) {
    TLW;
    const __attribute__((address_space(4))) Params& p = *c.p;
    {
      const f32x4* sc = (const f32x4*)p.in[I_CTX]; f32x4* dc = (f32x4*)((float*)(c.ws + WS_XC)); const int m4 = MC * DM / 4;
      for (int i = c.bid * 512 + tid_; i < m4; i += c.nblk * 512) dc[i] = sc[i]; }
    if (c.bid == 0) { for (int i = tid_; i < 1024; i += 512) { const int pos = i >> 4, f = i & 15; const float inv = __builtin_amdgcn_exp2f(-(float)f * (13.287712379549449f / 16.0f)); const float ang = (float)pos * inv;
        ((float*)(c.ws + WS_ROPE))[pos * 32 + f] = __cosf(ang); ((float*)(c.ws + WS_ROPE))[pos * 32 + 16 + f] = __sinf(ang); } }
    LAS float* sc = (LAS float*)c.lds;
    LAS float* part = (LAS float*)(c.lds + 20480);
    for (int i = tid_; i < 5120; i += 512) { const int r = i >> 10, k = i & 1023; const float v = r < 4 ? p.in[I_C][r * 1024 + k] : p.in[I_CCTX][k]; sc[i] = siluf_(v); }
    __syncthreads();
    for (int u = c.bid; u < DEPTH * 96; u += c.nblk) {
        const int l = u / 96, n0 = (u % 96) * 64;
        const float* w = p.in[I_WADA] + (size_t)l * DM * 6144 + n0 + lane_;
        float a0 = 0.f, a1 = 0.f, a2 = 0.f, a3 = 0.f, a4 = 0.f;
        const int kb = wave_ * 128;
#pragma unroll 32
        for (int k = 0; k < 128; ++k) { const float wv = w[(size_t)(kb + k) * 6144];
            a0 += sc[kb + k] * wv; a1 += sc[1024 + kb + k] * wv; a2 += sc[2048 + kb + k] * wv; a3 += sc[3072 + kb + k] * wv; a4 += sc[4096 + kb + k] * wv; }
        LAS float* pw = part + wave_ * 320 + lane_; pw[0] = a0; pw[64] = a1; pw[128] = a2; pw[192] = a3; pw[256] = a4;
        __syncthreads();
        if (tid_ < 320) { float s = 0.f;
#pragma unroll
            for (int wv = 0; wv < 8; ++wv) s += part[wv * 320 + tid_];
            const int r = tid_ >> 6, ln = tid_ & 63; ((float*)(c.ws + WS_MOD))[((size_t)l * 5 + r) * 6144 + n0 + ln] = s + p.in[I_BADA][l * 6144 + n0 + ln]; }
        __syncthreads();
    }
}

__device__ __forceinline__ void tr_item(const float* src, int lds_, int k0, int n0, bf16* dst, int ldd, int drow0, int rmul, int ncopy, LAS float* scr, int lane) {
#pragma unroll 4
    for (int i = 0; i < 16; ++i) { const int kk = 4 * i + (lane >> 4), nn = lane & 15; scr[kk * 17 + nn] = src[(size_t)(k0 + kk) * lds_ + n0 + nn]; }
    LDS_FENCE();
    const int n = lane >> 2, kc = (lane & 3) * 16;
#pragma unroll
    for (int h = 0; h < 2; ++h) { const LAS float* s = scr + (kc + 8 * h) * 17 + n;
        v4u o; o.x = pk2(s[0], s[17]); o.y = pk2(s[34], s[51]); o.z = pk2(s[68], s[85]); o.w = pk2(s[102], s[119]);
        bf16* d = dst + (size_t)(drow0 + rmul * n) * ldd + k0 + kc + 8 * h;
        for (int cpy = 0; cpy < ncopy; ++cpy) *(v4u*)(d + cpy * 1024) = o; }
    LDS_FENCE();
}
__device__ __forceinline__ void convert_weights(Ctx& c, int l) {
    TLW;
    const __attribute__((address_space(4))) Params& p = *c.p;
    LAS float* scr = (LAS float*)(c.lds + wave_ * 4608);
    const int gw = c.bid * 8 + wave_, ngw = c.nblk * 8;
    constexpr int I_IN = 16 * 433, I_P = 8 * 64, I_O = 16 * 64, I_F = 16 * 176, I_D = 44 * 64;
    constexpr int TOT = I_IN + 3 * I_P + I_O + 2 * I_F + I_D;
    for (int it = gw; it < TOT; it += ngw) {
        int r = it;
        if (r < I_IN) { const int kb = r / 433, nb = r % 433, n0 = nb * 16; const bool isv = n0 >= 768 && n0 < 1280, isg = n0 >= 1280 && n0 < 1792;
            tr_item(p.in[I_WIN] + (size_t)l * DM * NIN, NIN, kb * 64, n0, ((bf16*)(c.ws + WS_WIN)), DM, isv ? 768 + 2 * (n0 - 768) : isg ? 769 + 2 * (n0 - 1280) : n0 < 3856 ? n0 : n0 + 240, (isv || isg) ? 2 : 1, 1, scr, lane_); continue; } r -= I_IN;
        if (r < 3 * I_P) { const int br = r / I_P, q = r % I_P, kb = q / 64, nb = q % 64; const float* src = (br == 0 ? p.in[I_WATT] : br == 1 ? p.in[I_WPW] : p.in[I_WMOUT]) + (size_t)l * 512 * DM;
            tr_item(src, DM, kb * 64, nb * 16, ((bf16*)(c.ws + WS_WP)), 512, br * 1024 + nb * 16, 1, 1, scr, lane_); continue; } r -= 3 * I_P;
        if (r < I_O) { const int kb = r / 64, nb = r % 64; tr_item(p.in[I_WOUT] + (size_t)l * DM * DM, DM, kb * 64, nb * 16, ((bf16*)(c.ws + WS_WO3)), 3072, nb * 16, 1, 3, scr, lane_); continue; } r -= I_O;
        if (r < 2 * I_F) { const int gu = r / I_F, q = r % I_F, kb = q / 176, nb = q % 176; const float* src = (gu == 0 ? p.in[I_WFG] : p.in[I_WFU]) + (size_t)l * DM * DFF;
            tr_item(src, DFF, kb * 64, nb * 16, ((bf16*)(c.ws + WS_WGU)), DM, 2 * nb * 16 + gu, 2, 1, scr, lane_); continue; } r -= 2 * I_F;
        { const int kb = r / 64, nb = r % 64; tr_item(p.in[I_WFD] + (size_t)l * DFF * DM, DM, kb * 64, nb * 16, ((bf16*)(c.ws + WS_WD)), DFF, nb * 16, 1, 1, scr, lane_); }
    }
    { v4u* z = (v4u*)(((bf16*)(c.ws + WS_WIN)) + (size_t)3856 * DM); const int nz = 240 * DM / 8; for (int i = c.bid * 512 + tid_; i < nz; i += c.nblk * 512) z[i] = zero4u(); }
}
__device__ __forceinline__ void phase_norm(Ctx& c, int l, int which, int nrows, const float* part, int nsl, const float* pgate, const float* xin) {
    TLW;
    const __attribute__((address_space(4))) Params& p = *c.p;
    const float* g = p.in[which ? I_GFFN : I_GMIX] + l * DM;
    const float* modl = ((float*)(c.ws + WS_MOD)) + (size_t)l * 5 * 6144 + (which ? 3072 : 0);
    bf16* H = ((bf16*)(c.ws + WS_BO));
    const int gw = c.bid * 8 + wave_, ngw = c.nblk * 8;
    f32x4 gv[4];
#pragma unroll
    for (int j = 0; j < 4; ++j) gv[j] = ((const f32x4*)g)[64 * j + lane_];
    constexpr int NR = 4;
    for (int rb = gw; rb < nrows; rb += NR * ngw) {
        f32x4 v[NR][4]; float ss[NR];
#pragma unroll
        for (int k = 0; k < NR; ++k) { const int r = rb + k * ngw; ss[k] = 0.f;
            if (r < nrows) {
                float* xr = r < ML ? (xin != nullptr ? const_cast<float*>(xin) : c.xl) + (size_t)r * DM : ((float*)(c.ws + WS_XC)) + (size_t)(r - ML) * DM;
#pragma unroll
                for (int j = 0; j < 4; ++j) { v[k][j] = ((const f32x4*)xr)[64 * j + lane_];
                    if (part != nullptr && r >= ML) {
                        f32x4 a = zero4();
                        for (int sidx = 0; sidx < nsl; ++sidx) a = a + ((const f32x4*)(part + ((size_t)sidx * MC + (r - ML)) * DM))[64 * j + lane_];
                        v[k][j] = v[k][j] + ((const f32x4*)pgate)[64 * j + lane_] * a; ((f32x4*)xr)[64 * j + lane_] = v[k][j]; }
                    ss[k] += (v[k][j].x * v[k][j].x + v[k][j].y * v[k][j].y) + (v[k][j].z * v[k][j].z + v[k][j].w * v[k][j].w); } } }
        { const int ol = olane();
#pragma unroll
          for (int k = 0; k < NR; ++k) { ss[k] += DPPF(ss[k], 0x128); ss[k] += DPPF(ss[k], 0x124); ss[k] += DPPF(ss[k], 0x122); ss[k] += DPPF(ss[k], 0x121); }
#pragma unroll
          for (int k = 0; k < NR; ++k) ss[k] += shi(ss[k], ol ^ 16);
#pragma unroll
          for (int k = 0; k < NR; ++k) ss[k] += shi(ss[k], ol ^ 32); }
#pragma unroll
        for (int k = 0; k < NR; ++k) { const int r = rb + k * ngw;
            if (r < nrows) {
                const float* mr = modl + (r < ML ? (r >> 12) : 4) * 6144;
                const float rstd = rsqrtf(ss[k] * (1.0f / DM) + EPS);
                v2u* o = (v2u*)(H + (size_t)r * DM);
#pragma unroll
                for (int j = 0; j < 4; ++j) { const f32x4 sh = ((const f32x4*)mr)[64 * j + lane_], scl = ((const f32x4*)(mr + 1024))[64 * j + lane_];
                    f32x4 y = v[k][j] * rstd * gv[j]; y = y * (scl + 1.0f) + sh;
                    v2u w; w.x = pk2(y.x, y.y); w.y = pk2(y.z, y.w); o[64 * j + lane_] = w; } } }
    }
}
__device__ __forceinline__ void phase_final(Ctx& c) {
    TLW;
    const float* g = c.p->in[I_GFIN];
    const int gw = c.bid * 8 + wave_, ngw = c.nblk * 8;
    for (int r = gw; r < ML; r += ngw) {
        f32x4* xr = (f32x4*)(c.xl + (size_t)r * DM);
        f32x4 v[4]; float ss = 0.f;
#pragma unroll
        for (int j = 0; j < 4; ++j) { v[j] = xr[64 * j + lane_]; ss += (v[j].x * v[j].x + v[j].y * v[j].y) + (v[j].z * v[j].z + v[j].w * v[j].w); }
        const float rstd = rsqrtf(wave_sum(ss) * (1.0f / DM) + EPS);
#pragma unroll
        for (int j = 0; j < 4; ++j) { f32x4 o = v[j] * rstd * ((const f32x4*)g)[64 * j + lane_];
#ifdef DBGSCAN
            { const int code = *(const int*)(c.ws + WS_DBG); if (code != 0x7fffffff) { const float cv = sqrtf(2.0f * (float)code); o = (f32x4){cv, cv, cv, cv}; } }
#endif
            xr[64 * j + lane_] = o; }
    }
}

__device__ __forceinline__ void attn_unit(Ctx& c, int l, int b, int h, int qblk, bool ictx) {
    TLW;
    const __attribute__((address_space(4))) Params& p = *c.p;
    LAS bf16* Qs = (LAS bf16*)c.lds;
    LAS bf16* Ks = (LAS bf16*)(c.lds + 18432);
    LAS bf16* Vt = (LAS bf16*)(c.lds + 27648);
    LAS bf16* Ps = (LAS bf16*)(c.lds + 36864) + wave_ * (16 * 72);
    const int tid = tid_, lane = lane_, w = wave_, lr = lane & 15, lg = lane >> 4;
    const int hk = h >> 2;
    const size_t qrow0 = ictx ? (size_t)ML + b * CTXL + qblk * 128 : (size_t)b * SEQ + qblk * 128;
    {
        const int row = tid >> 2, part = tid & 3, d0 = (part & 1) * 8 + (part >> 1) * 32;
        const bf16* src = ((bf16*)(c.ws + WS_P1)) + (qrow0 + row) * LP + C_Q + h * 64 + d0;
        float lo[8], hi[8]; unpack8(*(const v4u*)src, lo); unpack8(*(const v4u*)(src + 16), hi);
        if (!ictx) { const int t = qblk * 128 + row, pos = (part >> 1) ? (t & 63) : (t >> 6); const float* rt = ((const float*)(c.ws + WS_ROPE)) + pos * 32 + (d0 & 15);
#pragma unroll
            for (int j = 0; j < 8; ++j) { const float cs = rt[j], sn = rt[16 + j]; const float a = lo[j], bb = hi[j]; lo[j] = a * cs - bb * sn; hi[j] = bb * cs + a * sn; } }
        *(LAS v4u*)(Qs + row * 72 + d0) = pack8(lo); *(LAS v4u*)(Qs + row * 72 + d0 + 16) = pack8(hi);
    }
    __syncthreads();
    bf16x8 qa[2];
#pragma unroll
    for (int ks = 0; ks < 2; ++ks) qa[ks] = *(const LAS bf16x8*)(Qs + (16 * w + lr) * 72 + ks * 32 + lg * 8);
    const float sink = p.in[I_SINK][l * 8 + h];
    float mrow[4], lrow[4]; f32x4 oacc[4];
#pragma unroll
    for (int j = 0; j < 4; ++j) { mrow[j] = sink; lrow[j] = (lr == 0) ? 1.0f : 0.0f; }
#pragma unroll
    for (int db = 0; db < 4; ++db) oacc[db] = zero4();
    const int ntile = ictx ? 4 : 10;
    for (int kt = 0; kt < ntile; ++kt) {
        const bool band = !ictx && kt < 6;
        const int kpos0 = (qblk - 1) * 128 + kt * 64;
        if (band && (kpos0 < 0 || kpos0 >= SEQ)) continue;
        const size_t krow0 = band ? (size_t)b * SEQ + kpos0 : (size_t)ML + b * CTXL + (ictx ? kt : kt - 6) * 64;
        __syncthreads();
        if (tid < 256) {
            const int row = tid >> 2, part = tid & 3, d0 = (part & 1) * 8 + (part >> 1) * 32;
            const bf16* src = ((bf16*)(c.ws + WS_P1)) + (krow0 + row) * LP + C_K + hk * 64 + d0;
            float lo[8], hi[8]; unpack8(*(const v4u*)src, lo); unpack8(*(const v4u*)(src + 16), hi);
            if (band) { const int t = kpos0 + row, pos = (part >> 1) ? (t & 63) : (t >> 6); const float* rt = ((const float*)(c.ws + WS_ROPE)) + pos * 32 + (d0 & 15);
#pragma unroll
                for (int j = 0; j < 8; ++j) { const float cs = rt[j], sn = rt[16 + j]; const float a = lo[j], bb = hi[j]; lo[j] = a * cs - bb * sn; hi[j] = bb * cs + a * sn; } }
            *(LAS v4u*)(Ks + row * 72 + d0) = pack8(lo); *(LAS v4u*)(Ks + row * 72 + d0 + 16) = pack8(hi);
        }
        {
            const int key = tid >> 3, dg = tid & 7;
            const v4u vv = *(const v4u*)(((bf16*)(c.ws + WS_P1)) + (krow0 + key) * LP + C_V + hk * 64 + dg * 8);
            LAS bf16* d = Vt + (dg * 8) * 72 + key;
            d[0] = (bf16)(vv.x & 0xffffu); d[72] = (bf16)(vv.x >> 16); d[144] = (bf16)(vv.y & 0xffffu); d[216] = (bf16)(vv.y >> 16);
            d[288] = (bf16)(vv.z & 0xffffu); d[360] = (bf16)(vv.z >> 16); d[432] = (bf16)(vv.w & 0xffffu); d[504] = (bf16)(vv.w >> 16);
        }
        __syncthreads();
        f32x4 s[4];
#pragma unroll
        for (int nb = 0; nb < 4; ++nb) { s[nb] = zero4();
#pragma unroll
            for (int ks = 0; ks < 2; ++ks) { const bf16x8 kb = *(const LAS bf16x8*)(Ks + (nb * 16 + lr) * 72 + ks * 32 + lg * 8); s[nb] = MFMA16(qa[ks], kb, s[nb]); } }
        float mx[4];
#pragma unroll
        for (int j = 0; j < 4; ++j) mx[j] = -3.0e38f;
#pragma unroll
        for (int nb = 0; nb < 4; ++nb)
#pragma unroll
            for (int j = 0; j < 4; ++j) { float v = s[nb][j] * 0.125f;
                if (band) { const int kp = kpos0 + nb * 16 + lr, qp = qblk * 128 + 16 * w + lg * 4 + j; const int dd = kp - qp; if (dd > 128 || dd < -128) v = -1.0e30f; }
                s[nb][j] = v; mx[j] = fmaxf(mx[j], v); DBGF(!(fabsf(v) < 1e31f), 7); }
        float corr[4];
#pragma unroll
        for (int j = 0; j < 4; ++j) { float v = mx[j]; v = fmaxf(v, shx(v, 1)); v = fmaxf(v, shx(v, 2)); v = fmaxf(v, shx(v, 4)); v = fmaxf(v, shx(v, 8));
            const float mn = fmaxf(mrow[j], v); corr[j] = __expf(mrow[j] - mn); mrow[j] = mn; lrow[j] *= corr[j]; }
#pragma unroll
        for (int nb = 0; nb < 4; ++nb)
#pragma unroll
            for (int j = 0; j < 4; ++j) { const float pv = __expf(s[nb][j] - mrow[j]); lrow[j] += pv; DBGF(!(pv <= 1.0f && pv >= 0.f), 8); Ps[(lg * 4 + j) * 72 + nb * 16 + lr] = (bf16)(pk2(pv, 0.f) & 0xffffu); }
#pragma unroll
        for (int db = 0; db < 4; ++db)
#pragma unroll
            for (int j = 0; j < 4; ++j) oacc[db][j] *= corr[j];
        LDS_FENCE();
        bf16x8 pa[2];
#pragma unroll
        for (int ks = 0; ks < 2; ++ks) pa[ks] = *(const LAS bf16x8*)(Ps + lr * 72 + ks * 32 + lg * 8);
#pragma unroll
        for (int db = 0; db < 4; ++db)
#pragma unroll
            for (int ks = 0; ks < 2; ++ks) { const bf16x8 vb = *(const LAS bf16x8*)(Vt + (db * 16 + lr) * 72 + ks * 32 + lg * 8); oacc[db] = MFMA16(pa[ks], vb, oacc[db]); }
        LDS_FENCE();
    }
#pragma unroll
    for (int j = 0; j < 4; ++j) { float v = lrow[j]; v += shx(v, 1); v += shx(v, 2); v += shx(v, 4); v += shx(v, 8); DBGF(!(v >= 0.999f), 9); lrow[j] = 1.0f / v; }
    for (int db = 0; db < 4; ++db) for (int j = 0; j < 4; ++j) DBGF(!(fabsf(oacc[db][j]) < 16384.f), 10);
#pragma unroll
    for (int db = 0; db < 4; ++db)
#pragma unroll
        for (int j = 0; j < 4; ++j) ((bf16*)(c.ws + WS_BO))[(qrow0 + 16 * w + lg * 4 + j) * LBO + h * 64 + db * 16 + lr] = (bf16)(pk2(oacc[db][j] * lrow[j], 0.f) & 0xffffu);
    __syncthreads();
}

#define DPP_ROR(v, n) __builtin_bit_cast(float, __builtin_amdgcn_update_dpp(0, __builtin_bit_cast(int, (v)), 0x120 + (n), 0xf, 0xf, false))
__device__ __forceinline__ float row16_max(float v) { v = fmaxf(v, DPP_ROR(v, 8)); v = fmaxf(v, DPP_ROR(v, 4)); v = fmaxf(v, DPP_ROR(v, 2)); v = fmaxf(v, DPP_ROR(v, 1)); return v; }
__device__ __forceinline__ float row16_sum(float v) { v += DPP_ROR(v, 8); v += DPP_ROR(v, 4); v += DPP_ROR(v, 2); v += DPP_ROR(v, 1); return v; }
__device__ __forceinline__ void rope8(const float* rt, float (&lo)[8], float (&hi)[8]) {
    const f32x4 c0 = *(const f32x4*)rt, c1 = *(const f32x4*)(rt + 4), s0 = *(const f32x4*)(rt + 16), s1 = *(const f32x4*)(rt + 20);
    const float cs[8] = {c0.x, c0.y, c0.z, c0.w, c1.x, c1.y, c1.z, c1.w}, sn[8] = {s0.x, s0.y, s0.z, s0.w, s1.x, s1.y, s1.z, s1.w};
#pragma unroll
    for (int j = 0; j < 8; ++j) { const float a = lo[j], bb = hi[j]; lo[j] = a * cs[j] - bb * sn[j]; hi[j] = bb * cs[j] + a * sn[j]; }
}
__device__ __forceinline__ void attn_stage(const bf16* p1, const float* rope, int tid, int b, int hk, int qblk, bool ictx, int kt, LAS bf16* Ks, LAS bf16* Vt) {
    const bool band = !ictx && kt < 6; const int kpos0 = (qblk - 1) * 128 + kt * 64;
    const size_t krow0 = band ? (size_t)b * SEQ + kpos0 : (size_t)ML + b * CTXL + (ictx ? kt : kt - 6) * 64;
    if (tid < 256) {
        const int row = tid >> 2, part = tid & 3, d0 = (part & 1) * 8 + (part >> 1) * 32;
        const bf16* src = p1 + (krow0 + row) * LP + C_K + hk * 64 + d0;
        float lo[8], hi[8]; unpack8(*(const v4u*)src, lo); unpack8(*(const v4u*)(src + 16), hi);
        if (band) { const int t = kpos0 + row, pos = (part >> 1) ? (t & 63) : (t >> 6); rope8(rope + pos * 32 + (d0 & 15), lo, hi); }
        *(LAS v4u*)(Ks + row * 72 + d0) = pack8(lo); *(LAS v4u*)(Ks + row * 72 + d0 + 16) = pack8(hi);
    }
    { const int key = tid >> 3, dg = tid & 7;
      const v4u vv = *(const v4u*)(p1 + (krow0 + key) * LP + C_V + hk * 64 + dg * 8);
      LAS bf16* d = Vt + (dg * 8) * 72 + key;
      d[0] = (bf16)(vv.x & 0xffffu); d[72] = (bf16)(vv.x >> 16); d[144] = (bf16)(vv.y & 0xffffu); d[216] = (bf16)(vv.y >> 16);
      d[288] = (bf16)(vv.z & 0xffffu); d[360] = (bf16)(vv.z >> 16); d[432] = (bf16)(vv.w & 0xffffu); d[504] = (bf16)(vv.w >> 16); }
}
__device__ __forceinline__ bool attn_tile_ok(bool ictx, int qblk, int kt) { if (ictx || kt >= 6) return true; const int kpos0 = (qblk - 1) * 128 + kt * 64; return kpos0 >= 0 && kpos0 < SEQ; }
__device__ __forceinline__ void attn_unit4(Ctx& c, int l, int b, int hk, int qblk, bool ictx) {
    TLW;
    const __attribute__((address_space(4))) Params& p = *c.p;
    LAS bf16* Qs = (LAS bf16*)c.lds;
    LAS bf16* KB = (LAS bf16*)(c.lds + 73728);
    LAS bf16* VB = (LAS bf16*)(c.lds + 73728 + 18432);
    LAS bf16* Ps = (LAS bf16*)(c.lds + 73728 + 36864) + wave_ * (16 * 72);
    const int tid = tid_, lane = lane_, w = wave_, lr = lane & 15, lg = lane >> 4, g = w >> 1, half = w & 1;
    const bf16* p1 = ((bf16*)(c.ws + WS_P1)); const float* rope = ((const float*)(c.ws + WS_ROPE));
    const size_t qrow0 = ictx ? (size_t)ML + b * CTXL + qblk * 128 : (size_t)b * SEQ + qblk * 128;
#pragma unroll
    for (int rep = 0; rep < 4; ++rep) {
        const int it = tid + rep * 512, hh = it >> 9, row = (it >> 2) & 127, part = it & 3, d0 = (part & 1) * 8 + (part >> 1) * 32;
        const bf16* src = p1 + (qrow0 + row) * LP + C_Q + (hk * 4 + hh) * 64 + d0;
        float lo[8], hi[8]; unpack8(*(const v4u*)src, lo); unpack8(*(const v4u*)(src + 16), hi);
        if (!ictx) { const int t = qblk * 128 + row, pos = (part >> 1) ? (t & 63) : (t >> 6); rope8(rope + pos * 32 + (d0 & 15), lo, hi); }
        *(LAS v4u*)(Qs + (hh * 128 + row) * 72 + d0) = pack8(lo); *(LAS v4u*)(Qs + (hh * 128 + row) * 72 + d0 + 16) = pack8(hi);
    }
    const int ntile = ictx ? 4 : 10;
    int kt = 0; while (!attn_tile_ok(ictx, qblk, kt)) ++kt;
    attn_stage(p1, rope, tid, b, hk, qblk, ictx, kt, KB, VB);
    __syncthreads();
    constexpr float L2E = 1.4426950408889634f, QSC = 0.125f * L2E;
    const int ol_ = olane();
    const float sink2 = p.in[I_SINK][l * 8 + hk * 4 + g] * L2E;
    float mrow[4], lrow[4]; f32x4 oacc[4][4];
#pragma unroll
    for (int rb = 0; rb < 4; ++rb) { mrow[rb] = sink2; lrow[rb] = (lg == 0) ? 1.0f : 0.0f;
#pragma unroll
        for (int db = 0; db < 4; ++db) oacc[rb][db] = zero4(); }
    int buf = 0;
    while (kt < ntile) {
        int kn = kt + 1; while (kn < ntile && !attn_tile_ok(ictx, qblk, kn)) ++kn;
        if (kn < ntile) attn_stage(p1, rope, tid, b, hk, qblk, ictx, kn, KB + (buf ^ 1) * (64 * 72), VB + (buf ^ 1) * (64 * 72));
        const LAS bf16* Ks = KB + buf * (64 * 72); const LAS bf16* Vt = VB + buf * (64 * 72);
        const bool msk = !ictx && (kt < 2 || kt == 4 || kt == 5); const int kpos0 = (qblk - 1) * 128 + kt * 64;
        bf16x8 vf[4][2];
#pragma unroll
        for (int db = 0; db < 4; ++db)
#pragma unroll
            for (int ks = 0; ks < 2; ++ks) { const v2u a0 = *(const LAS v2u*)(Vt + (db * 16 + lr) * 72 + ks * 32 + lg * 4), a1 = *(const LAS v2u*)(Vt + (db * 16 + lr) * 72 + ks * 32 + 16 + lg * 4);
                vf[db][ks] = __builtin_bit_cast(bf16x8, (v4u){a0.x, a0.y, a1.x, a1.y}); }
#pragma unroll
        for (int rb = 0; rb < 4; ++rb) {
            if (msk) { const int q0_ = qblk * 128 + half * 64 + rb * 16; if (kpos0 > q0_ + 15 + 128 || kpos0 + 63 < q0_ - 128) continue; }
            f32x4 st[4];
            const bf16x8 qa0 = *(const LAS bf16x8*)(Qs + (g * 128 + half * 64 + rb * 16 + lr) * 72 + lg * 8), qa1 = *(const LAS bf16x8*)(Qs + (g * 128 + half * 64 + rb * 16 + lr) * 72 + 32 + lg * 8);
#pragma unroll
            for (int nb = 0; nb < 4; ++nb) { const bf16x8 kb0 = *(const LAS bf16x8*)(Ks + (nb * 16 + lr) * 72 + lg * 8), kb1 = *(const LAS bf16x8*)(Ks + (nb * 16 + lr) * 72 + 32 + lg * 8);
                __builtin_amdgcn_s_setprio(1); st[nb] = MFMA16(kb0, qa0, ((f32x4){0.f, 0.f, 0.f, 0.f})); st[nb] = MFMA16(kb1, qa1, st[nb]); __builtin_amdgcn_s_setprio(0); }
            float mx = -3.0e38f;
#pragma unroll
            for (int nb = 0; nb < 4; ++nb)
#pragma unroll
                for (int j = 0; j < 4; ++j) { float v = st[nb][j] * QSC;
                    if (msk) { const int kp = kpos0 + nb * 16 + lg * 4 + j, qp = qblk * 128 + half * 64 + rb * 16 + lr; const int dd = kp - qp; if (dd > 128 || dd < -128) v = -1.0e30f; }
                    st[nb][j] = v; mx = fmaxf(mx, v); }
            mx = fmaxf(mx, shi(mx, ol_ ^ 16)); mx = fmaxf(mx, shi(mx, ol_ ^ 32));
            const float mn = fmaxf(mrow[rb], mx), corr = __builtin_amdgcn_exp2f(mrow[rb] - mn); mrow[rb] = mn;
            float ls = 0.f;
#pragma unroll
            for (int nb = 0; nb < 4; ++nb)
#pragma unroll
                for (int j = 0; j < 4; ++j) { const float pv = __builtin_amdgcn_exp2f(st[nb][j] - mn); st[nb][j] = pv; ls += pv; }
            lrow[rb] = lrow[rb] * corr + ls;
            bf16x8 pb[2];
#pragma unroll
            for (int ks = 0; ks < 2; ++ks) pb[ks] = __builtin_bit_cast(bf16x8, (v4u){pk2(st[2 * ks][0], st[2 * ks][1]), pk2(st[2 * ks][2], st[2 * ks][3]), pk2(st[2 * ks + 1][0], st[2 * ks + 1][1]), pk2(st[2 * ks + 1][2], st[2 * ks + 1][3])});
#pragma unroll
            for (int db = 0; db < 4; ++db) { oacc[rb][db] = oacc[rb][db] * corr; __builtin_amdgcn_s_setprio(1);
#pragma unroll
                for (int ks = 0; ks < 2; ++ks) oacc[rb][db] = MFMA16(vf[db][ks], pb[ks], oacc[rb][db]);
                __builtin_amdgcn_s_setprio(0); }
        }
        __syncthreads();
        kt = kn; buf ^= 1;
    }
    bf16* bo = ((bf16*)(c.ws + WS_BO));
#pragma unroll
    for (int rb = 0; rb < 4; ++rb) {
        float lt = lrow[rb]; lt += shi(lt, ol_ ^ 16); lt += shi(lt, ol_ ^ 32);
        const float inv = 1.0f / lt;
#pragma unroll
        for (int db = 0; db < 4; ++db) { v2u o; o.x = pk2(oacc[rb][db][0] * inv, oacc[rb][db][1] * inv); o.y = pk2(oacc[rb][db][2] * inv, oacc[rb][db][3] * inv);
            *(v2u*)(bo + (qrow0 + half * 64 + rb * 16 + lr) * LBO + (hk * 4 + g) * 64 + db * 16 + lg * 4) = o; }
    }
    __syncthreads();
}

__device__ __forceinline__ void conv_unit(Ctx& c, int l, int u) {
    TLW;
    const __attribute__((address_space(4))) Params& p = *c.p;
    LAS bf16* Zs = (LAS bf16*)c.lds;
    const int r0 = u * 64;
    const int seq_lo = r0 < ML ? (r0 / SEQ) * SEQ : ML + ((r0 - ML) / CTXL) * CTXL, seq_hi = seq_lo + (r0 < ML ? SEQ : CTXL);
    for (int it = tid_; it < 94 * 64; it += 512) {
        const int zr = it >> 6, cg8 = (it & 63) * 8; const int g = r0 - 15 + zr;
        v4u o = zero4u();
        if (g >= seq_lo && g < seq_hi) o = *(const v4u*)(((bf16*)(c.ws + WS_P1)) + (size_t)g * LP + C_GLU + cg8);
        *(LAS v4u*)(Zs + zr * 520 + cg8) = o;
    }
    __syncthreads();
    const int c0 = lane_ * 8, t0 = wave_ * 8;
    const float* wdw = p.in[I_WDW] + (size_t)l * 31 * 512 + c0;
    float acc[8][8];
    { const f32x4 b0 = *(const f32x4*)(p.in[I_BDW] + l * 512 + c0), b1 = *(const f32x4*)(p.in[I_BDW] + l * 512 + c0 + 4);
#pragma unroll
      for (int t = 0; t < 8; ++t) { acc[t][0] = b0.x; acc[t][1] = b0.y; acc[t][2] = b0.z; acc[t][3] = b0.w; acc[t][4] = b1.x; acc[t][5] = b1.y; acc[t][6] = b1.z; acc[t][7] = b1.w; } }
    float zw[8][8];
#pragma unroll
    for (int t = 0; t < 7; ++t) unpack8(*(const LAS v4u*)(Zs + (t0 + t) * 520 + c0), zw[t]);
    f32x4 wa = *(const f32x4*)(wdw), wb = *(const f32x4*)(wdw + 4);
#pragma unroll 1
    for (int j0 = 0; j0 < 32; j0 += 8) {
#pragma unroll
        for (int jj = 0; jj < 8; ++jj) {
            const int j = j0 + jj;
            if (j <= 30) {
                unpack8(*(const LAS v4u*)(Zs + (t0 + j + 7) * 520 + c0), zw[(jj + 7) & 7]);
                const float wv[8] = {wa.x, wa.y, wa.z, wa.w, wb.x, wb.y, wb.z, wb.w};
                if (j < 30) { wa = *(const f32x4*)(wdw + (j + 1) * 512); wb = *(const f32x4*)(wdw + (j + 1) * 512 + 4); }
#pragma unroll
                for (int t = 0; t < 8; ++t)
#pragma unroll
                    for (int i = 0; i < 8; ++i) acc[t][i] += wv[i] * zw[(jj + t) & 7][i];
            }
        }
    }
    const f32x4 g0 = *(const f32x4*)(p.in[I_GCLN] + l * 512 + c0), g1 = *(const f32x4*)(p.in[I_GCLN] + l * 512 + c0 + 4);
    const f32x4 e0 = *(const f32x4*)(p.in[I_BCLN] + l * 512 + c0), e1 = *(const f32x4*)(p.in[I_BCLN] + l * 512 + c0 + 4);
    const float gg[8] = {g0.x, g0.y, g0.z, g0.w, g1.x, g1.y, g1.z, g1.w}, ee[8] = {e0.x, e0.y, e0.z, e0.w, e1.x, e1.y, e1.z, e1.w};
    float sm[8], sq[8];
#pragma unroll
    for (int t = 0; t < 8; ++t) { float s = 0.f;
#pragma unroll
        for (int i = 0; i < 8; ++i) s += acc[t][i];
        sm[t] = s; }
    wave_sum8(sm);
#pragma unroll
    for (int t = 0; t < 8; ++t) { const float mean = sm[t] * (1.0f / 512.0f); float q = 0.f;
#pragma unroll
        for (int i = 0; i < 8; ++i) { acc[t][i] -= mean; q += acc[t][i] * acc[t][i]; }
        sq[t] = q; }
    wave_sum8(sq);
#pragma unroll
    for (int t = 0; t < 8; ++t) {
        const float rstd = rsqrtf(sq[t] * (1.0f / 512.0f) + EPS);
        float y[8];
#pragma unroll
        for (int i = 0; i < 8; ++i) { const float v = acc[t][i] * rstd * gg[i] + ee[i]; y[i] = siluf_(v); }
        *(v4u*)(((bf16*)(c.ws + WS_BO)) + (size_t)(r0 + t0 + t) * LBO + 512 + c0) = pack8(y);
    }
    __syncthreads();
}

__device__ __forceinline__ void qk_conv8(const bf16* p1, const float* wmc, int row, int seq_lo, int seq_hi, int col, float scale, float (&o)[8]) {
    float xm[8], x0[8], xp[8];
    const bool hm = row - 1 >= seq_lo, hp = row + 1 < seq_hi;
    const v4u r0_ = *(const v4u*)(p1 + (size_t)row * LP + C_QKM + col), rm_ = *(const v4u*)(p1 + (size_t)(hm ? row - 1 : row) * LP + C_QKM + col), rp_ = *(const v4u*)(p1 + (size_t)(hp ? row + 1 : row) * LP + C_QKM + col);
    unpack8(r0_, x0); unpack8(rm_, xm); unpack8(rp_, xp);
#pragma unroll
    for (int i = 0; i < 8; ++i) { xm[i] = hm ? xm[i] : 0.f; xp[i] = hp ? xp[i] : 0.f; }
    const f32x4 wa0 = *(const f32x4*)(wmc + col), wa1 = *(const f32x4*)(wmc + col + 4), wb0 = *(const f32x4*)(wmc + 1024 + col), wb1 = *(const f32x4*)(wmc + 1024 + col + 4), wc0 = *(const f32x4*)(wmc + 2048 + col), wc1 = *(const f32x4*)(wmc + 2048 + col + 4);
    const float wa[8] = {wa0.x, wa0.y, wa0.z, wa0.w, wa1.x, wa1.y, wa1.z, wa1.w}, wb[8] = {wb0.x, wb0.y, wb0.z, wb0.w, wb1.x, wb1.y, wb1.z, wb1.w}, wc[8] = {wc0.x, wc0.y, wc0.z, wc0.w, wc1.x, wc1.y, wc1.z, wc1.w};
#pragma unroll
    for (int i = 0; i < 8; ++i) { const float v = wa[i] * xm[i] + wb[i] * x0[i] + wc[i] * xp[i]; o[i] = siluf_(v) * scale; }
}
__device__ __forceinline__ void chunk_rows(int b, int jc, int& r0, int& seq_lo, int& seq_hi) {
    if (jc < 4) { seq_lo = ML + b * CTXL; seq_hi = seq_lo + CTXL; r0 = seq_lo + jc * 64; } else { seq_lo = b * SEQ; seq_hi = seq_lo + SEQ; r0 = seq_lo + (jc - 4) * 64; }
}
__device__ __forceinline__ void m1_unit(Ctx& c, int l, int b, int h, int jc) {
    TLW;
    const __attribute__((address_space(4))) Params& p = *c.p;
    LAS bf16* Vt = (LAS bf16*)c.lds;
    LAS bf16* Kt = (LAS bf16*)(c.lds + 18432);
    LAS float* wts = (LAS float*)(c.lds + 36864);
    const int tid = tid_, lane = lane_, w = wave_, lr = lane & 15, lg = lane >> 4;
    const bf16* p1 = ((bf16*)(c.ws + WS_P1));
    int r0, seq_lo, seq_hi; chunk_rows(b, jc, r0, seq_lo, seq_hi);
    const int chf = (b * 4 + h) * 2, chb = chf + 1, pf = jc, pb = jc < 4 ? 3 - jc : 71 - jc;
    if (w == 0) {
        const bf16* gp = p1 + (size_t)(r0 + lane) * LP + C_GM + h; const float* bm = p.in[I_BMG] + l * 16 + h;
        const float i_f = bf2f(gp[0]) + bm[0], i_b = bf2f(gp[4]) + bm[4], lf_f = logsigf_(bf2f(gp[8]) + bm[8]), lf_b = logsigf_(bf2f(gp[12]) + bm[12]);
        const float cf = scan_add(lf_f, lane), cb = scan_add(lf_b, lane);
        const float bend_f = shi(cf, 63), bend_b = shi(cb, 63);
        const float g_f = bend_f - cf + i_f, g_b = (cb - lf_b) + i_b;
        const float mu_f = wave_max(g_f), mu_b = wave_max(g_b);
        wts[lane] = __expf(g_f - mu_f); wts[64 + lane] = __expf(g_b - mu_b);
        if (lane == 0) { float* be = ((float*)(c.ws + WS_BEND)); float* mu = ((float*)(c.ws + WS_MU)); be[chf * NCHUNK + pf] = bend_f; mu[chf * NCHUNK + pf] = mu_f; be[chb * NCHUNK + pb] = bend_b; mu[chb * NCHUNK + pb] = mu_b; }
    } else {
        const float* wmc = p.in[I_WMCONV] + (size_t)l * 3 * 1024;
#pragma unroll
        for (int k_ = 0; k_ < 3; ++k_) { const int it0 = tid - 64 + k_ * 448; const bool ok = it0 < 1024; const int it = ok ? it0 : 1023;
            const int W = it >> 6, ln = it & 63, cg8 = ((ln >> 4) + 4 * (W & 3)) * 8, s = (ln & 15) + 16 * (W >> 2);
            const v4u vv = *(const v4u*)(p1 + (size_t)(r0 + s) * LP + C_VM + h * 128 + cg8);
            float k[8]; qk_conv8(p1, wmc, r0 + s, seq_lo, seq_hi, 512 + h * 128 + cg8, 0.08838834764831845f, k);
            if (!ok) continue;
            LAS bf16* d = Vt + cg8 * 72 + s;
            d[0] = (bf16)(vv.x & 0xffffu); d[72] = (bf16)(vv.x >> 16); d[144] = (bf16)(vv.y & 0xffffu); d[216] = (bf16)(vv.y >> 16);
            d[288] = (bf16)(vv.z & 0xffffu); d[360] = (bf16)(vv.z >> 16); d[432] = (bf16)(vv.w & 0xffffu); d[504] = (bf16)(vv.w >> 16);
            const v4u kk = pack8(k); LAS bf16* e = Kt + cg8 * 72 + s;
            e[0] = (bf16)(kk.x & 0xffffu); e[72] = (bf16)(kk.x >> 16); e[144] = (bf16)(kk.y & 0xffffu); e[216] = (bf16)(kk.y >> 16);
            e[288] = (bf16)(kk.z & 0xffffu); e[360] = (bf16)(kk.z >> 16); e[432] = (bf16)(kk.w & 0xffffu); e[504] = (bf16)(kk.w >> 16);
        }
    }
    __syncthreads();
    bf16x8 vaf[2], vab[2];
#pragma unroll
    for (int ks = 0; ks < 2; ++ks) {
        float vf[8]; unpack8(*(const LAS v4u*)(Vt + (16 * w + lr) * 72 + ks * 32 + lg * 8), vf);
        const f32x4 f0 = *(const LAS f32x4*)(wts + ks * 32 + lg * 8), f1 = *(const LAS f32x4*)(wts + ks * 32 + lg * 8 + 4), b0 = *(const LAS f32x4*)(wts + 64 + ks * 32 + lg * 8), b1 = *(const LAS f32x4*)(wts + 64 + ks * 32 + lg * 8 + 4);
        const float xf[8] = {vf[0] * f0.x, vf[1] * f0.y, vf[2] * f0.z, vf[3] * f0.w, vf[4] * f1.x, vf[5] * f1.y, vf[6] * f1.z, vf[7] * f1.w};
        const float xb[8] = {vf[0] * b0.x, vf[1] * b0.y, vf[2] * b0.z, vf[3] * b0.w, vf[4] * b1.x, vf[5] * b1.y, vf[6] * b1.z, vf[7] * b1.w};
        vaf[ks] = __builtin_bit_cast(bf16x8, pack8(xf)); vab[ks] = __builtin_bit_cast(bf16x8, pack8(xb));
    }
    bf16* stf = ((bf16*)(c.ws + WS_ST)) + ((size_t)chf * NCHUNK + pf) * 16384; bf16* stb = ((bf16*)(c.ws + WS_ST)) + ((size_t)chb * NCHUNK + pb) * 16384;
#pragma unroll
    for (int m = 0; m < 4; ++m) {
        f32x4 af[2], ab[2];
#pragma unroll
        for (int hh = 0; hh < 2; ++hh) { af[hh] = zero4(); ab[hh] = zero4();
            const int dkrow = 32 * m + 8 * (lr >> 2) + 4 * hh + (lr & 3);
#pragma unroll
            for (int ks = 0; ks < 2; ++ks) { const bf16x8 kb = *(const LAS bf16x8*)(Kt + dkrow * 72 + ks * 32 + lg * 8); af[hh] = MFMA16(kb, vaf[ks], af[hh]); ab[hh] = MFMA16(kb, vab[ks], ab[hh]); } }
        const float rf[8] = {af[0][0], af[0][1], af[0][2], af[0][3], af[1][0], af[1][1], af[1][2], af[1][3]}, rbk[8] = {ab[0][0], ab[0][1], ab[0][2], ab[0][3], ab[1][0], ab[1][1], ab[1][2], ab[1][3]};
        *(v4u*)(stf + (16 * w + lr) * 128 + 32 * m + 8 * lg) = pack8(rf); *(v4u*)(stb + (16 * w + lr) * 128 + 32 * m + 8 * lg) = pack8(rbk);
    }
    if (tid < 256) { const int dir = tid >> 7, dk = tid & 127; const LAS bf16* Kd = Kt + dk * 72; const LAS float* wd = wts + dir * 64; float sm = 0.f;
#pragma unroll 8
        for (int i = 0; i < 64; ++i) sm += bf2f(Kd[i]) * wd[i];
        ((float*)(c.ws + WS_NS))[((size_t)(dir ? chb : chf) * NCHUNK + (dir ? pb : pf)) * 128 + dk] = sm; }
    __syncthreads();
}
__device__ __forceinline__ void phase_m2(Ctx& c) {
    TLW;
    for (int gid = c.bid * 512 + tid_; gid < 32 * 4096; gid += c.nblk * 512) {
        const int ch = gid >> 12, e4 = gid & 4095;
        v2u* sp = (v2u*)(((bf16*)(c.ws + WS_ST)) + (size_t)ch * NCHUNK * 16384) + e4;
        f32x4* np = (f32x4*)(((float*)(c.ws + WS_NS)) + (size_t)ch * NCHUNK * 128) + (e4 & 31);
        const float* be = ((float*)(c.ws + WS_BEND)) + ch * NCHUNK; const float* mu = ((float*)(c.ws + WS_MU)) + ch * NCHUNK; float* ms = ((float*)(c.ws + WS_MS)) + ch * NCHUNK;
        const bool do_n = e4 < 32;
        float m = -1.0e30f; f32x4 cs = zero4(), nsv = zero4();
#pragma unroll 1
        for (int q0 = 0; q0 < NCHUNK - 1; q0 += 16) {
            v2u uv[16]; float bq[16], mq[16]; f32x4 nv[16];
#pragma unroll
            for (int i = 0; i < 16; ++i) if (q0 + i < NCHUNK - 1) { uv[i] = sp[(size_t)(q0 + i) * 4096]; bq[i] = be[q0 + i]; mq[i] = mu[q0 + i]; if (do_n) nv[i] = np[(q0 + i) * 32]; }
#pragma unroll
            for (int i = 0; i < 16; ++i) if (q0 + i < NCHUNK - 1) {
                const float mn = fmaxf(bq[i] + m, mq[i]), dec = __expf(bq[i] + m - mn), sc = __expf(mq[i] - mn);
                cs.x = dec * cs.x + sc * bf2f(uv[i].x & 0xffffu); cs.y = dec * cs.y + sc * bf2f(uv[i].x >> 16); cs.z = dec * cs.z + sc * bf2f(uv[i].y & 0xffffu); cs.w = dec * cs.w + sc * bf2f(uv[i].y >> 16);
                v2u o; o.x = pk2(cs.x, cs.y); o.y = pk2(cs.z, cs.w); sp[(size_t)(q0 + i) * 4096] = o;
                if (do_n) { nsv = nsv * dec + nv[i] * sc; np[(q0 + i) * 32] = nsv; }
                if (e4 == 0) ms[q0 + i] = mn;
                m = mn;
            }
        }
    }
}
__device__ __forceinline__ void m3_unit(Ctx& c, int l, int b, int h, int jc) {
    TLW;
    const __attribute__((address_space(4))) Params& p = *c.p;
    LAS bf16* Qs = (LAS bf16*)c.lds;
    LAS bf16* Ks = (LAS bf16*)(c.lds + 17408);
    LAS bf16* Vt = (LAS bf16*)(c.lds + 34816);
    LAS bf16* Cs = (LAS bf16*)(c.lds + 53248);
    LAS float* HB = (LAS float*)(c.lds + 53248);
    LAS bf16* Ps = (LAS bf16*)(c.lds + 122880) + wave_ * (16 * 72);
    LAS float* sca = (LAS float*)(c.lds + 141312);
    LAS float* nin = (LAS float*)(c.lds + 143360);
    const int tid = tid_, lane = lane_, w = wave_, lr = lane & 15, lg = lane >> 4;
    int r0, seq_lo, seq_hi; chunk_rows(b, jc, r0, seq_lo, seq_hi);
    const int chf = (b * 4 + h) * 2, chb = chf + 1, pf = jc, pb = jc < 4 ? 3 - jc : 71 - jc;
    if (w < 2) {
        const int dir = w, ch = dir ? chb : chf, pp = dir ? pb : pf;
        const bf16* gp = ((bf16*)(c.ws + WS_P1)) + (size_t)(r0 + lane) * LP + C_GM + h + 4 * dir; const float* bm = p.in[I_BMG] + l * 16 + h + 4 * dir;
        const float ig = bf2f(gp[0]) + bm[0], lf = logsigf_(bf2f(gp[8]) + bm[8]);
        const float m_in = pp > 0 ? ((float*)(c.ws + WS_MS))[ch * NCHUNK + pp - 1] : -1.0e30f;
        const int sl = dir ? 63 - lane : lane;
        const float lfp = shi(lf, sl), igp = shi(ig, sl);
        const float bcum = scan_add(lfp, lane);
        const float beta = igp - bcum;
        const float pmx = scan_max(beta, lane);
        const float a_t = bcum + m_in, mt = fmaxf(a_t, bcum + pmx);
        const float alpha = bcum - mt, wint = __expf(a_t - mt), emt = __expf(-mt);
        LAS float* s = sca + dir * 256;
        s[sl] = alpha; s[64 + sl] = beta; s[128 + sl] = wint; s[192 + sl] = emt;
    }
    if (w >= 2) {
        const float* wmc = p.in[I_WMCONV] + (size_t)l * 3 * 1024;
        const bf16* p1 = ((bf16*)(c.ws + WS_P1));
#pragma unroll
        for (int k_ = 0; k_ < 6; ++k_) { const int it0 = tid - 128 + k_ * 384; const bool ok = it0 < 2048; const int it = ok ? it0 : 2047;
            const int isk = it >> 10, s = (it >> 4) & 63, cg8 = (it & 15) * 8;
            float o[8]; qk_conv8(p1, wmc, r0 + s, seq_lo, seq_hi, isk * 512 + h * 128 + cg8, isk ? 0.08838834764831845f : 1.0f, o);
            if (ok) *(LAS v4u*)((isk ? Ks : Qs) + s * 136 + cg8) = pack8(o);
        }
#pragma unroll
        for (int k_ = 0; k_ < 3; ++k_) { const int it0 = tid - 128 + k_ * 384; const bool ok = it0 < 1024; const int it = ok ? it0 : 1023;
            const int W = it >> 6, ln = it & 63, cg8 = ((ln >> 4) + 4 * (W & 3)) * 8, s = (ln & 15) + 16 * (W >> 2);
            const v4u vv = *(const v4u*)(p1 + (size_t)(r0 + s) * LP + C_VM + h * 128 + cg8);
            if (!ok) continue;
            LAS bf16* d = Vt + cg8 * 72 + s;
            d[0] = (bf16)(vv.x & 0xffffu); d[72] = (bf16)(vv.x >> 16); d[144] = (bf16)(vv.y & 0xffffu); d[216] = (bf16)(vv.y >> 16);
            d[288] = (bf16)(vv.z & 0xffffu); d[360] = (bf16)(vv.z >> 16); d[432] = (bf16)(vv.w & 0xffffu); d[504] = (bf16)(vv.w >> 16);
        }
#pragma unroll
        for (int dir = 0; dir < 2; ++dir) {
            const int ch = dir ? chb : chf, pp = dir ? pb : pf;
            const v4u* src = (const v4u*)(((bf16*)(c.ws + WS_ST)) + ((size_t)ch * NCHUNK + (pp > 0 ? pp - 1 : 0)) * 16384);
#pragma unroll
            for (int k_ = 0; k_ < 6; ++k_) { const int it0 = tid - 128 + k_ * 384; const bool ok = it0 < 2048; const int it = ok ? it0 : 2047; const int dv = it >> 4, ck = (it & 15) * 8; v4u v = src[it]; if (pp <= 0) v = zero4u();
                if (ok) *(LAS v4u*)(Cs + dir * (128 * 136) + dv * 136 + ck) = v; }
        }
        if (tid - 128 < 256) { const int q = tid - 128, dir = q >> 7, k = q & 127, ch = dir ? chb : chf, pp = dir ? pb : pf; nin[q] = pp > 0 ? ((float*)(c.ws + WS_NS))[((size_t)ch * NCHUNK + pp - 1) * 128 + k] : 0.f; }
    }
    __syncthreads();
    const int dir = w >> 2, rb = w & 3;
    const LAS float* sd = sca + dir * 256;
    const int t = 16 * rb + lr;
    const float al = sd[t], wi = sd[128 + t], em = sd[192 + t];
    bf16x8 qa[4];
#pragma unroll
    for (int ks = 0; ks < 4; ++ks) qa[ks] = *(const LAS bf16x8*)(Qs + t * 136 + ks * 32 + lg * 8);
    f32x4 st[4]; float rs = 0.f;
#pragma unroll
    for (int nb = 0; nb < 4; ++nb) { f32x4 a = zero4();
#pragma unroll
        for (int ks = 0; ks < 4; ++ks) { const bf16x8 kb = *(const LAS bf16x8*)(Ks + (nb * 16 + lr) * 136 + ks * 32 + lg * 8); a = MFMA16(kb, qa[ks], a); }
        const f32x4 be = *(const LAS f32x4*)(sd + 64 + nb * 16 + lg * 4);
#pragma unroll
        for (int j = 0; j < 4; ++j) { const int s_ = nb * 16 + lg * 4 + j; const bool valid = dir ? (s_ >= t) : (s_ <= t);
            const float pv = valid ? a[j] * __expf(al + be[j]) : 0.f; rs += pv; a[j] = pv; }
        st[nb] = a; }
    bf16x8 pfr[2];
#pragma unroll
    for (int ks = 0; ks < 2; ++ks) pfr[ks] = __builtin_bit_cast(bf16x8, (v4u){pk2(st[2 * ks][0], st[2 * ks][1]), pk2(st[2 * ks][2], st[2 * ks][3]), pk2(st[2 * ks + 1][0], st[2 * ks + 1][1]), pk2(st[2 * ks + 1][2], st[2 * ks + 1][3])});
    f32x4 oacc[8];
#pragma unroll
    for (int db = 0; db < 8; ++db) { f32x4 a = zero4();
#pragma unroll
        for (int ks = 0; ks < 4; ++ks) { const bf16x8 cb = *(const LAS bf16x8*)(Cs + dir * (128 * 136) + (db * 16 + lr) * 136 + ks * 32 + lg * 8); a = MFMA16(cb, qa[ks], a); }
        a = a * wi;
#pragma unroll
        for (int ks = 0; ks < 2; ++ks) { const v2u a0 = *(const LAS v2u*)(Vt + (db * 16 + lr) * 72 + ks * 32 + lg * 4), a1 = *(const LAS v2u*)(Vt + (db * 16 + lr) * 72 + ks * 32 + 16 + lg * 4);
            a = MFMA16(__builtin_bit_cast(bf16x8, (v4u){a0.x, a0.y, a1.x, a1.y}), pfr[ks], a); }
        oacc[db] = a; }
    float qn = 0.f;
    { const LAS bf16* qr = Qs + t * 136 + lg * 32; const LAS float* nn = nin + dir * 128 + lg * 32;
#pragma unroll
      for (int k8 = 0; k8 < 4; ++k8) { float qf[8]; unpack8(*(const LAS v4u*)(qr + k8 * 8), qf);
#pragma unroll
          for (int i = 0; i < 8; ++i) qn += qf[i] * nn[k8 * 8 + i]; } }
    { const int ol = olane(); const float q1 = shi(qn, ol ^ 16), r1 = shi(rs, ol ^ 16); qn += q1; rs += r1; const float q2 = shi(qn, ol ^ 32), r2 = shi(rs, ol ^ 32); qn += q2; rs += r2; }
    const float inv = 1.0f / fmaxf(fabsf(wi * qn + rs), em);
    __syncthreads();
#pragma unroll
    for (int db = 0; db < 8; ++db) *(LAS f32x4*)(HB + dir * (64 * 132) + t * 132 + db * 16 + lg * 4) = oacc[db] * inv;
    __syncthreads();
    const float g0 = p.in[I_GMN][l * 512 + h * 128 + 2 * lane], g1 = p.in[I_GMN][l * 512 + h * 128 + 2 * lane + 1];
    float v0[8], v1[8], sm[8], sq[8];
#pragma unroll
    for (int tt = 0; tt < 8; ++tt) {
        const int t = 8 * w + tt;
        const unsigned ov = *(const unsigned*)(((bf16*)(c.ws + WS_P1)) + (size_t)(r0 + t) * LP + C_OM + h * 128 + 2 * lane);
        float a0 = HB[t * 132 + 2 * lane] + HB[64 * 132 + t * 132 + 2 * lane], a1 = HB[t * 132 + 2 * lane + 1] + HB[64 * 132 + t * 132 + 2 * lane + 1];
        a0 *= sigmoidf_(bf2f(ov & 0xffffu)); a1 *= sigmoidf_(bf2f(ov >> 16));
        v0[tt] = a0; v1[tt] = a1; sm[tt] = a0 + a1;
    }
    wave_sum8(sm);
#pragma unroll
    for (int tt = 0; tt < 8; ++tt) { const float mean = sm[tt] * (1.0f / 128.0f); v0[tt] -= mean; v1[tt] -= mean; sq[tt] = v0[tt] * v0[tt] + v1[tt] * v1[tt]; }
    wave_sum8(sq);
#pragma unroll
    for (int tt = 0; tt < 8; ++tt) { const float rstd = rsqrtf(sq[tt] * (1.0f / 128.0f) + EPS);
        *(unsigned*)(((bf16*)(c.ws + WS_BO)) + (size_t)(r0 + 8 * w + tt) * LBO + 1024 + h * 128 + 2 * lane) = pk2(v0[tt] * rstd * g0, v1[tt] * rstd * g1); }
    __syncthreads();
}


#ifdef DBGSCAN
__device__ __forceinline__ void scan16(Ctx& c, const bf16* p, size_t rows, int cols, int ld, int code) {
    TLW;
    const int c8 = cols / 8; const size_t n = rows * c8; bool bad = false;
    for (size_t i = (size_t)c.bid * 512 + tid_; i < n; i += (size_t)c.nblk * 512) { const size_t r = i / c8; const int cc = (int)(i % c8) * 8; const v4u v = *(const v4u*)(p + r * ld + cc);
        bad |= ((v.x & 0x7FFFu) > 0x4680u) | (((v.x >> 16) & 0x7FFFu) > 0x4680u) | ((v.y & 0x7FFFu) > 0x4680u) | (((v.y >> 16) & 0x7FFFu) > 0x4680u) | ((v.z & 0x7FFFu) > 0x4680u) | (((v.z >> 16) & 0x7FFFu) > 0x4680u) | ((v.w & 0x7FFFu) > 0x4680u) | (((v.w >> 16) & 0x7FFFu) > 0x4680u); }
    if (bad) atomicMin((int*)(c.ws + WS_DBG), code);
}
__device__ __forceinline__ void scan32(Ctx& c, const float* p, size_t n, int code) {
    TLW;
    bool bad = false;
    for (size_t i = (size_t)c.bid * 512 + tid_; i < n; i += (size_t)c.nblk * 512) { bad |= !(fabsf(p[i]) < 16384.0f); }
    if (bad) atomicMin((int*)(c.ws + WS_DBG), code);
}
__device__ __forceinline__ void dbg_scan(Ctx& c, int ph) {
    TLW;
    if (ph == 0) { if (c.bid == 0 && tid_ == 0) *(int*)(c.ws + WS_DBG) = 0x7fffffff; return; }
    if (ph >= NPHASE - 1) return;
    const int sp = (ph - 1) % 10, code = ph > 11 ? 56 + ph : 20 + ph * 4;
    if (sp == 0) { scan16(c, ((bf16*)(c.ws + WS_BO)), MT, 1024, 1024, code); scan16(c, ((bf16*)(c.ws + WS_WIN)), 7168, 1024, 1024, code + 1); scan16(c, ((bf16*)(c.ws + WS_WP)), 3072, 512, 512, code + 1);
        scan16(c, ((bf16*)(c.ws + WS_WO3)), 1024, 3072, 3072, code + 1); scan16(c, ((bf16*)(c.ws + WS_WGU)), 5632, 1024, 1024, code + 1); scan16(c, ((bf16*)(c.ws + WS_WD)), 1024, 2816, 2816, code + 1);
        scan32(c, (const float*)(c.ws + WS_MOD), 4 * 5 * 6144, code + 2); scan32(c, c.xl, (size_t)ML * DM, code + 3); scan32(c, (const float*)(c.ws + WS_XC), (size_t)MC * DM, code + 3); }
    else if (sp == 1) { scan16(c, ((bf16*)(c.ws + WS_P1)), MT, 4096, 4096, code); scan16(c, ((bf16*)(c.ws + WS_G)), MT, 3072, 3072, code + 1); }
    else if (sp == 2) { scan16(c, ((bf16*)(c.ws + WS_BO)), MT, 512, 1536, code); scan16(c, ((bf16*)(c.ws + WS_BO)) + 512, MT, 512, 1536, code + 1); scan16(c, ((bf16*)(c.ws + WS_ST)), 32 * 68 * 128, 128, 128, code + 2);
        scan32(c, (const float*)(c.ws + WS_NS), 32 * 68 * 128, code + 3); scan32(c, (const float*)(c.ws + WS_BEND), 32 * 68, code + 3); scan32(c, (const float*)(c.ws + WS_MU), 32 * 68, code + 3); }
    else if (sp == 3) { for (int ch = 0; ch < 32; ++ch) { scan16(c, ((bf16*)(c.ws + WS_ST)) + (size_t)ch * 68 * 16384, 67 * 128, 128, 128, code); scan32(c, (const float*)(c.ws + WS_NS) + ch * 68 * 128, 67 * 128, code + 1); scan32(c, (const float*)(c.ws + WS_MS) + ch * 68, 67, code + 2); } }
    else if (sp == 4) scan16(c, ((bf16*)(c.ws + WS_BO)) + 1024, MT, 512, 1536, code);
    else if (sp == 5) scan16(c, ((bf16*)(c.ws + WS_G)), MT, 3072, 3072, code);
    else if (sp == 6 || sp == 9) { scan32(c, c.xl, (size_t)ML * DM, code); scan32(c, (const float*)(c.ws + WS_XC), (size_t)MC * DM, code + 1); }
    else if (sp == 7) scan16(c, ((bf16*)(c.ws + WS_BO)), MT, 1024, 1024, code);
    else if (sp == 8) scan16(c, ((bf16*)(c.ws + WS_P1)), MT, 2816, 2816, code);
}
#endif
template <class Epi, class Sched = pg8::StaticOrder>
__device__ __forceinline__ void run_gemm(Ctx& c, const bf16* A, int lda, int mode, const bf16* Bt, int ldb, int M, int N, int K, const Epi& E) {
    pg8::Gemm g{A, Bt, M, N, K, lda, ldb, mode}; Sched S; S.init(M, N, c.nblk, c.bid);
    pg8::gemm_phase<Epi, Sched, true, true>(c.lds, g, S, E);
}

__global__ void __launch_bounds__(512, 2) mk_fwd(Params prm) {
    extern __shared__ __attribute__((aligned(16))) uchar lds_raw[];
    cg::grid_group grid = cg::this_grid();
    Ctx c; c.p = (const __attribute__((address_space(4))) Params*)__builtin_amdgcn_kernarg_segment_ptr(); c.lds = (LAS uchar*)lds_raw; c.bid = blockIdx.x; c.nblk = gridDim.x;
    { LAS unsigned* misc = (LAS unsigned*)(c.lds + MISC_OFF); if (threadIdx.x < 4) misc[threadIdx.x] = 0u; }
    __syncthreads();
    const XcdBarrier xbar = xcd_barrier_post((unsigned*)(prm.ws + WS_BAR), (volatile LAS unsigned*)(c.lds + MISC_OFF));
    for (int ph = prm.ph_lo; ph < prm.ph_hi; ++ph) {
        { const __attribute__((address_space(4))) Params* pp_ = (const __attribute__((address_space(4))) Params*)__builtin_amdgcn_kernarg_segment_ptr(); asm volatile("" : "+s"(pp_)); c.p = pp_; }
        { uchar* w_ = prm.ws; asm volatile("" : "+s"(w_)); c.ws = w_; float* x_ = prm.out; asm volatile("" : "+s"(x_)); c.xl = x_; }
        if (ph == 0) {
#ifndef NO_INIT
 phase_init(c);
#endif
 }
        else if (ph == NPHASE - 1) phase_final(c);
        else {
            const int l = (ph - 1) / 10, sp = (ph - 1) % 10; const bool wctx = l < DEPTH - 1; const int Mx = wctx ? MT : ML;
            if (sp == 0) {
#ifndef NO_CONV
 convert_weights(c, l);
#endif
 phase_norm(c, l, 0, MT, l > 0 ? (const float*)(c.ws + WS_G) : nullptr, 11, ((float*)(c.ws + WS_MOD)) + (size_t)(l > 0 ? l - 1 : 0) * 5 * 6144 + 4 * 6144 + 5120, l == 0 ? c.p->in[I_X] : nullptr); }
            else if (sp == 1) { EpiP1G E{((bf16*)(c.ws + WS_P1)), ((bf16*)(c.ws + WS_G))}; run_gemm(c, ((bf16*)(c.ws + WS_BO)), DM, 0, ((bf16*)(c.ws + WS_WIN)), DM, MT, NINP, DM, E); }
            else if (sp == 2) {
                const int n_att = 256 + (wctx ? 16 : 0), n_m1 = 16 * NCHUNK, n_conv = Mx / 64;
                if (c.nblk == 256 && wctx) {
                    const int w_ = c.bid;
                    attn_unit4(c, l, w_ >> 6, (w_ >> 5) & 1, w_ & 31, false);
                    if (w_ < 16) attn_unit4(c, l, w_ >> 2, (w_ >> 1) & 1, w_ & 1, true);
                    conv_unit(c, l, w_);
                    if (w_ >= 16 && w_ < 32) conv_unit(c, l, 256 + (w_ - 16));
                    if (w_ < 32) { for (int m = w_; m < 64; m += 32) m1_unit(c, l, m / (4 * NCHUNK), (m / NCHUNK) & 3, m % NCHUNK); }
                    else { for (int m = 64 + (w_ - 32); m < n_m1; m += 224) m1_unit(c, l, m / (4 * NCHUNK), (m / NCHUNK) & 3, m % NCHUNK); }
                } else
                for (int u = c.bid; u < n_att + n_m1 + n_conv; u += c.nblk) {
                    if (u < n_att) { if (u < 256) attn_unit4(c, l, u >> 6, (u >> 5) & 1, u & 31, false); else { const int q = u - 256; attn_unit4(c, l, q >> 2, (q >> 1) & 1, q & 1, true); } }
                    else if (u < n_att + n_m1) { const int m = u - n_att; m1_unit(c, l, m / (4 * NCHUNK), (m / NCHUNK) & 3, m % NCHUNK); }
                    else conv_unit(c, l, u - n_att - n_m1);
                }
            }
            else if (sp == 3) {
#ifndef NO_M2
 phase_m2(c);
#endif
 }
            else if (sp == 4) {
                const int jlo = wctx ? 0 : 4, per = NCHUNK - jlo;
                #ifndef NO_M3
 for (int u = c.bid; u < 16 * per; u += c.nblk) m3_unit(c, l, u / (4 * per), (u / per) & 3, jlo + u % per);
#endif

            }
            else if (sp == 5) {
                { EpiMerge E{((const bf16*)(c.ws + WS_G)), ((bf16*)(c.ws + WS_P1))}; run_gemm<EpiMerge, pg8::Merge3Order>(c, ((bf16*)(c.ws + WS_BO)), LBO, 2, ((bf16*)(c.ws + WS_WP)), 512, ML, DM, 512, E); }
                if (wctx) { EpiGateMul E{((bf16*)(c.ws + WS_G)) + (size_t)ML * NG}; run_gemm(c, ((bf16*)(c.ws + WS_BO)) + (size_t)ML * LBO, LBO, 1, ((bf16*)(c.ws + WS_WP)), 512, MC, NG, 512, E); }
            }
            else if (sp == 6) {
                { EpiResid E{c.xl, ((float*)(c.ws + WS_XC)), ((float*)(c.ws + WS_MOD)) + (size_t)l * 5 * 6144 + 2048, l == 0 ? c.p->in[I_X] : (const float*)c.xl}; run_gemm(c, ((bf16*)(c.ws + WS_P1)), DM, 0, ((bf16*)(c.ws + WS_WO3)), NG, ML, DM, DM, E); }
                if (wctx) { EpiPartial E{(float*)(c.ws + WS_P1 + 40 * MiB)}; run_gemm(c, ((bf16*)(c.ws + WS_G)) + (size_t)ML * NG, NG, 3, ((bf16*)(c.ws + WS_WO3)), NG, MC, DM * 12, 256, E); }
            }
            else if (sp == 7) phase_norm(c, l, 1, Mx, wctx ? (const float*)(c.ws + WS_P1 + 40 * MiB) : nullptr, 12, ((float*)(c.ws + WS_MOD)) + (size_t)l * 5 * 6144 + 4 * 6144 + 2048, nullptr);
            else if (sp == 8) { EpiSwiGLU E{((bf16*)(c.ws + WS_P1))}; run_gemm(c, ((bf16*)(c.ws + WS_BO)), DM, 0, ((bf16*)(c.ws + WS_WGU)), DM, Mx, 2 * DFF, DM, E); }
            else {
                { EpiResid E{c.xl, ((float*)(c.ws + WS_XC)), ((float*)(c.ws + WS_MOD)) + (size_t)l * 5 * 6144 + 5120, (const float*)c.xl}; run_gemm(c, ((bf16*)(c.ws + WS_P1)), DFF, 0, ((bf16*)(c.ws + WS_WD)), DFF, ML, DM, DFF, E); }
                if (wctx) { EpiPartial E{(float*)(c.ws + WS_G)}; run_gemm(c, ((bf16*)(c.ws + WS_P1)) + (size_t)ML * DFF, DFF, 3, ((bf16*)(c.ws + WS_WD)), DFF, MC, DM * 11, 256, E); }
            }
        }
        if (ph + 1 < prm.ph_hi) { asm volatile("s_waitcnt vmcnt(0) lgkmcnt(0)" ::: "memory"); __syncthreads(); if (ph == prm.ph_lo) grid.sync(); else { unsigned* bp_ = (unsigned*)(prm.ws + WS_BAR); asm volatile("" : "+s"(bp_)); XcdBarrier xb2; xb2.bar = bp_; xb2.x = xbar.x; xb2.st = (volatile LAS unsigned*)(c.lds + MISC_OFF); xcd_barrier(xb2); }
#ifdef PROBE_SYNC2
            grid.sync();
#endif
#ifdef DBGSCAN
            dbg_scan(c, ph); asm volatile("s_waitcnt vmcnt(0) lgkmcnt(0)" ::: "memory"); __syncthreads(); grid.sync();
#endif
        }
    }
}

extern "C" void kernel_launch(void* const* d_in, const int* in_sizes, int n_in, void* d_out, int out_size, void* d_ws, size_t ws_size, hipStream_t stream) {
    static int grid = 0;
    if (grid == 0) {
        if (n_in != 25 || ws_size < WS_END) { fprintf(stderr, "kernel_launch: unexpected n_in %d / ws_size %zu (need %zu)\n", n_in, ws_size, (size_t)WS_END); grid = -1; return; }
        int dev = 0, cus = 0, per_cu = 0;
        hipGetDevice(&dev); hipDeviceGetAttribute(&cus, hipDeviceAttributeMultiprocessorCount, dev);
        if (hipFuncSetAttribute((const void*)mk_fwd, hipFuncAttributeMaxDynamicSharedMemorySize, LDS_BYTES) != hipSuccess) { fprintf(stderr, "kernel_launch: hipFuncSetAttribute failed\n"); }
        if (hipOccupancyMaxActiveBlocksPerMultiprocessor(&per_cu, (const void*)mk_fwd, 512, LDS_BYTES) != hipSuccess || per_cu < 1) { fprintf(stderr, "kernel_launch: occupancy query says %d\n", per_cu); per_cu = 1; }
        (void)hipGetLastError();
        grid = cus * 1;
        fprintf(stderr, "kernel_launch: grid %d (cus %d, per_cu %d)\n", grid, cus, per_cu);
    }
    if (grid < 0) return;
    if (hipMemsetAsync((char*)d_ws + WS_BAR, 0, BAR_BYTES, stream) != hipSuccess) fprintf(stderr, "kernel_launch: memset failed\n");
    Params prm{};
    for (int i = 0; i < 25; ++i) prm.in[i] = (const float*)d_in[i];
    prm.out = (float*)d_out; prm.ws = (uchar*)d_ws;
#if defined(MK_MULTI)
    for (int ph = 0; ph < NPHASE; ++ph) { prm.ph_lo = ph; prm.ph_hi = ph + 1; hipLaunchKernelGGL(mk_fwd, dim3(grid), dim3(512), LDS_BYTES, stream, prm); }
#else
    prm.ph_lo = 0; prm.ph_hi = NPHASE;
    void* args[] = {&prm};
    hipError_t e = hipLaunchCooperativeKernel((const void*)mk_fwd, dim3(grid), dim3(512), args, LDS_BYTES, stream);
    if (e != hipSuccess) fprintf(stderr, "kernel_launch: cooperative launch failed: %s (grid %d)\n", hipGetErrorString(e), grid);
#endif
}
```

```cpp
#include <hip/hip_runtime.h>
#include <hip/hip_cooperative_groups.h>
#include <cstdio>
#include <cstdint>
namespace cg = cooperative_groups;
namespace pg8 {
#define PG8_LAS __attribute__((address_space(3)))
typedef unsigned short bf16_t;
typedef short bf16x8 __attribute__((ext_vector_type(8)));
typedef float f32x4 __attribute__((ext_vector_type(4)));
typedef unsigned u32x4 __attribute__((ext_vector_type(4)));
constexpr int BM = 256, BK = 64, HALF = 128, HTB = HALF * BK * 2  , STAGE_BYTES = 8 * HTB, NXCD = 8, WGM = 8;

__host__ __device__ __forceinline__ int lds_byte(int r, int c) { const int st = (r >> 4) * 2 + (c >> 5), rr = r & 15, cc = c & 31, ob = rr * 64 + cc * 2; return st * 1024 + (ob ^ (((ob >> 9) & 1) << 5)); }
__host__ __device__ __forceinline__ void stage_rc(int b, int& R, int& C) { const int st = b / 1024, sb = b % 1024, swz = sb ^ (((sb >> 9) & 1) << 5); R = (st >> 1) * 16 + swz / 64; C = (st & 1) * 32 + (swz % 64) / 2; }
__host__ __device__ __forceinline__ int perm32(int rho) { const int n = rho >> 4, i = rho & 15; return 8 * (i >> 2) + 4 * n + (i & 3); }

struct Unit { int pm, pn, z; };
struct Gemm { const bf16_t* A; const bf16_t* Bt; int M, N, K, lda, ldb, mode; };
__device__ __forceinline__ size_t op_aoff(const Gemm& g, const Unit& u, size_t tstepA) { size_t o = (size_t)u.pm * tstepA; if (g.mode == 1) o += (size_t)(u.pn >> 2) * 1024; else if (g.mode == 2) o += (size_t)u.z * 1024; else if (g.mode == 3) o += (size_t)(u.pn >> 2) * 512; return o; }
__device__ __forceinline__ size_t op_boff(const Gemm& g, const Unit& u, size_t tstepB) { if (g.mode == 2) return (size_t)(u.z * 4 + u.pn) * tstepB; if (g.mode == 3) return (size_t)(u.pn & 3) * tstepB + (size_t)(u.pn >> 2) * 512; return (size_t)u.pn * tstepB; }

struct StaticOrder {
    int nM, nN, nwg, G, c;
    __host__ __device__ void init(int M, int N, int G_, int c_) { nM = M / BM; nN = N / BM; nwg = nM * nN; G = G_; c = c_; }
    __host__ __device__ bool next(int i, Unit& u) const {
        const long L = (long)i * G + c; if (L >= nwg) return false;
        int wgid = (int)L; { const int q = nwg / NXCD, r = nwg % NXCD, xcd = wgid % NXCD, off = wgid / NXCD; wgid = (xcd < r ? xcd * (q + 1) : r * (q + 1) + (xcd - r) * q) + off; }
        const int nig = WGM * nN, gid = wgid / nig, fm = gid * WGM, gsz = (nM - fm) < WGM ? (nM - fm) : WGM;
        u.pm = fm + ((wgid % nig) % gsz); u.pn = (wgid % nig) / gsz; u.z = 0; return true;
    }
    __device__ __forceinline__ void a_ready(const Unit&) const {}
    __device__ __forceinline__ void done(const Unit&) const {}
};

struct Merge3Order { StaticOrder base;
    __device__ void init(int M, int N, int G_, int c_) { base.init(M, N, G_, c_); }
    __device__ bool next(int i, Unit& u) const { const int r = i / 3; if (!base.next(r, u)) return false; u.z = i - 3 * r; return true; }
    __device__ __forceinline__ void a_ready(const Unit&) const {}
    __device__ __forceinline__ void done(const Unit&) const {}
};
__device__ __forceinline__ unsigned cvt_pk_bf16(float lo, float hi) { unsigned r; asm volatile("v_cvt_pk_bf16_f32 %0, %1, %2" : "=v"(r) : "v"(lo), "v"(hi)); return r; }
typedef float f32x2 __attribute__((ext_vector_type(2)));
template <class Epi, class Sched, bool ALIGN_EPI = false, bool SP2 = false>
__device__ __forceinline__ void gemm_phase(PG8_LAS unsigned char* lds, const Gemm g, const Sched& S, const Epi& E) {
    int tid = threadIdx.x; asm volatile("" : "+v"(tid));
    const int wid = __builtin_amdgcn_readfirstlane(tid >> 6), lane = tid & 63, wr = wid >> 2, wc = wid & 3, fr = lane & 15, fq = lane >> 4;
    const int K = g.K, nt = K / BK;
    unsigned voffA[2], voffB[2];
#pragma unroll
    for (int i = 0; i < 2; ++i) { int R, C; stage_rc(tid * 16 + i * 8192, R, C); const int Rb = Epi::PERM ? ((R & ~31) + perm32(R & 31)) : R;
        voffA[i] = (unsigned)(R * g.lda + C) * 2u; voffB[i] = (unsigned)(Rb * g.ldb + C) * 2u; }
    const size_t kstep = (size_t)(BK * 2);
    const size_t hstepA = (size_t)HALF * g.lda * 2, hstepB = (size_t)HALF * g.ldb * 2;
    const size_t tstepA = 2 * hstepA, tstepB = 2 * hstepB;
    const unsigned ldsw = (unsigned)wid * 1024u;
    const int aoff = lds_byte(wr * 64 + fr, fq * 8), boff = lds_byte(wc * 32 + fr, fq * 8);
#define PG8_SA(b, h) (((b) * 2 + (h)) * HTB)
#define PG8_SB(b, h) ((4 + (b) * 2 + (h)) * HTB)
#define PG8_STAGE(bufoff, gbase, voff) do { _Pragma("unroll") for (int _i = 0; _i < 2; ++_i) \
        __builtin_amdgcn_global_load_lds((const unsigned*)((const char*)(gbase) + (voff)[_i]), (PG8_LAS unsigned*)(lds + (bufoff) + ldsw + _i * 8192), 16, 0, 0); } while (0)
#define PG8_LDA(dst, b, h) do { _Pragma("unroll") for (int m = 0; m < 4; ++m) _Pragma("unroll") for (int k = 0; k < 2; ++k) dst[m][k] = *(const PG8_LAS bf16x8*)(lds + PG8_SA(b, h) + aoff + m * 2048 + k * 1024); } while (0)
#define PG8_LDB(dst, b, h) do { _Pragma("unroll") for (int n = 0; n < 2; ++n) _Pragma("unroll") for (int k = 0; k < 2; ++k) dst[n][k] = *(const PG8_LAS bf16x8*)(lds + PG8_SB(b, h) + boff + n * 2048 + k * 1024); } while (0)
#define PG8_MMA(ai, bj, At, Bt) do { __builtin_amdgcn_s_setprio(1); _Pragma("unroll") for (int m = 0; m < 4; ++m) _Pragma("unroll") for (int n = 0; n < 2; ++n) _Pragma("unroll") for (int k = 0; k < 2; ++k) \
        acc[ai][bj][m][n] = __builtin_amdgcn_mfma_f32_16x16x32_bf16(Bt[n][k], At[m][k], acc[ai][bj][m][n], 0, 0, 0); __builtin_amdgcn_s_setprio(0); } while (0)
#define PG8_WAIT_V(n) asm volatile("s_waitcnt vmcnt(" #n ")" ::: "memory")
#define PG8_WAIT_L(n) asm volatile("s_waitcnt lgkmcnt(" #n ")" ::: "memory")
#define PG8_BAR __builtin_amdgcn_s_barrier()
#define PG8_SCHED __builtin_amdgcn_sched_barrier(0)
    Unit cur, nxt; int ui = 0;
    if (!S.next(0, cur)) return;
    f32x4 acc[2][2][4][2];
#pragma unroll
    for (int a = 0; a < 2; ++a)
#pragma unroll
        for (int b = 0; b < 2; ++b)
#pragma unroll
            for (int m = 0; m < 4; ++m)
#pragma unroll
                for (int n = 0; n < 2; ++n) { float z0, z1, z2, z3; asm volatile("v_mov_b32 %0, 0\n\tv_mov_b32 %1, 0\n\tv_mov_b32 %2, 0\n\tv_mov_b32 %3, 0" : "=v"(z0), "=v"(z1), "=v"(z2), "=v"(z3)); acc[a][b][m][n] = (f32x4){z0, z1, z2, z3}; }
    bf16x8 At[4][2], B0[2][2], B1[2][2];
    const char* cA = (const char*)g.A + op_aoff(g, cur, tstepA); const char* cB = (const char*)g.Bt + op_boff(g, cur, tstepB);
    S.a_ready(cur);
    if constexpr (SP2) {
        PG8_STAGE(PG8_SB(0, 0), cB, voffB); PG8_STAGE(PG8_SB(0, 1), cB + hstepB, voffB); PG8_STAGE(PG8_SA(0, 0), cA, voffA); PG8_STAGE(PG8_SA(0, 1), cA + hstepA, voffA);
        if (wr == 1) PG8_BAR;
        PG8_WAIT_V(2); PG8_BAR;
        PG8_STAGE(PG8_SB(1, 0), cB + kstep, voffB); PG8_STAGE(PG8_SA(1, 0), cA + kstep, voffA); PG8_STAGE(PG8_SB(1, 1), cB + hstepB + kstep, voffB);
        PG8_WAIT_V(6); PG8_BAR;
    } else {
        PG8_STAGE(PG8_SB(0, 0), cB, voffB); PG8_STAGE(PG8_SA(0, 0), cA, voffA); PG8_STAGE(PG8_SB(0, 1), cB + hstepB, voffB); PG8_STAGE(PG8_SA(0, 1), cA + hstepA, voffA);
        if (wr == 1) PG8_BAR;
        PG8_WAIT_V(4); PG8_BAR;
        PG8_STAGE(PG8_SB(1, 0), cB + kstep, voffB); PG8_STAGE(PG8_SA(1, 0), cA + kstep, voffA); PG8_STAGE(PG8_SB(1, 1), cB + hstepB + kstep, voffB);
        PG8_WAIT_V(6); PG8_BAR;
    }
    for (;;) {
        const bool has_next = S.next(ui + 1, nxt);
        const char* nA = has_next ? (const char*)g.A + op_aoff(g, nxt, tstepA) : cA; const char* nB = has_next ? (const char*)g.Bt + op_boff(g, nxt, tstepB) : cB;
        for (int t = 0; t < nt; t += 2) {
            const bool last = (t == nt - 2);
            const char* a1 = cA + (size_t)(t + 1) * kstep;
            const char* a2 = last ? nA : cA + (size_t)(t + 2) * kstep; const char* b2 = last ? nB : cB + (size_t)(t + 2) * kstep;
            const char* a3 = a2 + kstep; const char* b3 = b2 + kstep;
            if (last && has_next) S.a_ready(nxt);
            if constexpr (SP2) {
            PG8_LDB(B0, 0, 0); PG8_LDB(B1, 0, 1); PG8_SCHED; PG8_LDA(At, 0, 0); PG8_STAGE(PG8_SA(1, 1), a1 + hstepA, voffA);
            PG8_WAIT_V(8); PG8_WAIT_L(0); PG8_BAR; PG8_MMA(0, 0, At, B0); PG8_MMA(0, 1, At, B1); PG8_BAR; PG8_SCHED;
            PG8_LDA(At, 0, 1); PG8_STAGE(PG8_SB(0, 0), b2, voffB); PG8_STAGE(PG8_SB(0, 1), b2 + hstepB, voffB); PG8_STAGE(PG8_SA(0, 0), a2, voffA);
            PG8_WAIT_V(8); PG8_WAIT_L(0); PG8_BAR; PG8_MMA(1, 0, At, B0); PG8_MMA(1, 1, At, B1); PG8_BAR; PG8_SCHED;
            PG8_LDB(B0, 1, 0); PG8_LDB(B1, 1, 1); PG8_SCHED; PG8_LDA(At, 1, 0); PG8_STAGE(PG8_SA(0, 1), a2 + hstepA, voffA);
            PG8_WAIT_V(8); PG8_WAIT_L(0); PG8_BAR; PG8_MMA(0, 0, At, B0); PG8_MMA(0, 1, At, B1); PG8_BAR; PG8_SCHED;
            PG8_LDA(At, 1, 1); PG8_STAGE(PG8_SB(1, 0), b3, voffB); PG8_STAGE(PG8_SB(1, 1), b3 + hstepB, voffB); PG8_STAGE(PG8_SA(1, 0), a3, voffA);
            PG8_WAIT_V(8); PG8_WAIT_L(0); PG8_BAR; PG8_MMA(1, 0, At, B0); PG8_MMA(1, 1, At, B1); PG8_BAR; PG8_SCHED;
            } else {
            PG8_LDB(B0, 0, 0); PG8_SCHED; PG8_LDA(At, 0, 0); PG8_STAGE(PG8_SA(1, 1), a1 + hstepA, voffA);
            PG8_WAIT_L(8); PG8_BAR; PG8_WAIT_L(0); PG8_MMA(0, 0, At, B0); PG8_BAR; PG8_SCHED;
            PG8_LDB(B1, 0, 1); PG8_STAGE(PG8_SB(0, 0), b2, voffB);
            PG8_BAR; PG8_WAIT_L(0); PG8_MMA(0, 1, At, B1); PG8_BAR;
            PG8_LDA(At, 0, 1); PG8_STAGE(PG8_SA(0, 0), a2, voffA);
            PG8_BAR; PG8_WAIT_L(0); PG8_MMA(1, 0, At, B0); PG8_BAR; PG8_SCHED;
            PG8_STAGE(PG8_SB(0, 1), b2 + hstepB, voffB);
            PG8_WAIT_V(6); PG8_BAR; PG8_MMA(1, 1, At, B1); PG8_BAR;
            PG8_LDB(B0, 1, 0); PG8_SCHED; PG8_LDA(At, 1, 0); PG8_STAGE(PG8_SA(0, 1), a2 + hstepA, voffA);
            PG8_WAIT_L(8); PG8_BAR; PG8_WAIT_L(0); PG8_MMA(0, 0, At, B0); PG8_BAR; PG8_SCHED;
            PG8_LDB(B1, 1, 1); PG8_STAGE(PG8_SB(1, 0), b3, voffB);
            PG8_BAR; PG8_WAIT_L(0); PG8_MMA(0, 1, At, B1); PG8_BAR;
            PG8_LDA(At, 1, 1); PG8_STAGE(PG8_SA(1, 0), a3, voffA);
            PG8_BAR; PG8_WAIT_L(0); PG8_MMA(1, 0, At, B0); PG8_BAR; PG8_SCHED;
            PG8_STAGE(PG8_SB(1, 1), b3 + hstepB, voffB);
            PG8_WAIT_V(6); PG8_BAR; PG8_MMA(1, 1, At, B1); PG8_BAR;
            }
        }
        if constexpr (ALIGN_EPI) { if (wr == 0) PG8_BAR; }
        if constexpr (!Epi::AFTER_DRAIN) { E(acc, cur, wr, wc, fr, fq); S.done(cur); }
        if (!has_next) break;
#pragma unroll
        for (int a = 0; a < 2; ++a)
#pragma unroll
        for (int b = 0; b < 2; ++b)
#pragma unroll
            for (int m = 0; m < 4; ++m)
#pragma unroll
                for (int n = 0; n < 2; ++n) { float z0, z1, z2, z3; asm volatile("v_mov_b32 %0, 0\n\tv_mov_b32 %1, 0\n\tv_mov_b32 %2, 0\n\tv_mov_b32 %3, 0" : "=v"(z0), "=v"(z1), "=v"(z2), "=v"(z3)); acc[a][b][m][n] = (f32x4){z0, z1, z2, z3}; }
        cur = nxt; cA = nA; cB = nB; ++ui;
        if constexpr (ALIGN_EPI) { if (wr == 1) PG8_BAR; }
    }
    PG8_WAIT_V(0);
    if constexpr (!ALIGN_EPI) { if (wr == 0) PG8_BAR; }
    PG8_BAR;
    if constexpr (Epi::AFTER_DRAIN) { E.fused(acc, cur, wr, wc, fr, fq, lds, wid, lane); S.done(cur); }
#undef PG8_SA
#undef PG8_SB
#undef PG8_STAGE
#undef PG8_LDA
#undef PG8_LDB
#undef PG8_MMA
#undef PG8_WAIT_V
#undef PG8_WAIT_L
#undef PG8_BAR
#undef PG8_SCHED
}
}

#define LAS __attribute__((address_space(3)))
typedef unsigned short bf16;
typedef unsigned char uchar;
typedef short bf16x8 __attribute__((ext_vector_type(8)));
typedef float f32x4 __attribute__((ext_vector_type(4)));
typedef unsigned v4u __attribute__((ext_vector_type(4)));
typedef unsigned v2u __attribute__((ext_vector_type(2)));

constexpr int DM = 1024, NBATCH = 4, SEQ = 4096, DEPTH = 4, CTXL = 256;
constexpr int ML = NBATCH * SEQ, MC = NBATCH * CTXL, MT = ML + MC;
constexpr int LP = 4096, NG = 3072, DFF = 2816, NIN = 6928, NINP = 7168, LBO = 1536;
constexpr int C_Q = 0, C_K = 512, C_V = 640, C_GLU = 768, C_QKM = 1792, C_VM = 2816, C_OM = 3328, C_GM = 3840;
constexpr int NCHUNK = 68;
constexpr float EPS = 1e-6f;
constexpr size_t MiB = 1u << 20;
constexpr size_t WS_MOD = 0, WS_ROPE = 512 * 1024, WS_BEND = 1 * MiB, WS_MU = WS_BEND + 16384, WS_MS = WS_MU + 16384, WS_NS = 2 * MiB;
constexpr size_t WS_XC = 4 * MiB, WS_WIN = 8 * MiB, WS_WP = 22 * MiB, WS_WO3 = 25 * MiB, WS_WGU = 31 * MiB, WS_WD = 42 * MiB;
constexpr size_t WS_BO = 48 * MiB, WS_P1 = 99 * MiB, WS_G = 235 * MiB, WS_ST = 337 * MiB, WS_END = 405 * MiB;
constexpr size_t WS_DBG = 768 * 1024, WS_BAR = 3 * MiB + 512 * 1024, BAR_BYTES = 16384;
constexpr int MISC_OFF = 155136;
constexpr int LDS_BYTES = 155648;
constexpr int NPHASE = 2 + 10 * DEPTH;

struct Params { const float* in[25]; float* out; uchar* ws; int ph_lo, ph_hi; };
enum { I_X = 0, I_C, I_CTX, I_CCTX, I_WADA, I_BADA, I_GMIX, I_GFFN, I_WIN, I_BMG, I_SINK, I_WATT, I_WDW, I_BDW, I_GCLN, I_BCLN, I_WPW, I_WMCONV, I_GMN, I_WMOUT, I_WOUT, I_WFG, I_WFU, I_WFD, I_GFIN };

__device__ __forceinline__ float bf2f(unsigned h) { return __uint_as_float(h << 16); }
typedef __bf16 bf16x2_t __attribute__((ext_vector_type(2)));
typedef float f32x2_t __attribute__((ext_vector_type(2)));
__device__ __forceinline__ unsigned pk2(float lo, float hi) { f32x2_t v = {lo, hi}; bf16x2_t b = __builtin_convertvector(v, bf16x2_t); return __builtin_bit_cast(unsigned, b); }
__device__ __forceinline__ float sigmoidf_(float x) { return __builtin_amdgcn_rcpf(1.0f + __expf(-x)); }
__device__ __forceinline__ float siluf_(float x) { return x * __builtin_amdgcn_rcpf(1.0f + __expf(-x)); }
__device__ __forceinline__ float logsigf_(float x) { return fminf(x, 0.f) - __logf(1.0f + __expf(-fabsf(x))); }
__device__ __forceinline__ int olane() { int l = __builtin_amdgcn_mbcnt_hi(-1, __builtin_amdgcn_mbcnt_lo(-1, 0)); asm volatile("" : "+v"(l)); return l; }
__device__ __forceinline__ float shi(float v, int src) { return __builtin_bit_cast(float, __builtin_amdgcn_ds_bpermute(src << 2, __builtin_bit_cast(int, v))); }
__device__ __forceinline__ float shx(float v, int o) { return shi(v, olane() ^ o); }
__device__ __forceinline__ float wave_sum(float v) {
    const int l = olane();
#pragma unroll
    for (int o = 1; o < 64; o <<= 1) v += shi(v, l ^ o);
    return v;
}
#define DPPF(v, ctrl) __builtin_bit_cast(float, __builtin_amdgcn_update_dpp(0, __builtin_bit_cast(int, (v)), (ctrl), 0xf, 0xf, false))
__device__ __forceinline__ void wave_sum8(float (&v)[8]) {
#pragma unroll
    for (int t = 0; t < 8; ++t) { v[t] += DPPF(v[t], 0x128); v[t] += DPPF(v[t], 0x124); v[t] += DPPF(v[t], 0x122); v[t] += DPPF(v[t], 0x121); }
    const int l = olane();
#pragma unroll
    for (int t = 0; t < 8; ++t) v[t] += shi(v[t], l ^ 16);
#pragma unroll
    for (int t = 0; t < 8; ++t) v[t] += shi(v[t], l ^ 32);
}
__device__ __forceinline__ float wave_max(float v) {
    const int l = olane();
#pragma unroll
    for (int o = 1; o < 64; o <<= 1) v = fmaxf(v, shi(v, l ^ o));
    return v;
}
__device__ __forceinline__ float scan_add(float v, int lane) {
#pragma unroll
    for (int o = 1; o < 64; o <<= 1) { const float t = shi(v, lane >= o ? lane - o : lane); if (lane >= o) v += t; }
    return v;
}
__device__ __forceinline__ float scan_max(float v, int lane) {
#pragma unroll
    for (int o = 1; o < 64; o <<= 1) { const float t = shi(v, lane >= o ? lane - o : lane); if (lane >= o) v = fmaxf(v, t); }
    return v;
}
__device__ __forceinline__ void unpack8(v4u w, float (&f)[8]) {
    f[0] = bf2f(w.x & 0xffffu); f[1] = bf2f(w.x >> 16); f[2] = bf2f(w.y & 0xffffu); f[3] = bf2f(w.y >> 16);
    f[4] = bf2f(w.z & 0xffffu); f[5] = bf2f(w.z >> 16); f[6] = bf2f(w.w & 0xffffu); f[7] = bf2f(w.w >> 16);
}
__device__ __forceinline__ v4u pack8(const float (&f)[8]) { v4u w; w.x = pk2(f[0], f[1]); w.y = pk2(f[2], f[3]); w.z = pk2(f[4], f[5]); w.w = pk2(f[6], f[7]); return w; }
#define LDS_FENCE() asm volatile("s_waitcnt lgkmcnt(0)" ::: "memory")
#define MFMA16(a, b, c) __builtin_amdgcn_mfma_f32_16x16x32_bf16((a), (b), (c), 0, 0, 0)
#define DBGF(cond, code) do { if (cond) atomicMin((int*)(c.ws + WS_DBG), (code)); } while (0)

__device__ __forceinline__ int otid() { int t = threadIdx.x; asm volatile("" : "+v"(t)); return t; }
#define TLW const int tid_ = otid(), lane_ = tid_ & 63, wave_ = __builtin_amdgcn_readfirstlane(tid_ >> 6); (void)lane_; (void)wave_
__device__ __forceinline__ f32x4 zero4() { float z0, z1, z2, z3; asm volatile("v_mov_b32 %0, 0\n\tv_mov_b32 %1, 0\n\tv_mov_b32 %2, 0\n\tv_mov_b32 %3, 0" : "=v"(z0), "=v"(z1), "=v"(z2), "=v"(z3)); return (f32x4){z0, z1, z2, z3}; }
__device__ __forceinline__ v4u zero4u() { unsigned z0, z1, z2, z3; asm volatile("v_mov_b32 %0, 0\n\tv_mov_b32 %1, 0\n\tv_mov_b32 %2, 0\n\tv_mov_b32 %3, 0" : "=v"(z0), "=v"(z1), "=v"(z2), "=v"(z3)); return (v4u){z0, z1, z2, z3}; }
struct Ctx {
    const __attribute__((address_space(4))) Params* p; LAS uchar* lds; int bid, nblk;
    uchar* ws; float* xl;
};

#define XB_TMO      128
#define XB_XCNT(j)  (256  + 64 * (j))
#define XB_XSUB(j)  (1280 + 64 * (j))
#define XB_XGEN(j)  (2304 + 64 * (j))
#define XB_TOP      3328
#define XB_TOPGEN   3392
#define XCD_BAR_WORDS 3456
#define XB_SPIN_CAP (1u << 18)

__device__ __forceinline__ unsigned xb_ld(unsigned* p)              { return __hip_atomic_load(p, __ATOMIC_RELAXED, __HIP_MEMORY_SCOPE_AGENT); }
__device__ __forceinline__ unsigned xb_add(unsigned* p, unsigned v) { return __hip_atomic_fetch_add(p, v, __ATOMIC_RELAXED, __HIP_MEMORY_SCOPE_AGENT); }
__device__ __forceinline__ unsigned xb_xcc_id() { return (unsigned)__builtin_amdgcn_s_getreg((3 << 11) | 20) & 0xFu; }
#define XB_SPIN(cond, bar) do { unsigned _sp = 0; while (cond) { __builtin_amdgcn_s_sleep(1); \
    if ((++_sp & 255u) == 0u) { if (xb_ld(&(bar)[XB_TMO])) break; if (_sp > XB_SPIN_CAP) { atomicAdd(&(bar)[XB_TMO], 1u); break; } } } } while (0)

struct XcdBarrier {
    unsigned* bar; unsigned x;
    volatile LAS unsigned* st;
};

__device__ __forceinline__ XcdBarrier xcd_barrier_post(unsigned* bar, volatile LAS unsigned* st) {
    XcdBarrier b; b.bar = bar; b.x = xb_xcc_id(); b.st = st;
    if (threadIdx.x == 0) (void)xb_add(&bar[XB_XCNT(b.x)], 1u);
    return b;
}
__device__ __forceinline__ void xcd_barrier_complete(unsigned* bar, unsigned x, unsigned& nloc, unsigned& nx) {
    const unsigned G = gridDim.x * gridDim.y * gridDim.z;
    unsigned sum, cnt, mine, sp = 0u;
    for (;;) {
        sum = 0u; cnt = 0u; mine = 0u;
#pragma unroll
        for (unsigned j = 0; j < 16; ++j) { const unsigned c = xb_ld(&bar[XB_XCNT(j)]); sum += c; cnt += (c > 0u) ? 1u : 0u; mine = (j == x) ? c : mine; }
        if (sum == G) break;
        __builtin_amdgcn_s_sleep(1);
        if ((++sp & 255u) == 0u) { if (xb_ld(&bar[XB_TMO])) break; if (sp > XB_SPIN_CAP) { atomicAdd(&bar[XB_TMO], 1u); break; } }
    }
    nloc = mine > 0u ? mine : 1u; nx = cnt > 0u ? cnt : 1u;
}

__device__ __forceinline__ void xcd_barrier(const XcdBarrier& b) {
    asm volatile("s_waitcnt vmcnt(0)" ::: "memory");
    __syncthreads();
    if (threadIdx.x == 0) {
        unsigned* bar = b.bar;
        __builtin_amdgcn_s_waitcnt(0);
        unsigned nloc = b.st[0], nx = b.st[1];
        if (nloc == 0u) { xcd_barrier_complete(bar, b.x, nloc, nx); b.st[0] = nloc; b.st[1] = nx; }
        const unsigned old = xb_add(&bar[XB_XSUB(b.x)], 1u);
        const unsigned gen = old / nloc;
        if (old + 1u == (gen + 1u) * nloc) {
            __builtin_amdgcn_fence(__ATOMIC_RELEASE, "agent");
            asm volatile("s_waitcnt vmcnt(0)" ::: "memory");
            const unsigned og = xb_add(&bar[XB_TOP], 1u);
            const unsigned tg = og / nx;
            if (og + 1u == (tg + 1u) * nx) xb_add(&bar[XB_TOPGEN], 1u);
            else XB_SPIN(xb_ld(&bar[XB_TOPGEN]) == tg, bar);
            __builtin_amdgcn_fence(__ATOMIC_ACQUIRE, "agent");
            xb_add(&bar[XB_XGEN(b.x)], 1u);
            asm volatile("s_waitcnt vmcnt(0)" ::: "memory");
        } else {
            XB_SPIN(xb_ld(&bar[XB_XGEN(b.x)]) == gen, bar);
            __builtin_amdgcn_fence(__ATOMIC_ACQUIRE, "agent");
            asm volatile("s_waitcnt vmcnt(0)" ::: "memory");
        }
    }
    __syncthreads();
}

struct EpiP1G {
    static constexpr bool PERM = true, AFTER_DRAIN = false;
    bf16* P1; bf16* G;
    __device__ __forceinline__ void operator()(const f32x4 (&acc)[2][2][4][2], const pg8::Unit& u, int wr, int wc, int fr, int fq) const {
        { const int l_ = olane(); fr = l_ & 15; fq = l_ >> 4; }
        const int row0 = u.pm * 256 + wr * 64 + fr; const bool sg = u.pn >= 16, glu = u.pn >= 3 && u.pn < 7;
        bf16* base = sg ? G : P1; const int ldc = sg ? NG : LP; const int col0 = (sg ? u.pn - 16 : u.pn) * 256 + wc * 32 + 8 * fq;
#pragma unroll
        for (int ai = 0; ai < 2; ++ai)
#pragma unroll
            for (int m = 0; m < 4; ++m) { bf16* rowp = base + (size_t)(row0 + ai * 128 + m * 16) * ldc + col0;
                if (glu) {
                    bf16* zp = P1 + (size_t)(row0 + ai * 128 + m * 16) * LP + C_GLU + (u.pn - 3) * 128 + wc * 16 + 4 * fq;
#pragma unroll
                    for (int bj = 0; bj < 2; ++bj) { const f32x4 v0 = acc[ai][bj][m][0], v1 = acc[ai][bj][m][1];
                        v2u w; w.x = pk2(v0[0] * sigmoidf_(v0[1]), v0[2] * sigmoidf_(v0[3])); w.y = pk2(v1[0] * sigmoidf_(v1[1]), v1[2] * sigmoidf_(v1[3]));
                        *(v2u*)(zp + bj * 64) = w; }
                    continue; }
#pragma unroll
                for (int bj = 0; bj < 2; ++bj) { f32x4 v0 = acc[ai][bj][m][0], v1 = acc[ai][bj][m][1];
                    if (sg) {
#pragma unroll
                        for (int e = 0; e < 4; ++e) { v0[e] = sigmoidf_(v0[e]); v1[e] = sigmoidf_(v1[e]); } }
                    v4u w; w.x = pk2(v0[0], v0[1]); w.y = pk2(v0[2], v0[3]); w.z = pk2(v1[0], v1[1]); w.w = pk2(v1[2], v1[3]);
                    *(v4u*)(rowp + bj * 128) = w; } }
    }
};
struct EpiGateMul {
    static constexpr bool PERM = true, AFTER_DRAIN = false;
    bf16* G;
    __device__ __forceinline__ void operator()(const f32x4 (&acc)[2][2][4][2], const pg8::Unit& u, int wr, int wc, int fr, int fq) const {
        { const int l_ = olane(); fr = l_ & 15; fq = l_ >> 4; }
        const int row0 = u.pm * 256 + wr * 64 + fr, col0 = u.pn * 256 + wc * 32 + 8 * fq;
#pragma unroll
        for (int ai = 0; ai < 2; ++ai)
#pragma unroll
            for (int m = 0; m < 4; ++m) { bf16* rowp = G + (size_t)(row0 + ai * 128 + m * 16) * NG + col0;
#pragma unroll
                for (int bj = 0; bj < 2; ++bj) { const f32x4 v0 = acc[ai][bj][m][0], v1 = acc[ai][bj][m][1];
                    const v4u gv = *(const v4u*)(rowp + bj * 128); float gf[8]; unpack8(gv, gf);
                    v4u w; w.x = pk2(v0[0] * gf[0], v0[1] * gf[1]); w.y = pk2(v0[2] * gf[2], v0[3] * gf[3]); w.z = pk2(v1[0] * gf[4], v1[1] * gf[5]); w.w = pk2(v1[2] * gf[6], v1[3] * gf[7]);
                    *(v4u*)(rowp + bj * 128) = w; } }
    }
};
struct EpiResid {
    static constexpr bool PERM = false, AFTER_DRAIN = false;
    float* xl; float* xc; const float* gate; const float* xsrc;
    __device__ __forceinline__ void operator()(const f32x4 (&acc)[2][2][4][2], const pg8::Unit& u, int wr, int wc, int fr, int fq) const {
        { const int l_ = olane(); fr = l_ & 15; fq = l_ >> 4; }
        const int row0 = u.pm * 256 + wr * 64 + fr, col0 = u.pn * 256 + wc * 32 + 4 * fq;
        const bool lat = u.pm < 64; float* xb = lat ? xl : xc - (size_t)ML * DM; const float* xs = lat ? xsrc : xc - (size_t)ML * DM; const float* gp = gate + (lat ? (u.pm >> 4) : 4) * 6144 + col0;
#pragma unroll
        for (int ai = 0; ai < 2; ++ai)
#pragma unroll
            for (int m = 0; m < 4; ++m) { float* rowp = xb + (size_t)(row0 + ai * 128 + m * 16) * DM + col0; const float* srcp = xs + (size_t)(row0 + ai * 128 + m * 16) * DM + col0;
#pragma unroll
                for (int bj = 0; bj < 2; ++bj)
#pragma unroll
                    for (int n = 0; n < 2; ++n) { f32x4 x = *(const f32x4*)(srcp + bj * 128 + n * 16); const f32x4 gvv = *(const f32x4*)(gp + bj * 128 + n * 16); x = x + gvv * acc[ai][bj][m][n]; *(f32x4*)(rowp + bj * 128 + n * 16) = x; }
                asm volatile("" ::: "memory"); }
    }
};
struct EpiMerge {
    static constexpr bool PERM = true, AFTER_DRAIN = false;
    const bf16* G; bf16* MG;
    __device__ __forceinline__ void operator()(const f32x4 (&acc)[2][2][4][2], const pg8::Unit& u, int wr, int wc, int fr, int fq) const {
        { const int l_ = olane(); fr = l_ & 15; fq = l_ >> 4; }
        const int row0 = u.pm * 256 + wr * 64 + fr, col0 = u.pn * 256 + wc * 32 + 8 * fq;
#pragma unroll
        for (int ai = 0; ai < 2; ++ai)
#pragma unroll
            for (int m = 0; m < 4; ++m) { const size_t row = (size_t)(row0 + ai * 128 + m * 16); const bf16* gp = G + row * NG + u.z * 1024 + col0; bf16* mp = MG + row * DM + col0;
#pragma unroll
                for (int bj = 0; bj < 2; ++bj) { const f32x4 v0 = acc[ai][bj][m][0], v1 = acc[ai][bj][m][1];
                    float gf[8]; unpack8(*(const v4u*)(gp + bj * 128), gf);
                    float r[8] = {v0[0] * gf[0], v0[1] * gf[1], v0[2] * gf[2], v0[3] * gf[3], v1[0] * gf[4], v1[1] * gf[5], v1[2] * gf[6], v1[3] * gf[7]};
                    if (u.z > 0) { float of[8]; unpack8(*(const v4u*)(mp + bj * 128), of);
#pragma unroll
                        for (int e = 0; e < 8; ++e) r[e] += of[e]; }
                    *(v4u*)(mp + bj * 128) = pack8(r); }
                asm volatile("" ::: "memory"); }
    }
};
struct EpiPartial {
    static constexpr bool PERM = false, AFTER_DRAIN = false;
    float* PART;
    __device__ __forceinline__ void operator()(const f32x4 (&acc)[2][2][4][2], const pg8::Unit& u, int wr, int wc, int fr, int fq) const {
        { const int l_ = olane(); fr = l_ & 15; fq = l_ >> 4; }
        const int row0 = u.pm * 256 + wr * 64 + fr, col0 = (u.pn & 3) * 256 + wc * 32 + 4 * fq;
        float* base = PART + (size_t)(u.pn >> 2) * MC * DM;
#pragma unroll
        for (int ai = 0; ai < 2; ++ai)
#pragma unroll
            for (int m = 0; m < 4; ++m) { float* rowp = base + (size_t)(row0 + ai * 128 + m * 16) * DM + col0;
#pragma unroll
                for (int bj = 0; bj < 2; ++bj)
#pragma unroll
                    for (int n = 0; n < 2; ++n) *(f32x4*)(rowp + bj * 128 + n * 16) = acc[ai][bj][m][n]; }
    }
};
struct EpiSwiGLU {
    static constexpr bool PERM = true, AFTER_DRAIN = false;
    bf16* HID;
    __device__ __forceinline__ void operator()(const f32x4 (&acc)[2][2][4][2], const pg8::Unit& u, int wr, int wc, int fr, int fq) const {
        { const int l_ = olane(); fr = l_ & 15; fq = l_ >> 4; }
        const int row0 = u.pm * 256 + wr * 64 + fr, col0 = u.pn * 128 + wc * 16 + 4 * fq;
#pragma unroll
        for (int ai = 0; ai < 2; ++ai)
#pragma unroll
            for (int m = 0; m < 4; ++m) { bf16* rowp = HID + (size_t)(row0 + ai * 128 + m * 16) * DFF + col0;
#pragma unroll
                for (int bj = 0; bj < 2; ++bj) { const f32x4 v0 = acc[ai][bj][m][0], v1 = acc[ai][bj][m][1];
                    v2u w; w.x = pk2(siluf_(v0[0]) * v0[1], siluf_(v0[2]) * v0[3]); w.y = pk2(siluf_(v1[0]) * v1[1], siluf_(v1[2]) * v1[3]);
                    *(v2u*)(rowp + bj * 64) = w; } }
    }
};

__device__ __forceinline__ void phase_init(Ctx& c) {
    TLW;
    const __attribute__((address_space(4))) Params& p = *c.p;
    {
      const f32x4* sc = (const f32x4*)((const float*)(const __attribute__((address_space(1))) float*)p.in[I_CTX]); f32x4* dc = (f32x4*)((float*)(c.ws + WS_XC)); const int m4 = MC * DM / 4;
      for (int i = c.bid * 512 + tid_; i < m4; i += c.nblk * 512) dc[i] = sc[i]; }
    if (c.bid == 0) { for (int i = tid_; i < 1024; i += 512) { const int pos = i >> 4, f = i & 15; const float inv = __builtin_amdgcn_exp2f(-(float)f * (13.287712379549449f / 16.0f)); const float ang = (float)pos * inv;
        ((float*)(c.ws + WS_ROPE))[pos * 32 + f] = __cosf(ang); ((float*)(c.ws + WS_ROPE))[pos * 32 + 16 + f] = __sinf(ang); } }
    LAS float* sc = (LAS float*)c.lds;
    LAS float* part = (LAS float*)(c.lds + 20480);
    for (int i = tid_; i < 5120; i += 512) { const int r = i >> 10, k = i & 1023; const float v = r < 4 ? ((const float*)(const __attribute__((address_space(1))) float*)p.in[I_C])[r * 1024 + k] : ((const float*)(const __attribute__((address_space(1))) float*)p.in[I_CCTX])[k]; sc[i] = siluf_(v); }
    __syncthreads();
    for (int u = c.bid; u < DEPTH * 96; u += c.nblk) {
        const int l = u / 96, n0 = (u % 96) * 64;
        const float* w = ((const float*)(const __attribute__((address_space(1))) float*)p.in[I_WADA]) + (size_t)l * DM * 6144 + n0 + lane_;
        float a0 = 0.f, a1 = 0.f, a2 = 0.f, a3 = 0.f, a4 = 0.f;
        const int kb = wave_ * 128;
#pragma unroll 32
        for (int k = 0; k < 128; ++k) { const float wv = w[(size_t)(kb + k) * 6144];
            a0 += sc[kb + k] * wv; a1 += sc[1024 + kb + k] * wv; a2 += sc[2048 + kb + k] * wv; a3 += sc[3072 + kb + k] * wv; a4 += sc[4096 + kb + k] * wv; }
        LAS float* pw = part + wave_ * 320 + lane_; pw[0] = a0; pw[64] = a1; pw[128] = a2; pw[192] = a3; pw[256] = a4;
        __syncthreads();
        if (tid_ < 320) { float s = 0.f;
#pragma unroll
            for (int wv = 0; wv < 8; ++wv) s += part[wv * 320 + tid_];
            const int r = tid_ >> 6, ln = tid_ & 63; ((float*)(c.ws + WS_MOD))[((size_t)l * 5 + r) * 6144 + n0 + ln] = s + ((const float*)(const __attribute__((address_space(1))) float*)p.in[I_BADA])[l * 6144 + n0 + ln]; }
        __syncthreads();
    }
}

__device__ __forceinline__ void tr_item(const float* src, int lds_, int k0, int n0, bf16* dst, int ldd, int drow0, int rmul, int ncopy, LAS float* scr, int lane) {
#pragma unroll 4
    for (int i = 0; i < 16; ++i) { const int kk = 4 * i + (lane >> 4), nn = lane & 15; scr[kk * 17 + nn] = src[(size_t)(k0 + kk) * lds_ + n0 + nn]; }
    LDS_FENCE();
    const int n = lane >> 2, kc = (lane & 3) * 16;
#pragma unroll
    for (int h = 0; h < 2; ++h) { const LAS float* s = scr + (kc + 8 * h) * 17 + n;
        v4u o; o.x = pk2(s[0], s[17]); o.y = pk2(s[34], s[51]); o.z = pk2(s[68], s[85]); o.w = pk2(s[102], s[119]);
        bf16* d = dst + (size_t)(drow0 + rmul * n) * ldd + k0 + kc + 8 * h;
        for (int cpy = 0; cpy < ncopy; ++cpy) *(v4u*)(d + cpy * 1024) = o; }
    LDS_FENCE();
}
__device__ __forceinline__ void convert_weights(Ctx& c, int l) {
    TLW;
    const __attribute__((address_space(4))) Params& p = *c.p;
    LAS float* scr = (LAS float*)(c.lds + wave_ * 4608);
    const int gw = c.bid * 8 + wave_, ngw = c.nblk * 8;
    constexpr int I_IN = 16 * 433, I_P = 8 * 64, I_O = 16 * 64, I_F = 16 * 176, I_D = 44 * 64;
    constexpr int TOT = I_IN + 3 * I_P + I_O + 2 * I_F + I_D;
    for (int it = gw; it < TOT; it += ngw) {
        int r = it;
        if (r < I_IN) { const int kb = r / 433, nb = r % 433, n0 = nb * 16; const bool isv = n0 >= 768 && n0 < 1280, isg = n0 >= 1280 && n0 < 1792;
            tr_item(((const float*)(const __attribute__((address_space(1))) float*)p.in[I_WIN]) + (size_t)l * DM * NIN, NIN, kb * 64, n0, ((bf16*)(c.ws + WS_WIN)), DM, isv ? 768 + 2 * (n0 - 768) : isg ? 769 + 2 * (n0 - 1280) : n0 < 3856 ? n0 : n0 + 240, (isv || isg) ? 2 : 1, 1, scr, lane_); continue; } r -= I_IN;
        if (r < 3 * I_P) { const int br = r / I_P, q = r % I_P, kb = q / 64, nb = q % 64; const float* src = (br == 0 ? ((const float*)(const __attribute__((address_space(1))) float*)p.in[I_WATT]) : br == 1 ? ((const float*)(const __attribute__((address_space(1))) float*)p.in[I_WPW]) : ((const float*)(const __attribute__((address_space(1))) float*)p.in[I_WMOUT])) + (size_t)l * 512 * DM;
            tr_item(src, DM, kb * 64, nb * 16, ((bf16*)(c.ws + WS_WP)), 512, br * 1024 + nb * 16, 1, 1, scr, lane_); continue; } r -= 3 * I_P;
        if (r < I_O) { const int kb = r / 64, nb = r % 64; tr_item(((const float*)(const __attribute__((address_space(1))) float*)p.in[I_WOUT]) + (size_t)l * DM * DM, DM, kb * 64, nb * 16, ((bf16*)(c.ws + WS_WO3)), 3072, nb * 16, 1, 3, scr, lane_); continue; } r -= I_O;
        if (r < 2 * I_F) { const int gu = r / I_F, q = r % I_F, kb = q / 176, nb = q % 176; const float* src = (gu == 0 ? ((const float*)(const __attribute__((address_space(1))) float*)p.in[I_WFG]) : ((const float*)(const __attribute__((address_space(1))) float*)p.in[I_WFU])) + (size_t)l * DM * DFF;
            tr_item(src, DFF, kb * 64, nb * 16, ((bf16*)(c.ws + WS_WGU)), DM, 2 * nb * 16 + gu, 2, 1, scr, lane_); continue; } r -= 2 * I_F;
        { const int kb = r / 64, nb = r % 64; tr_item(((const float*)(const __attribute__((address_space(1))) float*)p.in[I_WFD]) + (size_t)l * DFF * DM, DM, kb * 64, nb * 16, ((bf16*)(c.ws + WS_WD)), DFF, nb * 16, 1, 1, scr, lane_); }
    }
    { v4u* z = (v4u*)(((bf16*)(c.ws + WS_WIN)) + (size_t)3856 * DM); const int nz = 240 * DM / 8; for (int i = c.bid * 512 + tid_; i < nz; i += c.nblk * 512) z[i] = zero4u(); }
}
__device__ __forceinline__ void phase_norm(Ctx& c, int l, int which, int nrows, const float* part, int nsl, const float* pgate, const float* xin) {
    TLW;
    const __attribute__((address_space(4))) Params& p = *c.p;
    const float* g = p.in[which ? I_GFFN : I_GMIX] + l * DM;
    const float* modl = ((float*)(c.ws + WS_MOD)) + (size_t)l * 5 * 6144 + (which ? 3072 : 0);
    bf16* H = ((bf16*)(c.ws + WS_BO));
    const int gw = c.bid * 8 + wave_, ngw = c.nblk * 8;
    f32x4 gv[4];
#pragma unroll
    for (int j = 0; j < 4; ++j) gv[j] = ((const f32x4*)g)[64 * j + lane_];
    constexpr int NR = 4;
    for (int rb = gw; rb < nrows; rb += NR * ngw) {
        f32x4 v[NR][4]; float ss[NR];
#pragma unroll
        for (int k = 0; k < NR; ++k) { const int r = rb + k * ngw; ss[k] = 0.f;
            if (r < nrows) {
                float* xr = r < ML ? (xin != nullptr ? const_cast<float*>(xin) : c.xl) + (size_t)r * DM : ((float*)(c.ws + WS_XC)) + (size_t)(r - ML) * DM;
#pragma unroll
                for (int j = 0; j < 4; ++j) { v[k][j] = ((const f32x4*)xr)[64 * j + lane_];
                    if (part != nullptr && r >= ML) {
                        f32x4 a = zero4();
                        for (int sidx = 0; sidx < nsl; ++sidx) a = a + ((const f32x4*)(part + ((size_t)sidx * MC + (r - ML)) * DM))[64 * j + lane_];
                        v[k][j] = v[k][j] + ((const f32x4*)pgate)[64 * j + lane_] * a; ((f32x4*)xr)[64 * j + lane_] = v[k][j]; }
                    ss[k] += (v[k][j].x * v[k][j].x + v[k][j].y * v[k][j].y) + (v[k][j].z * v[k][j].z + v[k][j].w * v[k][j].w); } } }
        { const int ol = olane();
#pragma unroll
          for (int k = 0; k < NR; ++k) { ss[k] += DPPF(ss[k], 0x128); ss[k] += DPPF(ss[k], 0x124); ss[k] += DPPF(ss[k], 0x122); ss[k] += DPPF(ss[k], 0x121); }
#pragma unroll
          for (int k = 0; k < NR; ++k) ss[k] += shi(ss[k], ol ^ 16);
#pragma unroll
          for (int k = 0; k < NR; ++k) ss[k] += shi(ss[k], ol ^ 32); }
#pragma unroll
        for (int k = 0; k < NR; ++k) { const int r = rb + k * ngw;
            if (r < nrows) {
                const float* mr = modl + (r < ML ? (r >> 12) : 4) * 6144;
                const float rstd = rsqrtf(ss[k] * (1.0f / DM) + EPS);
                v2u* o = (v2u*)(H + (size_t)r * DM);
#pragma unroll
                for (int j = 0; j < 4; ++j) { const f32x4 sh = ((const f32x4*)mr)[64 * j + lane_], scl = ((const f32x4*)(mr + 1024))[64 * j + lane_];
                    f32x4 y = v[k][j] * rstd * gv[j]; y = y * (scl + 1.0f) + sh;
                    v2u w; w.x = pk2(y.x, y.y); w.y = pk2(y.z, y.w); o[64 * j + lane_] = w; } } }
    }
}
__device__ __forceinline__ void phase_final(Ctx& c) {
    TLW;
    const float* g = ((const float*)(const __attribute__((address_space(1))) float*)c.p->in[I_GFIN]);
    const int gw = c.bid * 8 + wave_, ngw = c.nblk * 8;
    for (int r = gw; r < ML; r += ngw) {
        f32x4* xr = (f32x4*)(c.xl + (size_t)r * DM);
        f32x4 v[4]; float ss = 0.f;
#pragma unroll
        for (int j = 0; j < 4; ++j) { v[j] = xr[64 * j + lane_]; ss += (v[j].x * v[j].x + v[j].y * v[j].y) + (v[j].z * v[j].z + v[j].w * v[j].w); }
        const float rstd = rsqrtf(wave_sum(ss) * (1.0f / DM) + EPS);
#pragma unroll
        for (int j = 0; j < 4; ++j) { f32x4 o = v[j] * rstd * ((const f32x4*)g)[64 * j + lane_];
#ifdef DBGSCAN
            { const int code = *(const int*)(c.ws + WS_DBG); if (code != 0x7fffffff) { const float cv = sqrtf(2.0f * (float)code); o = (f32x4){cv, cv, cv, cv}; } }
#endif
            xr[64 * j + lane_] = o; }
    }
}

__device__ __forceinline__ void attn_unit(Ctx& c, int l, int b, int h, int qblk, bool ictx) {
    TLW;
    const __attribute__((address_space(4))) Params& p = *c.p;
    LAS bf16* Qs = (LAS bf16*)c.lds;
    LAS bf16* Ks = (LAS bf16*)(c.lds + 18432);
    LAS bf16* Vt = (LAS bf16*)(c.lds + 27648);
    LAS bf16* Ps = (LAS bf16*)(c.lds + 36864) + wave_ * (16 * 72);
    const int tid = tid_, lane = lane_, w = wave_, lr = lane & 15, lg = lane >> 4;
    const int hk = h >> 2;
    const size_t qrow0 = ictx ? (size_t)ML + b * CTXL + qblk * 128 : (size_t)b * SEQ + qblk * 128;
    {
        const int row = tid >> 2, part = tid & 3, d0 = (part & 1) * 8 + (part >> 1) * 32;
        const bf16* src = ((bf16*)(c.ws + WS_P1)) + (qrow0 + row) * LP + C_Q + h * 64 + d0;
        float lo[8], hi[8]; unpack8(*(const v4u*)src, lo); unpack8(*(const v4u*)(src + 16), hi);
        if (!ictx) { const int t = qblk * 128 + row, pos = (part >> 1) ? (t & 63) : (t >> 6); const float* rt = ((const float*)(c.ws + WS_ROPE)) + pos * 32 + (d0 & 15);
#pragma unroll
            for (int j = 0; j < 8; ++j) { const float cs = rt[j], sn = rt[16 + j]; const float a = lo[j], bb = hi[j]; lo[j] = a * cs - bb * sn; hi[j] = bb * cs + a * sn; } }
        *(LAS v4u*)(Qs + row * 72 + d0) = pack8(lo); *(LAS v4u*)(Qs + row * 72 + d0 + 16) = pack8(hi);
    }
    __syncthreads();
    bf16x8 qa[2];
#pragma unroll
    for (int ks = 0; ks < 2; ++ks) qa[ks] = *(const LAS bf16x8*)(Qs + (16 * w + lr) * 72 + ks * 32 + lg * 8);
    const float sink = ((const float*)(const __attribute__((address_space(1))) float*)p.in[I_SINK])[l * 8 + h];
    float mrow[4], lrow[4]; f32x4 oacc[4];
#pragma unroll
    for (int j = 0; j < 4; ++j) { mrow[j] = sink; lrow[j] = (lr == 0) ? 1.0f : 0.0f; }
#pragma unroll
    for (int db = 0; db < 4; ++db) oacc[db] = zero4();
    const int ntile = ictx ? 4 : 10;
    for (int kt = 0; kt < ntile; ++kt) {
        const bool band = !ictx && kt < 6;
        const int kpos0 = (qblk - 1) * 128 + kt * 64;
        if (band && (kpos0 < 0 || kpos0 >= SEQ)) continue;
        const size_t krow0 = band ? (size_t)b * SEQ + kpos0 : (size_t)ML + b * CTXL + (ictx ? kt : kt - 6) * 64;
        __syncthreads();
        if (tid < 256) {
            const int row = tid >> 2, part = tid & 3, d0 = (part & 1) * 8 + (part >> 1) * 32;
            const bf16* src = ((bf16*)(c.ws + WS_P1)) + (krow0 + row) * LP + C_K + hk * 64 + d0;
            float lo[8], hi[8]; unpack8(*(const v4u*)src, lo); unpack8(*(const v4u*)(src + 16), hi);
            if (band) { const int t = kpos0 + row, pos = (part >> 1) ? (t & 63) : (t >> 6); const float* rt = ((const float*)(c.ws + WS_ROPE)) + pos * 32 + (d0 & 15);
#pragma unroll
                for (int j = 0; j < 8; ++j) { const float cs = rt[j], sn = rt[16 + j]; const float a = lo[j], bb = hi[j]; lo[j] = a * cs - bb * sn; hi[j] = bb * cs + a * sn; } }
            *(LAS v4u*)(Ks + row * 72 + d0) = pack8(lo); *(LAS v4u*)(Ks + row * 72 + d0 + 16) = pack8(hi);
        }
        {
            const int key = tid >> 3, dg = tid & 7;
            const v4u vv = *(const v4u*)(((bf16*)(c.ws + WS_P1)) + (krow0 + key) * LP + C_V + hk * 64 + dg * 8);
            LAS bf16* d = Vt + (dg * 8) * 72 + key;
            d[0] = (bf16)(vv.x & 0xffffu); d[72] = (bf16)(vv.x >> 16); d[144] = (bf16)(vv.y & 0xffffu); d[216] = (bf16)(vv.y >> 16);
            d[288] = (bf16)(vv.z & 0xffffu); d[360] = (bf16)(vv.z >> 16); d[432] = (bf16)(vv.w & 0xffffu); d[504] = (bf16)(vv.w >> 16);
        }
        __syncthreads();
        f32x4 s[4];
#pragma unroll
        for (int nb = 0; nb < 4; ++nb) { s[nb] = zero4();
#pragma unroll
            for (int ks = 0; ks < 2; ++ks) { const bf16x8 kb = *(const LAS bf16x8*)(Ks + (nb * 16 + lr) * 72 + ks * 32 + lg * 8); s[nb] = MFMA16(qa[ks], kb, s[nb]); } }
        float mx[4];
#pragma unroll
        for (int j = 0; j < 4; ++j) mx[j] = -3.0e38f;
#pragma unroll
        for (int nb = 0; nb < 4; ++nb)
#pragma unroll
            for (int j = 0; j < 4; ++j) { float v = s[nb][j] * 0.125f;
                if (band) { const int kp = kpos0 + nb * 16 + lr, qp = qblk * 128 + 16 * w + lg * 4 + j; const int dd = kp - qp; if (dd > 128 || dd < -128) v = -1.0e30f; }
                s[nb][j] = v; mx[j] = fmaxf(mx[j], v); DBGF(!(fabsf(v) < 1e31f), 7); }
        float corr[4];
#pragma unroll
        for (int j = 0; j < 4; ++j) { float v = mx[j]; v = fmaxf(v, shx(v, 1)); v = fmaxf(v, shx(v, 2)); v = fmaxf(v, shx(v, 4)); v = fmaxf(v, shx(v, 8));
            const float mn = fmaxf(mrow[j], v); corr[j] = __expf(mrow[j] - mn); mrow[j] = mn; lrow[j] *= corr[j]; }
#pragma unroll
        for (int nb = 0; nb < 4; ++nb)
#pragma unroll
            for (int j = 0; j < 4; ++j) { const float pv = __expf(s[nb][j] - mrow[j]); lrow[j] += pv; DBGF(!(pv <= 1.0f && pv >= 0.f), 8); Ps[(lg * 4 + j) * 72 + nb * 16 + lr] = (bf16)(pk2(pv, 0.f) & 0xffffu); }
#pragma unroll
        for (int db = 0; db < 4; ++db)
#pragma unroll
            for (int j = 0; j < 4; ++j) oacc[db][j] *= corr[j];
        LDS_FENCE();
        bf16x8 pa[2];
#pragma unroll
        for (int ks = 0; ks < 2; ++ks) pa[ks] = *(const LAS bf16x8*)(Ps + lr * 72 + ks * 32 + lg * 8);
#pragma unroll
        for (int db = 0; db < 4; ++db)
#pragma unroll
            for (int ks = 0; ks < 2; ++ks) { const bf16x8 vb = *(const LAS bf16x8*)(Vt + (db * 16 + lr) * 72 + ks * 32 + lg * 8); oacc[db] = MFMA16(pa[ks], vb, oacc[db]); }
        LDS_FENCE();
    }
#pragma unroll
    for (int j = 0; j < 4; ++j) { float v = lrow[j]; v += shx(v, 1); v += shx(v, 2); v += shx(v, 4); v += shx(v, 8); DBGF(!(v >= 0.999f), 9); lrow[j] = 1.0f / v; }
    for (int db = 0; db < 4; ++db) for (int j = 0; j < 4; ++j) DBGF(!(fabsf(oacc[db][j]) < 16384.f), 10);
#pragma unroll
    for (int db = 0; db < 4; ++db)
#pragma unroll
        for (int j = 0; j < 4; ++j) ((bf16*)(c.ws + WS_BO))[(qrow0 + 16 * w + lg * 4 + j) * LBO + h * 64 + db * 16 + lr] = (bf16)(pk2(oacc[db][j] * lrow[j], 0.f) & 0xffffu);
    __syncthreads();
}

#define DPP_ROR(v, n) __builtin_bit_cast(float, __builtin_amdgcn_update_dpp(0, __builtin_bit_cast(int, (v)), 0x120 + (n), 0xf, 0xf, false))
__device__ __forceinline__ float row16_max(float v) { v = fmaxf(v, DPP_ROR(v, 8)); v = fmaxf(v, DPP_ROR(v, 4)); v = fmaxf(v, DPP_ROR(v, 2)); v = fmaxf(v, DPP_ROR(v, 1)); return v; }
__device__ __forceinline__ float row16_sum(float v) { v += DPP_ROR(v, 8); v += DPP_ROR(v, 4); v += DPP_ROR(v, 2); v += DPP_ROR(v, 1); return v; }
__device__ __forceinline__ void rope8(const float* rt, float (&lo)[8], float (&hi)[8]) {
    const f32x4 c0 = *(const f32x4*)rt, c1 = *(const f32x4*)(rt + 4), s0 = *(const f32x4*)(rt + 16), s1 = *(const f32x4*)(rt + 20);
    const float cs[8] = {c0.x, c0.y, c0.z, c0.w, c1.x, c1.y, c1.z, c1.w}, sn[8] = {s0.x, s0.y, s0.z, s0.w, s1.x, s1.y, s1.z, s1.w};
#pragma unroll
    for (int j = 0; j < 8; ++j) { const float a = lo[j], bb = hi[j]; lo[j] = a * cs[j] - bb * sn[j]; hi[j] = bb * cs[j] + a * sn[j]; }
}
__device__ __forceinline__ void attn_stage(const bf16* p1, const float* rope, int tid, int b, int hk, int qblk, bool ictx, int kt, LAS bf16* Ks, LAS bf16* Vt) {
    const bool band = !ictx && kt < 6; const int kpos0 = (qblk - 1) * 128 + kt * 64;
    const size_t krow0 = band ? (size_t)b * SEQ + kpos0 : (size_t)ML + b * CTXL + (ictx ? kt : kt - 6) * 64;
    if (tid < 256) {
        const int row = tid >> 2, part = tid & 3, d0 = (part & 1) * 8 + (part >> 1) * 32;
        const bf16* src = p1 + (krow0 + row) * LP + C_K + hk * 64 + d0;
        float lo[8], hi[8]; unpack8(*(const v4u*)src, lo); unpack8(*(const v4u*)(src + 16), hi);
        if (band) { const int t = kpos0 + row, pos = (part >> 1) ? (t & 63) : (t >> 6); rope8(rope + pos * 32 + (d0 & 15), lo, hi); }
        *(LAS v4u*)(Ks + row * 72 + d0) = pack8(lo); *(LAS v4u*)(Ks + row * 72 + d0 + 16) = pack8(hi);
    }
    { const int key = tid >> 3, dg = tid & 7;
      const v4u vv = *(const v4u*)(p1 + (krow0 + key) * LP + C_V + hk * 64 + dg * 8);
      LAS bf16* d = Vt + (dg * 8) * 72 + key;
      d[0] = (bf16)(vv.x & 0xffffu); d[72] = (bf16)(vv.x >> 16); d[144] = (bf16)(vv.y & 0xffffu); d[216] = (bf16)(vv.y >> 16);
      d[288] = (bf16)(vv.z & 0xffffu); d[360] = (bf16)(vv.z >> 16); d[432] = (bf16)(vv.w & 0xffffu); d[504] = (bf16)(vv.w >> 16); }
}
__device__ __forceinline__ bool attn_tile_ok(bool ictx, int qblk, int kt) { if (ictx || kt >= 6) return true; const int kpos0 = (qblk - 1) * 128 + kt * 64; return kpos0 >= 0 && kpos0 < SEQ; }
__device__ __forceinline__ void attn_unit4(Ctx& c, int l, int b, int hk, int qblk, bool ictx) {
    TLW;
    const __attribute__((address_space(4))) Params& p = *c.p;
    LAS bf16* Qs = (LAS bf16*)c.lds;
    LAS bf16* KB = (LAS bf16*)(c.lds + 73728);
    LAS bf16* VB = (LAS bf16*)(c.lds + 73728 + 18432);
    LAS bf16* Ps = (LAS bf16*)(c.lds + 73728 + 36864) + wave_ * (16 * 72);
    const int tid = tid_, lane = lane_, w = wave_, lr = lane & 15, lg = lane >> 4, g = w >> 1, half = w & 1;
    const bf16* p1 = ((bf16*)(c.ws + WS_P1)); const float* rope = ((const float*)(c.ws + WS_ROPE));
    const size_t qrow0 = ictx ? (size_t)ML + b * CTXL + qblk * 128 : (size_t)b * SEQ + qblk * 128;
#pragma unroll
    for (int rep = 0; rep < 4; ++rep) {
        const int it = tid + rep * 512, hh = it >> 9, row = (it >> 2) & 127, part = it & 3, d0 = (part & 1) * 8 + (part >> 1) * 32;
        const bf16* src = p1 + (qrow0 + row) * LP + C_Q + (hk * 4 + hh) * 64 + d0;
        float lo[8], hi[8]; unpack8(*(const v4u*)src, lo); unpack8(*(const v4u*)(src + 16), hi);
        if (!ictx) { const int t = qblk * 128 + row, pos = (part >> 1) ? (t & 63) : (t >> 6); rope8(rope + pos * 32 + (d0 & 15), lo, hi); }
        *(LAS v4u*)(Qs + (hh * 128 + row) * 72 + d0) = pack8(lo); *(LAS v4u*)(Qs + (hh * 128 + row) * 72 + d0 + 16) = pack8(hi);
    }
    const int ntile = ictx ? 4 : 10;
    int kt = 0; while (!attn_tile_ok(ictx, qblk, kt)) ++kt;
    attn_stage(p1, rope, tid, b, hk, qblk, ictx, kt, KB, VB);
    __syncthreads();
    constexpr float L2E = 1.4426950408889634f, QSC = 0.125f * L2E;
    const int ol_ = olane();
    const float sink2 = ((const float*)(const __attribute__((address_space(1))) float*)p.in[I_SINK])[l * 8 + hk * 4 + g] * L2E;
    float mrow[4], lrow[4]; f32x4 oacc[4][4];
#pragma unroll
    for (int rb = 0; rb < 4; ++rb) { mrow[rb] = sink2; lrow[rb] = (lg == 0) ? 1.0f : 0.0f;
#pragma unroll
        for (int db = 0; db < 4; ++db) oacc[rb][db] = zero4(); }
    int buf = 0;
    while (kt < ntile) {
        int kn = kt + 1; while (kn < ntile && !attn_tile_ok(ictx, qblk, kn)) ++kn;
        if (kn < ntile) attn_stage(p1, rope, tid, b, hk, qblk, ictx, kn, KB + (buf ^ 1) * (64 * 72), VB + (buf ^ 1) * (64 * 72));
        const LAS bf16* Ks = KB + buf * (64 * 72); const LAS bf16* Vt = VB + buf * (64 * 72);
        const bool msk = !ictx && (kt < 2 || kt == 4 || kt == 5); const int kpos0 = (qblk - 1) * 128 + kt * 64;
        bf16x8 vf[4][2];
#pragma unroll
        for (int db = 0; db < 4; ++db)
#pragma unroll
            for (int ks = 0; ks < 2; ++ks) { const v2u a0 = *(const LAS v2u*)(Vt + (db * 16 + lr) * 72 + ks * 32 + lg * 4), a1 = *(const LAS v2u*)(Vt + (db * 16 + lr) * 72 + ks * 32 + 16 + lg * 4);
                vf[db][ks] = __builtin_bit_cast(bf16x8, (v4u){a0.x, a0.y, a1.x, a1.y}); }
#pragma unroll
        for (int rb = 0; rb < 4; ++rb) {
            if (msk) { const int q0_ = qblk * 128 + half * 64 + rb * 16; if (kpos0 > q0_ + 15 + 128 || kpos0 + 63 < q0_ - 128) continue; }
            f32x4 st[4];
            const bf16x8 qa0 = *(const LAS bf16x8*)(Qs + (g * 128 + half * 64 + rb * 16 + lr) * 72 + lg * 8), qa1 = *(const LAS bf16x8*)(Qs + (g * 128 + half * 64 + rb * 16 + lr) * 72 + 32 + lg * 8);
#pragma unroll
            for (int nb = 0; nb < 4; ++nb) { const bf16x8 kb0 = *(const LAS bf16x8*)(Ks + (nb * 16 + lr) * 72 + lg * 8), kb1 = *(const LAS bf16x8*)(Ks + (nb * 16 + lr) * 72 + 32 + lg * 8);
                st[nb] = MFMA16(kb0, qa0, ((f32x4){0.f, 0.f, 0.f, 0.f})); st[nb] = MFMA16(kb1, qa1, st[nb]); }
            float mx = -3.0e38f;
#pragma unroll
            for (int nb = 0; nb < 4; ++nb)
#pragma unroll
                for (int j = 0; j < 4; ++j) { float v = st[nb][j] * QSC;
                    if (msk) { const int kp = kpos0 + nb * 16 + lg * 4 + j, qp = qblk * 128 + half * 64 + rb * 16 + lr; const int dd = kp - qp; if (dd > 128 || dd < -128) v = -1.0e30f; }
                    st[nb][j] = v; mx = fmaxf(mx, v); }
            mx = fmaxf(mx, shi(mx, ol_ ^ 16)); mx = fmaxf(mx, shi(mx, ol_ ^ 32));
            const float mn = fmaxf(mrow[rb], mx), corr = __builtin_amdgcn_exp2f(mrow[rb] - mn); mrow[rb] = mn;
            float ls = 0.f;
#pragma unroll
            for (int nb = 0; nb < 4; ++nb)
#pragma unroll
                for (int j = 0; j < 4; ++j) { const float pv = __builtin_amdgcn_exp2f(st[nb][j] - mn); st[nb][j] = pv; ls += pv; }
            lrow[rb] = lrow[rb] * corr + ls;
            bf16x8 pb[2];
#pragma unroll
            for (int ks = 0; ks < 2; ++ks) pb[ks] = __builtin_bit_cast(bf16x8, (v4u){pk2(st[2 * ks][0], st[2 * ks][1]), pk2(st[2 * ks][2], st[2 * ks][3]), pk2(st[2 * ks + 1][0], st[2 * ks + 1][1]), pk2(st[2 * ks + 1][2], st[2 * ks + 1][3])});
#pragma unroll
            for (int db = 0; db < 4; ++db) { oacc[rb][db] = oacc[rb][db] * corr;
#pragma unroll
                for (int ks = 0; ks < 2; ++ks) oacc[rb][db] = MFMA16(vf[db][ks], pb[ks], oacc[rb][db]); }
        }
        __syncthreads();
        kt = kn; buf ^= 1;
    }
    bf16* bo = ((bf16*)(c.ws + WS_BO));
#pragma unroll
    for (int rb = 0; rb < 4; ++rb) {
        float lt = lrow[rb]; lt += shi(lt, ol_ ^ 16); lt += shi(lt, ol_ ^ 32);
        const float inv = 1.0f / lt;
#pragma unroll
        for (int db = 0; db < 4; ++db) { v2u o; o.x = pk2(oacc[rb][db][0] * inv, oacc[rb][db][1] * inv); o.y = pk2(oacc[rb][db][2] * inv, oacc[rb][db][3] * inv);
            *(v2u*)(bo + (qrow0 + half * 64 + rb * 16 + lr) * LBO + (hk * 4 + g) * 64 + db * 16 + lg * 4) = o; }
    }
    __syncthreads();
}

__device__ __forceinline__ void conv_unit(Ctx& c, int l, int u) {
    TLW;
    const __attribute__((address_space(4))) Params& p = *c.p;
    LAS bf16* Zs = (LAS bf16*)c.lds;
    const int r0 = u * 64;
    const int seq_lo = r0 < ML ? (r0 / SEQ) * SEQ : ML + ((r0 - ML) / CTXL) * CTXL, seq_hi = seq_lo + (r0 < ML ? SEQ : CTXL);
    for (int it = tid_; it < 94 * 64; it += 512) {
        const int zr = it >> 6, cg8 = (it & 63) * 8; const int g = r0 - 15 + zr;
        v4u o = zero4u();
        if (g >= seq_lo && g < seq_hi) o = *(const v4u*)(((bf16*)(c.ws + WS_P1)) + (size_t)g * LP + C_GLU + cg8);
        *(LAS v4u*)(Zs + zr * 520 + cg8) = o;
    }
    __syncthreads();
    const int c0 = lane_ * 8, t0 = wave_ * 8;
    const float* wdw = ((const float*)(const __attribute__((address_space(1))) float*)p.in[I_WDW]) + (size_t)l * 31 * 512 + c0;
    float acc[8][8];
    { const f32x4 b0 = *(const f32x4*)(((const float*)(const __attribute__((address_space(1))) float*)p.in[I_BDW]) + l * 512 + c0), b1 = *(const f32x4*)(((const float*)(const __attribute__((address_space(1))) float*)p.in[I_BDW]) + l * 512 + c0 + 4);
#pragma unroll
      for (int t = 0; t < 8; ++t) { acc[t][0] = b0.x; acc[t][1] = b0.y; acc[t][2] = b0.z; acc[t][3] = b0.w; acc[t][4] = b1.x; acc[t][5] = b1.y; acc[t][6] = b1.z; acc[t][7] = b1.w; } }
    float zw[8][8];
#pragma unroll
    for (int t = 0; t < 7; ++t) unpack8(*(const LAS v4u*)(Zs + (t0 + t) * 520 + c0), zw[t]);
    f32x4 wa = *(const f32x4*)(wdw), wb = *(const f32x4*)(wdw + 4);
#pragma unroll 1
    for (int j0 = 0; j0 < 32; j0 += 8) {
#pragma unroll
        for (int jj = 0; jj < 8; ++jj) {
            const int j = j0 + jj;
            if (j <= 30) {
                unpack8(*(const LAS v4u*)(Zs + (t0 + j + 7) * 520 + c0), zw[(jj + 7) & 7]);
                const float wv[8] = {wa.x, wa.y, wa.z, wa.w, wb.x, wb.y, wb.z, wb.w};
                if (j < 30) { wa = *(const f32x4*)(wdw + (j + 1) * 512); wb = *(const f32x4*)(wdw + (j + 1) * 512 + 4); }
#pragma unroll
                for (int t = 0; t < 8; ++t)
#pragma unroll
                    for (int i = 0; i < 8; ++i) acc[t][i] += wv[i] * zw[(jj + t) & 7][i];
            }
        }
    }
    const f32x4 g0 = *(const f32x4*)(((const float*)(const __attribute__((address_space(1))) float*)p.in[I_GCLN]) + l * 512 + c0), g1 = *(const f32x4*)(((const float*)(const __attribute__((address_space(1))) float*)p.in[I_GCLN]) + l * 512 + c0 + 4);
    const f32x4 e0 = *(const f32x4*)(((const float*)(const __attribute__((address_space(1))) float*)p.in[I_BCLN]) + l * 512 + c0), e1 = *(const f32x4*)(((const float*)(const __attribute__((address_space(1))) float*)p.in[I_BCLN]) + l * 512 + c0 + 4);
    const float gg[8] = {g0.x, g0.y, g0.z, g0.w, g1.x, g1.y, g1.z, g1.w}, ee[8] = {e0.x, e0.y, e0.z, e0.w, e1.x, e1.y, e1.z, e1.w};
    float sm[8], sq[8];
#pragma unroll
    for (int t = 0; t < 8; ++t) { float s = 0.f;
#pragma unroll
        for (int i = 0; i < 8; ++i) s += acc[t][i];
        sm[t] = s; }
    wave_sum8(sm);
#pragma unroll
    for (int t = 0; t < 8; ++t) { const float mean = sm[t] * (1.0f / 512.0f); float q = 0.f;
#pragma unroll
        for (int i = 0; i < 8; ++i) { acc[t][i] -= mean; q += acc[t][i] * acc[t][i]; }
        sq[t] = q; }
    wave_sum8(sq);
#pragma unroll
    for (int t = 0; t < 8; ++t) {
        const float rstd = rsqrtf(sq[t] * (1.0f / 512.0f) + EPS);
        float y[8];
#pragma unroll
        for (int i = 0; i < 8; ++i) { const float v = acc[t][i] * rstd * gg[i] + ee[i]; y[i] = siluf_(v); }
        *(v4u*)(((bf16*)(c.ws + WS_BO)) + (size_t)(r0 + t0 + t) * LBO + 512 + c0) = pack8(y);
    }
    __syncthreads();
}

__device__ __forceinline__ void qk_conv8(const bf16* p1, const float* wmc, int row, int seq_lo, int seq_hi, int col, float scale, float (&o)[8]) {
    float xm[8], x0[8], xp[8];
    const bool hm = row - 1 >= seq_lo, hp = row + 1 < seq_hi;
    const v4u r0_ = *(const v4u*)(p1 + (size_t)row * LP + C_QKM + col), rm_ = *(const v4u*)(p1 + (size_t)(hm ? row - 1 : row) * LP + C_QKM + col), rp_ = *(const v4u*)(p1 + (size_t)(hp ? row + 1 : row) * LP + C_QKM + col);
    unpack8(r0_, x0); unpack8(rm_, xm); unpack8(rp_, xp);
#pragma unroll
    for (int i = 0; i < 8; ++i) { xm[i] = hm ? xm[i] : 0.f; xp[i] = hp ? xp[i] : 0.f; }
    const f32x4 wa0 = *(const f32x4*)(wmc + col), wa1 = *(const f32x4*)(wmc + col + 4), wb0 = *(const f32x4*)(wmc + 1024 + col), wb1 = *(const f32x4*)(wmc + 1024 + col + 4), wc0 = *(const f32x4*)(wmc + 2048 + col), wc1 = *(const f32x4*)(wmc + 2048 + col + 4);
    const float wa[8] = {wa0.x, wa0.y, wa0.z, wa0.w, wa1.x, wa1.y, wa1.z, wa1.w}, wb[8] = {wb0.x, wb0.y, wb0.z, wb0.w, wb1.x, wb1.y, wb1.z, wb1.w}, wc[8] = {wc0.x, wc0.y, wc0.z, wc0.w, wc1.x, wc1.y, wc1.z, wc1.w};
#pragma unroll
    for (int i = 0; i < 8; ++i) { const float v = wa[i] * xm[i] + wb[i] * x0[i] + wc[i] * xp[i]; o[i] = siluf_(v) * scale; }
}
__device__ __forceinline__ void chunk_rows(int b, int jc, int& r0, int& seq_lo, int& seq_hi) {
    if (jc < 4) { seq_lo = ML + b * CTXL; seq_hi = seq_lo + CTXL; r0 = seq_lo + jc * 64; } else { seq_lo = b * SEQ; seq_hi = seq_lo + SEQ; r0 = seq_lo + (jc - 4) * 64; }
}
__device__ __forceinline__ void m1_unit(Ctx& c, int l, int b, int h, int jc) {
    TLW;
    const __attribute__((address_space(4))) Params& p = *c.p;
    LAS bf16* Vt = (LAS bf16*)c.lds;
    LAS bf16* Kt = (LAS bf16*)(c.lds + 18432);
    LAS float* wts = (LAS float*)(c.lds + 36864);
    const int tid = tid_, lane = lane_, w = wave_, lr = lane & 15, lg = lane >> 4;
    const bf16* p1 = ((bf16*)(c.ws + WS_P1));
    int r0, seq_lo, seq_hi; chunk_rows(b, jc, r0, seq_lo, seq_hi);
    const int chf = (b * 4 + h) * 2, chb = chf + 1, pf = jc, pb = jc < 4 ? 3 - jc : 71 - jc;
    if (w == 0) {
        const bf16* gp = p1 + (size_t)(r0 + lane) * LP + C_GM + h; const float* bm = ((const float*)(const __attribute__((address_space(1))) float*)p.in[I_BMG]) + l * 16 + h;
        const float i_f = bf2f(gp[0]) + bm[0], i_b = bf2f(gp[4]) + bm[4], lf_f = logsigf_(bf2f(gp[8]) + bm[8]), lf_b = logsigf_(bf2f(gp[12]) + bm[12]);
        const float cf = scan_add(lf_f, lane), cb = scan_add(lf_b, lane);
        const float bend_f = shi(cf, 63), bend_b = shi(cb, 63);
        const float g_f = bend_f - cf + i_f, g_b = (cb - lf_b) + i_b;
        const float mu_f = wave_max(g_f), mu_b = wave_max(g_b);
        wts[lane] = __expf(g_f - mu_f); wts[64 + lane] = __expf(g_b - mu_b);
        if (lane == 0) { float* be = ((float*)(c.ws + WS_BEND)); float* mu = ((float*)(c.ws + WS_MU)); be[chf * NCHUNK + pf] = bend_f; mu[chf * NCHUNK + pf] = mu_f; be[chb * NCHUNK + pb] = bend_b; mu[chb * NCHUNK + pb] = mu_b; }
    } else {
        const float* wmc = ((const float*)(const __attribute__((address_space(1))) float*)p.in[I_WMCONV]) + (size_t)l * 3 * 1024;
#pragma unroll
        for (int k_ = 0; k_ < 3; ++k_) { const int it0 = tid - 64 + k_ * 448; const bool ok = it0 < 1024; const int it = ok ? it0 : 1023;
            const int W = it >> 6, ln = it & 63, cg8 = ((ln >> 4) + 4 * (W & 3)) * 8, s = (ln & 15) + 16 * (W >> 2);
            const v4u vv = *(const v4u*)(p1 + (size_t)(r0 + s) * LP + C_VM + h * 128 + cg8);
            float k[8]; qk_conv8(p1, wmc, r0 + s, seq_lo, seq_hi, 512 + h * 128 + cg8, 0.08838834764831845f, k);
            if (!ok) continue;
            LAS bf16* d = Vt + cg8 * 72 + s;
            d[0] = (bf16)(vv.x & 0xffffu); d[72] = (bf16)(vv.x >> 16); d[144] = (bf16)(vv.y & 0xffffu); d[216] = (bf16)(vv.y >> 16);
            d[288] = (bf16)(vv.z & 0xffffu); d[360] = (bf16)(vv.z >> 16); d[432] = (bf16)(vv.w & 0xffffu); d[504] = (bf16)(vv.w >> 16);
            const v4u kk = pack8(k); LAS bf16* e = Kt + cg8 * 72 + s;
            e[0] = (bf16)(kk.x & 0xffffu); e[72] = (bf16)(kk.x >> 16); e[144] = (bf16)(kk.y & 0xffffu); e[216] = (bf16)(kk.y >> 16);
            e[288] = (bf16)(kk.z & 0xffffu); e[360] = (bf16)(kk.z >> 16); e[432] = (bf16)(kk.w & 0xffffu); e[504] = (bf16)(kk.w >> 16);
        }
    }
    __syncthreads();
    bf16x8 vaf[2], vab[2];
#pragma unroll
    for (int ks = 0; ks < 2; ++ks) {
        float vf[8]; unpack8(*(const LAS v4u*)(Vt + (16 * w + lr) * 72 + ks * 32 + lg * 8), vf);
        const f32x4 f0 = *(const LAS f32x4*)(wts + ks * 32 + lg * 8), f1 = *(const LAS f32x4*)(wts + ks * 32 + lg * 8 + 4), b0 = *(const LAS f32x4*)(wts + 64 + ks * 32 + lg * 8), b1 = *(const LAS f32x4*)(wts + 64 + ks * 32 + lg * 8 + 4);
        const float xf[8] = {vf[0] * f0.x, vf[1] * f0.y, vf[2] * f0.z, vf[3] * f0.w, vf[4] * f1.x, vf[5] * f1.y, vf[6] * f1.z, vf[7] * f1.w};
        const float xb[8] = {vf[0] * b0.x, vf[1] * b0.y, vf[2] * b0.z, vf[3] * b0.w, vf[4] * b1.x, vf[5] * b1.y, vf[6] * b1.z, vf[7] * b1.w};
        vaf[ks] = __builtin_bit_cast(bf16x8, pack8(xf)); vab[ks] = __builtin_bit_cast(bf16x8, pack8(xb));
    }
    bf16* stf = ((bf16*)(c.ws + WS_ST)) + ((size_t)chf * NCHUNK + pf) * 16384; bf16* stb = ((bf16*)(c.ws + WS_ST)) + ((size_t)chb * NCHUNK + pb) * 16384;
#pragma unroll
    for (int m = 0; m < 4; ++m) {
        f32x4 af[2], ab[2];
#pragma unroll
        for (int hh = 0; hh < 2; ++hh) { af[hh] = zero4(); ab[hh] = zero4();
            const int dkrow = 32 * m + 8 * (lr >> 2) + 4 * hh + (lr & 3);
#pragma unroll
            for (int ks = 0; ks < 2; ++ks) { const bf16x8 kb = *(const LAS bf16x8*)(Kt + dkrow * 72 + ks * 32 + lg * 8); af[hh] = MFMA16(kb, vaf[ks], af[hh]); ab[hh] = MFMA16(kb, vab[ks], ab[hh]); } }
        const float rf[8] = {af[0][0], af[0][1], af[0][2], af[0][3], af[1][0], af[1][1], af[1][2], af[1][3]}, rbk[8] = {ab[0][0], ab[0][1], ab[0][2], ab[0][3], ab[1][0], ab[1][1], ab[1][2], ab[1][3]};
        *(v4u*)(stf + (16 * w + lr) * 128 + 32 * m + 8 * lg) = pack8(rf); *(v4u*)(stb + (16 * w + lr) * 128 + 32 * m + 8 * lg) = pack8(rbk);
    }
    if (tid < 256) { const int dir = tid >> 7, dk = tid & 127; const LAS bf16* Kd = Kt + dk * 72; const LAS float* wd = wts + dir * 64; float sm = 0.f;
#pragma unroll 8
        for (int i = 0; i < 64; ++i) sm += bf2f(Kd[i]) * wd[i];
        ((float*)(c.ws + WS_NS))[((size_t)(dir ? chb : chf) * NCHUNK + (dir ? pb : pf)) * 128 + dk] = sm; }
    __syncthreads();
}
__device__ __forceinline__ void phase_m2(Ctx& c) {
    TLW;
    for (int gid = c.bid * 512 + tid_; gid < 32 * 4096; gid += c.nblk * 512) {
        const int ch = gid >> 12, e4 = gid & 4095;
        v2u* sp = (v2u*)(((bf16*)(c.ws + WS_ST)) + (size_t)ch * NCHUNK * 16384) + e4;
        f32x4* np = (f32x4*)(((float*)(c.ws + WS_NS)) + (size_t)ch * NCHUNK * 128) + (e4 & 31);
        const float* be = ((float*)(c.ws + WS_BEND)) + ch * NCHUNK; const float* mu = ((float*)(c.ws + WS_MU)) + ch * NCHUNK; float* ms = ((float*)(c.ws + WS_MS)) + ch * NCHUNK;
        const bool do_n = e4 < 32;
        float m = -1.0e30f; f32x4 cs = zero4(), nsv = zero4();
#pragma unroll 1
        for (int q0 = 0; q0 < NCHUNK - 1; q0 += 16) {
            v2u uv[16]; float bq[16], mq[16]; f32x4 nv[16];
#pragma unroll
            for (int i = 0; i < 16; ++i) if (q0 + i < NCHUNK - 1) { uv[i] = sp[(size_t)(q0 + i) * 4096]; bq[i] = be[q0 + i]; mq[i] = mu[q0 + i]; if (do_n) nv[i] = np[(q0 + i) * 32]; }
#pragma unroll
            for (int i = 0; i < 16; ++i) if (q0 + i < NCHUNK - 1) {
                const float mn = fmaxf(bq[i] + m, mq[i]), dec = __expf(bq[i] + m - mn), sc = __expf(mq[i] - mn);
                cs.x = dec * cs.x + sc * bf2f(uv[i].x & 0xffffu); cs.y = dec * cs.y + sc * bf2f(uv[i].x >> 16); cs.z = dec * cs.z + sc * bf2f(uv[i].y & 0xffffu); cs.w = dec * cs.w + sc * bf2f(uv[i].y >> 16);
                v2u o; o.x = pk2(cs.x, cs.y); o.y = pk2(cs.z, cs.w); sp[(size_t)(q0 + i) * 4096] = o;
                if (do_n) { nsv = nsv * dec + nv[i] * sc; np[(q0 + i) * 32] = nsv; }
                if (e4 == 0) ms[q0 + i] = mn;
                m = mn;
            }
        }
    }
}
__device__ __forceinline__ void m3_unit(Ctx& c, int l, int b, int h, int jc) {
    TLW;
    const __attribute__((address_space(4))) Params& p = *c.p;
    LAS bf16* Qs = (LAS bf16*)c.lds;
    LAS bf16* Ks = (LAS bf16*)(c.lds + 17408);
    LAS bf16* Vt = (LAS bf16*)(c.lds + 34816);
    LAS bf16* Cs = (LAS bf16*)(c.lds + 53248);
    LAS float* HB = (LAS float*)(c.lds + 53248);
    LAS bf16* Ps = (LAS bf16*)(c.lds + 122880) + wave_ * (16 * 72);
    LAS float* sca = (LAS float*)(c.lds + 141312);
    LAS float* nin = (LAS float*)(c.lds + 143360);
    const int tid = tid_, lane = lane_, w = wave_, lr = lane & 15, lg = lane >> 4;
    int r0, seq_lo, seq_hi; chunk_rows(b, jc, r0, seq_lo, seq_hi);
    const int chf = (b * 4 + h) * 2, chb = chf + 1, pf = jc, pb = jc < 4 ? 3 - jc : 71 - jc;
    if (w < 2) {
        const int dir = w, ch = dir ? chb : chf, pp = dir ? pb : pf;
        const bf16* gp = ((bf16*)(c.ws + WS_P1)) + (size_t)(r0 + lane) * LP + C_GM + h + 4 * dir; const float* bm = ((const float*)(const __attribute__((address_space(1))) float*)p.in[I_BMG]) + l * 16 + h + 4 * dir;
        const float ig = bf2f(gp[0]) + bm[0], lf = logsigf_(bf2f(gp[8]) + bm[8]);
        const float m_in = pp > 0 ? ((float*)(c.ws + WS_MS))[ch * NCHUNK + pp - 1] : -1.0e30f;
        const int sl = dir ? 63 - lane : lane;
        const float lfp = shi(lf, sl), igp = shi(ig, sl);
        const float bcum = scan_add(lfp, lane);
        const float beta = igp - bcum;
        const float pmx = scan_max(beta, lane);
        const float a_t = bcum + m_in, mt = fmaxf(a_t, bcum + pmx);
        const float alpha = bcum - mt, wint = __expf(a_t - mt), emt = __expf(-mt);
        LAS float* s = sca + dir * 256;
        s[sl] = alpha; s[64 + sl] = beta; s[128 + sl] = wint; s[192 + sl] = emt;
    }
    if (w >= 2) {
        const float* wmc = ((const float*)(const __attribute__((address_space(1))) float*)p.in[I_WMCONV]) + (size_t)l * 3 * 1024;
        const bf16* p1 = ((bf16*)(c.ws + WS_P1));
#pragma unroll
        for (int k_ = 0; k_ < 6; ++k_) { const int it0 = tid - 128 + k_ * 384; const bool ok = it0 < 2048; const int it = ok ? it0 : 2047;
            const int isk = it >> 10, s = (it >> 4) & 63, cg8 = (it & 15) * 8;
            float o[8]; qk_conv8(p1, wmc, r0 + s, seq_lo, seq_hi, isk * 512 + h * 128 + cg8, isk ? 0.08838834764831845f : 1.0f, o);
            if (ok) *(LAS v4u*)((isk ? Ks : Qs) + s * 136 + cg8) = pack8(o);
        }
#pragma unroll
        for (int k_ = 0; k_ < 3; ++k_) { const int it0 = tid - 128 + k_ * 384; const bool ok = it0 < 1024; const int it = ok ? it0 : 1023;
            const int W = it >> 6, ln = it & 63, cg8 = ((ln >> 4) + 4 * (W & 3)) * 8, s = (ln & 15) + 16 * (W >> 2);
            const v4u vv = *(const v4u*)(p1 + (size_t)(r0 + s) * LP + C_VM + h * 128 + cg8);
            if (!ok) continue;
            LAS bf16* d = Vt + cg8 * 72 + s;
            d[0] = (bf16)(vv.x & 0xffffu); d[72] = (bf16)(vv.x >> 16); d[144] = (bf16)(vv.y & 0xffffu); d[216] = (bf16)(vv.y >> 16);
            d[288] = (bf16)(vv.z & 0xffffu); d[360] = (bf16)(vv.z >> 16); d[432] = (bf16)(vv.w & 0xffffu); d[504] = (bf16)(vv.w >> 16);
        }
#pragma unroll
        for (int dir = 0; dir < 2; ++dir) {
            const int ch = dir ? chb : chf, pp = dir ? pb : pf;
            const v4u* src = (const v4u*)(((bf16*)(c.ws + WS_ST)) + ((size_t)ch * NCHUNK + (pp > 0 ? pp - 1 : 0)) * 16384);
#pragma unroll
            for (int k_ = 0; k_ < 6; ++k_) { const int it0 = tid - 128 + k_ * 384; const bool ok = it0 < 2048; const int it = ok ? it0 : 2047; const int dv = it >> 4, ck = (it & 15) * 8; v4u v = src[it]; if (pp <= 0) v = zero4u();
                if (ok) *(LAS v4u*)(Cs + dir * (128 * 136) + dv * 136 + ck) = v; }
        }
        if (tid - 128 < 256) { const int q = tid - 128, dir = q >> 7, k = q & 127, ch = dir ? chb : chf, pp = dir ? pb : pf; nin[q] = pp > 0 ? ((float*)(c.ws + WS_NS))[((size_t)ch * NCHUNK + pp - 1) * 128 + k] : 0.f; }
    }
    __syncthreads();
    const int dir = w >> 2, rb = w & 3;
    const LAS float* sd = sca + dir * 256;
    const int t = 16 * rb + lr;
    const float al = sd[t], wi = sd[128 + t], em = sd[192 + t];
    bf16x8 qa[4];
#pragma unroll
    for (int ks = 0; ks < 4; ++ks) qa[ks] = *(const LAS bf16x8*)(Qs + t * 136 + ks * 32 + lg * 8);
    f32x4 st[4]; float rs = 0.f;
#pragma unroll
    for (int nb = 0; nb < 4; ++nb) { f32x4 a = zero4();
#pragma unroll
        for (int ks = 0; ks < 4; ++ks) { const bf16x8 kb = *(const LAS bf16x8*)(Ks + (nb * 16 + lr) * 136 + ks * 32 + lg * 8); a = MFMA16(kb, qa[ks], a); }
        const f32x4 be = *(const LAS f32x4*)(sd + 64 + nb * 16 + lg * 4);
#pragma unroll
        for (int j = 0; j < 4; ++j) { const int s_ = nb * 16 + lg * 4 + j; const bool valid = dir ? (s_ >= t) : (s_ <= t);
            const float pv = valid ? a[j] * __expf(al + be[j]) : 0.f; rs += pv; a[j] = pv; }
        st[nb] = a; }
    bf16x8 pfr[2];
#pragma unroll
    for (int ks = 0; ks < 2; ++ks) pfr[ks] = __builtin_bit_cast(bf16x8, (v4u){pk2(st[2 * ks][0], st[2 * ks][1]), pk2(st[2 * ks][2], st[2 * ks][3]), pk2(st[2 * ks + 1][0], st[2 * ks + 1][1]), pk2(st[2 * ks + 1][2], st[2 * ks + 1][3])});
    f32x4 oacc[8];
#pragma unroll
    for (int db = 0; db < 8; ++db) { f32x4 a = zero4();
#pragma unroll
        for (int ks = 0; ks < 4; ++ks) { const bf16x8 cb = *(const LAS bf16x8*)(Cs + dir * (128 * 136) + (db * 16 + lr) * 136 + ks * 32 + lg * 8); a = MFMA16(cb, qa[ks], a); }
        a = a * wi;
#pragma unroll
        for (int ks = 0; ks < 2; ++ks) { const v2u a0 = *(const LAS v2u*)(Vt + (db * 16 + lr) * 72 + ks * 32 + lg * 4), a1 = *(const LAS v2u*)(Vt + (db * 16 + lr) * 72 + ks * 32 + 16 + lg * 4);
            a = MFMA16(__builtin_bit_cast(bf16x8, (v4u){a0.x, a0.y, a1.x, a1.y}), pfr[ks], a); }
        oacc[db] = a; }
    float qn = 0.f;
    { const LAS bf16* qr = Qs + t * 136 + lg * 32; const LAS float* nn = nin + dir * 128 + lg * 32;
#pragma unroll
      for (int k8 = 0; k8 < 4; ++k8) { float qf[8]; unpack8(*(const LAS v4u*)(qr + k8 * 8), qf);
#pragma unroll
          for (int i = 0; i < 8; ++i) qn += qf[i] * nn[k8 * 8 + i]; } }
    { const int ol = olane(); const float q1 = shi(qn, ol ^ 16), r1 = shi(rs, ol ^ 16); qn += q1; rs += r1; const float q2 = shi(qn, ol ^ 32), r2 = shi(rs, ol ^ 32); qn += q2; rs += r2; }
    const float inv = 1.0f / fmaxf(fabsf(wi * qn + rs), em);
    __syncthreads();
#pragma unroll
    for (int db = 0; db < 8; ++db) *(LAS f32x4*)(HB + dir * (64 * 132) + t * 132 + db * 16 + lg * 4) = oacc[db] * inv;
    __syncthreads();
    const float g0 = ((const float*)(const __attribute__((address_space(1))) float*)p.in[I_GMN])[l * 512 + h * 128 + 2 * lane], g1 = ((const float*)(const __attribute__((address_space(1))) float*)p.in[I_GMN])[l * 512 + h * 128 + 2 * lane + 1];
    float v0[8], v1[8], sm[8], sq[8];
#pragma unroll
    for (int tt = 0; tt < 8; ++tt) {
        const int t = 8 * w + tt;
        const unsigned ov = *(const unsigned*)(((bf16*)(c.ws + WS_P1)) + (size_t)(r0 + t) * LP + C_OM + h * 128 + 2 * lane);
        float a0 = HB[t * 132 + 2 * lane] + HB[64 * 132 + t * 132 + 2 * lane], a1 = HB[t * 132 + 2 * lane + 1] + HB[64 * 132 + t * 132 + 2 * lane + 1];
        a0 *= sigmoidf_(bf2f(ov & 0xffffu)); a1 *= sigmoidf_(bf2f(ov >> 16));
        v0[tt] = a0; v1[tt] = a1; sm[tt] = a0 + a1;
    }
    wave_sum8(sm);
#pragma unroll
    for (int tt = 0; tt < 8; ++tt) { const float mean = sm[tt] * (1.0f / 128.0f); v0[tt] -= mean; v1[tt] -= mean; sq[tt] = v0[tt] * v0[tt] + v1[tt] * v1[tt]; }
    wave_sum8(sq);
#pragma unroll
    for (int tt = 0; tt < 8; ++tt) { const float rstd = rsqrtf(sq[tt] * (1.0f / 128.0f) + EPS);
        *(unsigned*)(((bf16*)(c.ws + WS_BO)) + (size_t)(r0 + 8 * w + tt) * LBO + 1024 + h * 128 + 2 * lane) = pk2(v0[tt] * rstd * g0, v1[tt] * rstd * g1); }
    __syncthreads();
}


#ifdef DBGSCAN
__device__ __forceinline__ void scan16(Ctx& c, const bf16* p, size_t rows, int cols, int ld, int code) {
    TLW;
    const int c8 = cols / 8; const size_t n = rows * c8; bool bad = false;
    for (size_t i = (size_t)c.bid * 512 + tid_; i < n; i += (size_t)c.nblk * 512) { const size_t r = i / c8; const int cc = (int)(i % c8) * 8; const v4u v = *(const v4u*)(p + r * ld + cc);
        bad |= ((v.x & 0x7FFFu) > 0x4680u) | (((v.x >> 16) & 0x7FFFu) > 0x4680u) | ((v.y & 0x7FFFu) > 0x4680u) | (((v.y >> 16) & 0x7FFFu) > 0x4680u) | ((v.z & 0x7FFFu) > 0x4680u) | (((v.z >> 16) & 0x7FFFu) > 0x4680u) | ((v.w & 0x7FFFu) > 0x4680u) | (((v.w >> 16) & 0x7FFFu) > 0x4680u); }
    if (bad) atomicMin((int*)(c.ws + WS_DBG), code);
}
__device__ __forceinline__ void scan32(Ctx& c, const float* p, size_t n, int code) {
    TLW;
    bool bad = false;
    for (size_t i = (size_t)c.bid * 512 + tid_; i < n; i += (size_t)c.nblk * 512) { bad |= !(fabsf(p[i]) < 16384.0f); }
    if (bad) atomicMin((int*)(c.ws + WS_DBG), code);
}
__device__ __forceinline__ void dbg_scan(Ctx& c, int ph) {
    TLW;
    if (ph == 0) { if (c.bid == 0 && tid_ == 0) *(int*)(c.ws + WS_DBG) = 0x7fffffff; return; }
    if (ph >= NPHASE - 1) return;
    const int sp = (ph - 1) % 10, code = ph > 11 ? 56 + ph : 20 + ph * 4;
    if (sp == 0) { scan16(c, ((bf16*)(c.ws + WS_BO)), MT, 1024, 1024, code); scan16(c, ((bf16*)(c.ws + WS_WIN)), 7168, 1024, 1024, code + 1); scan16(c, ((bf16*)(c.ws + WS_WP)), 3072, 512, 512, code + 1);
        scan16(c, ((bf16*)(c.ws + WS_WO3)), 1024, 3072, 3072, code + 1); scan16(c, ((bf16*)(c.ws + WS_WGU)), 5632, 1024, 1024, code + 1); scan16(c, ((bf16*)(c.ws + WS_WD)), 1024, 2816, 2816, code + 1);
        scan32(c, (const float*)(c.ws + WS_MOD), 4 * 5 * 6144, code + 2); scan32(c, c.xl, (size_t)ML * DM, code + 3); scan32(c, (const float*)(c.ws + WS_XC), (size_t)MC * DM, code + 3); }
    else if (sp == 1) { scan16(c, ((bf16*)(c.ws + WS_P1)), MT, 4096, 4096, code); scan16(c, ((bf16*)(c.ws + WS_G)), MT, 3072, 3072, code + 1); }
    else if (sp == 2) { scan16(c, ((bf16*)(c.ws + WS_BO)), MT, 512, 1536, code); scan16(c, ((bf16*)(c.ws + WS_BO)) + 512, MT, 512, 1536, code + 1); scan16(c, ((bf16*)(c.ws + WS_ST)), 32 * 68 * 128, 128, 128, code + 2);
        scan32(c, (const float*)(c.ws + WS_NS), 32 * 68 * 128, code + 3); scan32(c, (const float*)(c.ws + WS_BEND), 32 * 68, code + 3); scan32(c, (const float*)(c.ws + WS_MU), 32 * 68, code + 3); }
    else if (sp == 3) { for (int ch = 0; ch < 32; ++ch) { scan16(c, ((bf16*)(c.ws + WS_ST)) + (size_t)ch * 68 * 16384, 67 * 128, 128, 128, code); scan32(c, (const float*)(c.ws + WS_NS) + ch * 68 * 128, 67 * 128, code + 1); scan32(c, (const float*)(c.ws + WS_MS) + ch * 68, 67, code + 2); } }
    else if (sp == 4) scan16(c, ((bf16*)(c.ws + WS_BO)) + 1024, MT, 512, 1536, code);
    else if (sp == 5) scan16(c, ((bf16*)(c.ws + WS_G)), MT, 3072, 3072, code);
    else if (sp == 6 || sp == 9) { scan32(c, c.xl, (size_t)ML * DM, code); scan32(c, (const float*)(c.ws + WS_XC), (size_t)MC * DM, code + 1); }
    else if (sp == 7) scan16(c, ((bf16*)(c.ws + WS_BO)), MT, 1024, 1024, code);
    else if (sp == 8) scan16(c, ((bf16*)(c.ws + WS_P1)), MT, 2816, 2816, code);
}
#endif
template <class Epi, class Sched = pg8::StaticOrder>
__device__ __forceinline__ void run_gemm(Ctx& c, const bf16* A, int lda, int mode, const bf16* Bt, int ldb, int M, int N, int K, const Epi& E) {
    pg8::Gemm g{A, Bt, M, N, K, lda, ldb, mode}; Sched S; S.init(M, N, c.nblk, c.bid);
    pg8::gemm_phase<Epi, Sched, true, true>(c.lds, g, S, E);
}

__global__ void __launch_bounds__(512, 2) mk_fwd(Params prm) {
    extern __shared__ __attribute__((aligned(16))) uchar lds_raw[];
    cg::grid_group grid = cg::this_grid();
    Ctx c; c.p = (const __attribute__((address_space(4))) Params*)__builtin_amdgcn_kernarg_segment_ptr(); c.lds = (LAS uchar*)lds_raw; c.bid = blockIdx.x; c.nblk = gridDim.x;
    { LAS unsigned* misc = (LAS unsigned*)(c.lds + MISC_OFF); if (threadIdx.x < 4) misc[threadIdx.x] = 0u; }
    __syncthreads();
    const XcdBarrier xbar = xcd_barrier_post((unsigned*)(prm.ws + WS_BAR), (volatile LAS unsigned*)(c.lds + MISC_OFF));
    for (int ph = prm.ph_lo; ph < prm.ph_hi; ++ph) {
        { const __attribute__((address_space(4))) Params* pp_ = (const __attribute__((address_space(4))) Params*)__builtin_amdgcn_kernarg_segment_ptr(); asm volatile("" : "+s"(pp_)); c.p = pp_; }
        { __attribute__((address_space(1))) uchar* w_ = (__attribute__((address_space(1))) uchar*)prm.ws; asm volatile("" : "+s"(w_)); c.ws = (uchar*)w_;
          __attribute__((address_space(1))) float* x_ = (__attribute__((address_space(1))) float*)prm.out; asm volatile("" : "+s"(x_)); c.xl = (float*)x_; }
        if (ph == 0) {
#ifndef NO_INIT
 phase_init(c);
#endif
 }
        else if (ph == NPHASE - 1) phase_final(c);
        else {
            const int l = (ph - 1) / 10, sp = (ph - 1) % 10; const bool wctx = l < DEPTH - 1; const int Mx = wctx ? MT : ML;
            if (sp == 0) {
#ifndef NO_CONV
 convert_weights(c, l);
#endif
 phase_norm(c, l, 0, MT, l > 0 ? (const float*)(c.ws + WS_G) : nullptr, 11, ((float*)(c.ws + WS_MOD)) + (size_t)(l > 0 ? l - 1 : 0) * 5 * 6144 + 4 * 6144 + 5120, l == 0 ? ((const float*)(const __attribute__((address_space(1))) float*)c.p->in[I_X]) : nullptr); }
            else if (sp == 1) { EpiP1G E{((bf16*)(c.ws + WS_P1)), ((bf16*)(c.ws + WS_G))}; run_gemm(c, ((bf16*)(c.ws + WS_BO)), DM, 0, ((bf16*)(c.ws + WS_WIN)), DM, MT, NINP, DM, E); }
            else if (sp == 2) {
                const int n_att = 256 + (wctx ? 16 : 0), n_m1 = 16 * NCHUNK, n_conv = Mx / 64;
                if (c.nblk == 256 && wctx) {
                    const int w_ = c.bid;
                    attn_unit4(c, l, w_ >> 6, (w_ >> 5) & 1, w_ & 31, false);
                    if (w_ < 16) attn_unit4(c, l, w_ >> 2, (w_ >> 1) & 1, w_ & 1, true);
                    conv_unit(c, l, w_);
                    if (w_ >= 16 && w_ < 32) conv_unit(c, l, 256 + (w_ - 16));
                    if (w_ < 32) { for (int m = w_; m < 64; m += 32) m1_unit(c, l, m / (4 * NCHUNK), (m / NCHUNK) & 3, m % NCHUNK); }
                    else { for (int m = 64 + (w_ - 32); m < n_m1; m += 224) m1_unit(c, l, m / (4 * NCHUNK), (m / NCHUNK) & 3, m % NCHUNK); }
                } else
                for (int u = c.bid; u < n_att + n_m1 + n_conv; u += c.nblk) {
                    if (u < n_att) { if (u < 256) attn_unit4(c, l, u >> 6, (u >> 5) & 1, u & 31, false); else { const int q = u - 256; attn_unit4(c, l, q >> 2, (q >> 1) & 1, q & 1, true); } }
                    else if (u < n_att + n_m1) { const int m = u - n_att; m1_unit(c, l, m / (4 * NCHUNK), (m / NCHUNK) & 3, m % NCHUNK); }
                    else conv_unit(c, l, u - n_att - n_m1);
                }
            }
            else if (sp == 3) {
#ifndef NO_M2
 phase_m2(c);
#endif
 }
            else if (sp == 4) {
                const int jlo = wctx ? 0 : 4, per = NCHUNK - jlo;
                #ifndef NO_M3
 for (int u = c.bid; u < 16 * per; u += c.nblk) m3_unit(c, l, u / (4 * per), (u / per) & 3, jlo + u % per);
#endif

            }
            else if (sp == 5) {
                { EpiMerge E{((const bf16*)(c.ws + WS_G)), ((bf16*)(c.ws + WS_P1))}; run_gemm<EpiMerge, pg8::Merge3Order>(c, ((bf16*)(c.ws + WS_BO)), LBO, 2, ((bf16*)(c.ws + WS_WP)), 512, ML, DM, 512, E); }
                if (wctx) { EpiGateMul E{((bf16*)(c.ws + WS_G)) + (size_t)ML * NG}; run_gemm(c, ((bf16*)(c.ws + WS_BO)) + (size_t)ML * LBO, LBO, 1, ((bf16*)(c.ws + WS_WP)), 512, MC, NG, 512, E); }
            }
            else if (sp == 6) {
                { EpiResid E{c.xl, ((float*)(c.ws + WS_XC)), ((float*)(c.ws + WS_MOD)) + (size_t)l * 5 * 6144 + 2048, l == 0 ? ((const float*)(const __attribute__((address_space(1))) float*)c.p->in[I_X]) : (const float*)c.xl}; run_gemm(c, ((bf16*)(c.ws + WS_P1)), DM, 0, ((bf16*)(c.ws + WS_WO3)), NG, ML, DM, DM, E); }
                if (wctx) { EpiPartial E{(float*)(c.ws + WS_P1 + 40 * MiB)}; run_gemm(c, ((bf16*)(c.ws + WS_G)) + (size_t)ML * NG, NG, 3, ((bf16*)(c.ws + WS_WO3)), NG, MC, DM * 12, 256, E); }
            }
            else if (sp == 7) phase_norm(c, l, 1, Mx, wctx ? (const float*)(c.ws + WS_P1 + 40 * MiB) : nullptr, 12, ((float*)(c.ws + WS_MOD)) + (size_t)l * 5 * 6144 + 4 * 6144 + 2048, nullptr);
            else if (sp == 8) { EpiSwiGLU E{((bf16*)(c.ws + WS_P1))}; run_gemm(c, ((bf16*)(c.ws + WS_BO)), DM, 0, ((bf16*)(c.ws + WS_WGU)), DM, Mx, 2 * DFF, DM, E); }
            else {
                { EpiResid E{c.xl, ((float*)(c.ws + WS_XC)), ((float*)(c.ws + WS_MOD)) + (size_t)l * 5 * 6144 + 5120, (const float*)c.xl}; run_gemm(c, ((bf16*)(c.ws + WS_P1)), DFF, 0, ((bf16*)(c.ws + WS_WD)), DFF, ML, DM, DFF, E); }
                if (wctx) { EpiPartial E{(float*)(c.ws + WS_G)}; run_gemm(c, ((bf16*)(c.ws + WS_P1)) + (size_t)ML * DFF, DFF, 3, ((bf16*)(c.ws + WS_WD)), DFF, MC, DM * 11, 256, E); }
            }
        }
        if (ph + 1 < prm.ph_hi) { asm volatile("s_waitcnt vmcnt(0) lgkmcnt(0)" ::: "memory"); __syncthreads(); if (ph == prm.ph_lo) grid.sync(); else { __attribute__((address_space(1))) unsigned* bp_ = (__attribute__((address_space(1))) unsigned*)(prm.ws + WS_BAR); asm volatile("" : "+s"(bp_)); XcdBarrier xb2; xb2.bar = (unsigned*)bp_; xb2.x = xbar.x; xb2.st = (volatile LAS unsigned*)(c.lds + MISC_OFF); xcd_barrier(xb2); }
#ifdef PROBE_SYNC2
            grid.sync();
#endif
#ifdef DBGSCAN
            dbg_scan(c, ph); asm volatile("s_waitcnt vmcnt(0) lgkmcnt(0)" ::: "memory"); __syncthreads(); grid.sync();
#endif
        }
    }
}

extern "C" void kernel_launch(void* const* d_in, const int* in_sizes, int n_in, void* d_out, int out_size, void* d_ws, size_t ws_size, hipStream_t stream) {
    static int grid = 0;
    if (grid == 0) {
        if (n_in != 25 || ws_size < WS_END) { fprintf(stderr, "kernel_launch: unexpected n_in %d / ws_size %zu (need %zu)\n", n_in, ws_size, (size_t)WS_END); grid = -1; return; }
        int dev = 0, cus = 0, per_cu = 0;
        hipGetDevice(&dev); hipDeviceGetAttribute(&cus, hipDeviceAttributeMultiprocessorCount, dev);
        if (hipFuncSetAttribute((const void*)mk_fwd, hipFuncAttributeMaxDynamicSharedMemorySize, LDS_BYTES) != hipSuccess) { fprintf(stderr, "kernel_launch: hipFuncSetAttribute failed\n"); }
        if (hipOccupancyMaxActiveBlocksPerMultiprocessor(&per_cu, (const void*)mk_fwd, 512, LDS_BYTES) != hipSuccess || per_cu < 1) { fprintf(stderr, "kernel_launch: occupancy query says %d\n", per_cu); per_cu = 1; }
        (void)hipGetLastError();
        grid = cus * 1;
        fprintf(stderr, "kernel_launch: grid %d (cus %d, per_cu %d)\n", grid, cus, per_cu);
    }
    if (grid < 0) return;
    if (hipMemsetAsync((char*)d_ws + WS_BAR, 0, BAR_BYTES, stream) != hipSuccess) fprintf(stderr, "kernel_launch: memset failed\n");
    Params prm{};
    for (int i = 0; i < 25; ++i) prm.in[i] = (const float*)d_in[i];
    prm.out = (float*)d_out; prm.ws = (uchar*)d_ws;
#if defined(MK_MULTI)
    for (int ph = 0; ph < NPHASE; ++ph) { prm.ph_lo = ph; prm.ph_hi = ph + 1; hipLaunchKernelGGL(mk_fwd, dim3(grid), dim3(512), LDS_BYTES, stream, prm); }
#else
    prm.ph_lo = 0; prm.ph_hi = NPHASE;
    void* args[] = {&prm};
    hipError_t e = hipLaunchCooperativeKernel((const void*)mk_fwd, dim3(grid), dim3(512), args, LDS_BYTES, stream);
    if (e != hipSuccess) fprintf(stderr, "kernel_launch: cooperative launch failed: %s (grid %d)\n", hipGetErrorString(e), grid);
#endif
}
```

```cpp
#include <hip/hip_runtime.h>
#include <hip/hip_cooperative_groups.h>
#include <cstdio>
#include <cstdint>
namespace cg = cooperative_groups;
namespace pg8 {
#define PG8_LAS __attribute__((address_space(3)))
typedef unsigned short bf16_t;
typedef short bf16x8 __attribute__((ext_vector_type(8)));
typedef float f32x4 __attribute__((ext_vector_type(4)));
typedef unsigned u32x4 __attribute__((ext_vector_type(4)));
constexpr int BM = 256, BK = 64, HALF = 128, HTB = HALF * BK * 2  , STAGE_BYTES = 8 * HTB, NXCD = 8, WGM = 8;

__host__ __device__ __forceinline__ int lds_byte(int r, int c) { const int st = (r >> 4) * 2 + (c >> 5), rr = r & 15, cc = c & 31, ob = rr * 64 + cc * 2; return st * 1024 + (ob ^ (((ob >> 9) & 1) << 5)); }
__host__ __device__ __forceinline__ void stage_rc(int b, int& R, int& C) { const int st = b / 1024, sb = b % 1024, swz = sb ^ (((sb >> 9) & 1) << 5); R = (st >> 1) * 16 + swz / 64; C = (st & 1) * 32 + (swz % 64) / 2; }
__host__ __device__ __forceinline__ int perm32(int rho) { const int n = rho >> 4, i = rho & 15; return 8 * (i >> 2) + 4 * n + (i & 3); }

struct Unit { int pm, pn, z; };
struct Gemm { const bf16_t* A; const bf16_t* Bt; int M, N, K, lda, ldb, mode; };
__device__ __forceinline__ size_t op_aoff(const Gemm& g, const Unit& u, size_t tstepA) { size_t o = (size_t)u.pm * tstepA; if (g.mode == 1) o += (size_t)(u.pn >> 2) * 1024; else if (g.mode == 2) o += (size_t)u.z * 1024; else if (g.mode == 3) o += (size_t)(u.pn >> 2) * 512; return o; }
__device__ __forceinline__ size_t op_boff(const Gemm& g, const Unit& u, size_t tstepB) { if (g.mode == 2) return (size_t)(u.z * 4 + u.pn) * tstepB; if (g.mode == 3) return (size_t)(u.pn & 3) * tstepB + (size_t)(u.pn >> 2) * 512; return (size_t)u.pn * tstepB; }

struct StaticOrder {
    int nM, nN, nwg, G, c;
    __host__ __device__ void init(int M, int N, int G_, int c_) { nM = M / BM; nN = N / BM; nwg = nM * nN; G = G_; c = c_; }
    __host__ __device__ bool next(int i, Unit& u) const {
        const long L = (long)i * G + c; if (L >= nwg) return false;
        int wgid = (int)L; { const int q = nwg / NXCD, r = nwg % NXCD, xcd = wgid % NXCD, off = wgid / NXCD; wgid = (xcd < r ? xcd * (q + 1) : r * (q + 1) + (xcd - r) * q) + off; }
        const int nig = WGM * nN, gid = wgid / nig, fm = gid * WGM, gsz = (nM - fm) < WGM ? (nM - fm) : WGM;
        u.pm = fm + ((wgid % nig) % gsz); u.pn = (wgid % nig) / gsz; u.z = 0; return true;
    }
    __device__ __forceinline__ void a_ready(const Unit&) const {}
    __device__ __forceinline__ void done(const Unit&) const {}
};

struct Merge3Order { StaticOrder base;
    __device__ void init(int M, int N, int G_, int c_) { base.init(M, N, G_, c_); }
    __device__ bool next(int i, Unit& u) const { const int r = i / 3; if (!base.next(r, u)) return false; u.z = i - 3 * r; return true; }
    __device__ __forceinline__ void a_ready(const Unit&) const {}
    __device__ __forceinline__ void done(const Unit&) const {}
};
__device__ __forceinline__ unsigned cvt_pk_bf16(float lo, float hi) { unsigned r; asm volatile("v_cvt_pk_bf16_f32 %0, %1, %2" : "=v"(r) : "v"(lo), "v"(hi)); return r; }
typedef float f32x2 __attribute__((ext_vector_type(2)));
template <class Epi, class Sched, bool ALIGN_EPI = false, bool SP2 = false>
__device__ __forceinline__ void gemm_phase(PG8_LAS unsigned char* lds, const Gemm g, const Sched& S, const Epi& E) {
    int tid = threadIdx.x; asm volatile("" : "+v"(tid));
    const int wid = __builtin_amdgcn_readfirstlane(tid >> 6), lane = tid & 63, wr = wid >> 2, wc = wid & 3, fr = lane & 15, fq = lane >> 4;
    const int K = g.K, nt = K / BK;
    unsigned voffA[2], voffB[2];
#pragma unroll
    for (int i = 0; i < 2; ++i) { int R, C; stage_rc(tid * 16 + i * 8192, R, C); const int Rb = Epi::PERM ? ((R & ~31) + perm32(R & 31)) : R;
        voffA[i] = (unsigned)(R * g.lda + C) * 2u; voffB[i] = (unsigned)(Rb * g.ldb + C) * 2u; }
    const size_t kstep = (size_t)(BK * 2);
    const size_t hstepA = (size_t)HALF * g.lda * 2, hstepB = (size_t)HALF * g.ldb * 2;
    const size_t tstepA = 2 * hstepA, tstepB = 2 * hstepB;
    const unsigned ldsw = (unsigned)wid * 1024u;
    const int aoff = lds_byte(wr * 64 + fr, fq * 8), boff = lds_byte(wc * 32 + fr, fq * 8);
#define PG8_SA(b, h) (((b) * 2 + (h)) * HTB)
#define PG8_SB(b, h) ((4 + (b) * 2 + (h)) * HTB)
#define PG8_STAGE(bufoff, gbase, voff) do { _Pragma("unroll") for (int _i = 0; _i < 2; ++_i) \
        __builtin_amdgcn_global_load_lds((const unsigned*)((const char*)(gbase) + (voff)[_i]), (PG8_LAS unsigned*)(lds + (bufoff) + ldsw + _i * 8192), 16, 0, 0); } while (0)
#define PG8_LDA(dst, b, h) do { _Pragma("unroll") for (int m = 0; m < 4; ++m) _Pragma("unroll") for (int k = 0; k < 2; ++k) dst[m][k] = *(const PG8_LAS bf16x8*)(lds + PG8_SA(b, h) + aoff + m * 2048 + k * 1024); } while (0)
#define PG8_LDB(dst, b, h) do { _Pragma("unroll") for (int n = 0; n < 2; ++n) _Pragma("unroll") for (int k = 0; k < 2; ++k) dst[n][k] = *(const PG8_LAS bf16x8*)(lds + PG8_SB(b, h) + boff + n * 2048 + k * 1024); } while (0)
#define PG8_MMA(ai, bj, At, Bt) do { __builtin_amdgcn_s_setprio(1); _Pragma("unroll") for (int m = 0; m < 4; ++m) _Pragma("unroll") for (int n = 0; n < 2; ++n) _Pragma("unroll") for (int k = 0; k < 2; ++k) \
        acc[ai][bj][m][n] = __builtin_amdgcn_mfma_f32_16x16x32_bf16(Bt[n][k], At[m][k], acc[ai][bj][m][n], 0, 0, 0); __builtin_amdgcn_s_setprio(0); } while (0)
#define PG8_WAIT_V(n) asm volatile("s_waitcnt vmcnt(" #n ")" ::: "memory")
#define PG8_WAIT_L(n) asm volatile("s_waitcnt lgkmcnt(" #n ")" ::: "memory")
#define PG8_BAR __builtin_amdgcn_s_barrier()
#define PG8_SCHED __builtin_amdgcn_sched_barrier(0)
    Unit cur, nxt; int ui = 0;
    if (!S.next(0, cur)) return;
    f32x4 acc[2][2][4][2];
#pragma unroll
    for (int a = 0; a < 2; ++a)
#pragma unroll
        for (int b = 0; b < 2; ++b)
#pragma unroll
            for (int m = 0; m < 4; ++m)
#pragma unroll
                for (int n = 0; n < 2; ++n) { float z0, z1, z2, z3; asm volatile("v_mov_b32 %0, 0\n\tv_mov_b32 %1, 0\n\tv_mov_b32 %2, 0\n\tv_mov_b32 %3, 0" : "=v"(z0), "=v"(z1), "=v"(z2), "=v"(z3)); acc[a][b][m][n] = (f32x4){z0, z1, z2, z3}; }
    bf16x8 At[4][2], B0[2][2], B1[2][2];
    const char* cA = (const char*)g.A + op_aoff(g, cur, tstepA); const char* cB = (const char*)g.Bt + op_boff(g, cur, tstepB);
    S.a_ready(cur);
    if constexpr (SP2) {
        PG8_STAGE(PG8_SB(0, 0), cB, voffB); PG8_STAGE(PG8_SB(0, 1), cB + hstepB, voffB); PG8_STAGE(PG8_SA(0, 0), cA, voffA); PG8_STAGE(PG8_SA(0, 1), cA + hstepA, voffA);
        if (wr == 1) PG8_BAR;
        PG8_WAIT_V(2); PG8_BAR;
        PG8_STAGE(PG8_SB(1, 0), cB + kstep, voffB); PG8_STAGE(PG8_SA(1, 0), cA + kstep, voffA); PG8_STAGE(PG8_SB(1, 1), cB + hstepB + kstep, voffB);
        PG8_WAIT_V(6); PG8_BAR;
    } else {
        PG8_STAGE(PG8_SB(0, 0), cB, voffB); PG8_STAGE(PG8_SA(0, 0), cA, voffA); PG8_STAGE(PG8_SB(0, 1), cB + hstepB, voffB); PG8_STAGE(PG8_SA(0, 1), cA + hstepA, voffA);
        if (wr == 1) PG8_BAR;
        PG8_WAIT_V(4); PG8_BAR;
        PG8_STAGE(PG8_SB(1, 0), cB + kstep, voffB); PG8_STAGE(PG8_SA(1, 0), cA + kstep, voffA); PG8_STAGE(PG8_SB(1, 1), cB + hstepB + kstep, voffB);
        PG8_WAIT_V(6); PG8_BAR;
    }
    for (;;) {
        const bool has_next = S.next(ui + 1, nxt);
        const char* nA = has_next ? (const char*)g.A + op_aoff(g, nxt, tstepA) : cA; const char* nB = has_next ? (const char*)g.Bt + op_boff(g, nxt, tstepB) : cB;
        for (int t = 0; t < nt; t += 2) {
            const bool last = (t == nt - 2);
            const char* a1 = cA + (size_t)(t + 1) * kstep;
            const char* a2 = last ? nA : cA + (size_t)(t + 2) * kstep; const char* b2 = last ? nB : cB + (size_t)(t + 2) * kstep;
            const char* a3 = a2 + kstep; const char* b3 = b2 + kstep;
            if (last && has_next) S.a_ready(nxt);
            if constexpr (SP2) {
            PG8_LDB(B0, 0, 0); PG8_LDB(B1, 0, 1); PG8_SCHED; PG8_LDA(At, 0, 0); PG8_STAGE(PG8_SA(1, 1), a1 + hstepA, voffA);
            PG8_WAIT_V(8); PG8_WAIT_L(0); PG8_BAR; PG8_MMA(0, 0, At, B0); PG8_MMA(0, 1, At, B1); PG8_BAR; PG8_SCHED;
            PG8_LDA(At, 0, 1); PG8_STAGE(PG8_SB(0, 0), b2, voffB); PG8_STAGE(PG8_SB(0, 1), b2 + hstepB, voffB); PG8_STAGE(PG8_SA(0, 0), a2, voffA);
            PG8_WAIT_V(8); PG8_WAIT_L(0); PG8_BAR; PG8_MMA(1, 0, At, B0); PG8_MMA(1, 1, At, B1); PG8_BAR; PG8_SCHED;
            PG8_LDB(B0, 1, 0); PG8_LDB(B1, 1, 1); PG8_SCHED; PG8_LDA(At, 1, 0); PG8_STAGE(PG8_SA(0, 1), a2 + hstepA, voffA);
            PG8_WAIT_V(8); PG8_WAIT_L(0); PG8_BAR; PG8_MMA(0, 0, At, B0); PG8_MMA(0, 1, At, B1); PG8_BAR; PG8_SCHED;
            PG8_LDA(At, 1, 1); PG8_STAGE(PG8_SB(1, 0), b3, voffB); PG8_STAGE(PG8_SB(1, 1), b3 + hstepB, voffB); PG8_STAGE(PG8_SA(1, 0), a3, voffA);
            PG8_WAIT_V(8); PG8_WAIT_L(0); PG8_BAR; PG8_MMA(1, 0, At, B0); PG8_MMA(1, 1, At, B1); PG8_BAR; PG8_SCHED;
            } else {
            PG8_LDB(B0, 0, 0); PG8_SCHED; PG8_LDA(At, 0, 0); PG8_STAGE(PG8_SA(1, 1), a1 + hstepA, voffA);
            PG8_WAIT_L(8); PG8_BAR; PG8_WAIT_L(0); PG8_MMA(0, 0, At, B0); PG8_BAR; PG8_SCHED;
            PG8_LDB(B1, 0, 1); PG8_STAGE(PG8_SB(0, 0), b2, voffB);
            PG8_BAR; PG8_WAIT_L(0); PG8_MMA(0, 1, At, B1); PG8_BAR;
            PG8_LDA(At, 0, 1); PG8_STAGE(PG8_SA(0, 0), a2, voffA);
            PG8_BAR; PG8_WAIT_L(0); PG8_MMA(1, 0, At, B0); PG8_BAR; PG8_SCHED;
            PG8_STAGE(PG8_SB(0, 1), b2 + hstepB, voffB);
            PG8_WAIT_V(6); PG8_BAR; PG8_MMA(1, 1, At, B1); PG8_BAR;
            PG8_LDB(B0, 1, 0); PG8_SCHED; PG8_LDA(At, 1, 0); PG8_STAGE(PG8_SA(0, 1), a2 + hstepA, voffA);
            PG8_WAIT_L(8); PG8_BAR; PG8_WAIT_L(0); PG8_MMA(0, 0, At, B0); PG8_BAR; PG8_SCHED;
            PG8_LDB(B1, 1, 1); PG8_STAGE(PG8_SB(1, 0), b3, voffB);
            PG8_BAR; PG8_WAIT_L(0); PG8_MMA(0, 1, At, B1); PG8_BAR;
            PG8_LDA(At, 1, 1); PG8_STAGE(PG8_SA(1, 0), a3, voffA);
            PG8_BAR; PG8_WAIT_L(0); PG8_MMA(1, 0, At, B0); PG8_BAR; PG8_SCHED;
            PG8_STAGE(PG8_SB(1, 1), b3 + hstepB, voffB);
            PG8_WAIT_V(6); PG8_BAR; PG8_MMA(1, 1, At, B1); PG8_BAR;
            }
        }
        if constexpr (ALIGN_EPI) { if (wr == 0) PG8_BAR; }
        if constexpr (!Epi::AFTER_DRAIN) { E(acc, cur, wr, wc, fr, fq); S.done(cur); }
        if (!has_next) break;
#pragma unroll
        for (int a = 0; a < 2; ++a)
#pragma unroll
        for (int b = 0; b < 2; ++b)
#pragma unroll
            for (int m = 0; m < 4; ++m)
#pragma unroll
                for (int n = 0; n < 2; ++n) { float z0, z1, z2, z3; asm volatile("v_mov_b32 %0, 0\n\tv_mov_b32 %1, 0\n\tv_mov_b32 %2, 0\n\tv_mov_b32 %3, 0" : "=v"(z0), "=v"(z1), "=v"(z2), "=v"(z3)); acc[a][b][m][n] = (f32x4){z0, z1, z2, z3}; }
        cur = nxt; cA = nA; cB = nB; ++ui;
        if constexpr (ALIGN_EPI) { if (wr == 1) PG8_BAR; }
    }
    PG8_WAIT_V(0);
    if constexpr (!ALIGN_EPI) { if (wr == 0) PG8_BAR; }
    PG8_BAR;
    if constexpr (Epi::AFTER_DRAIN) { E.fused(acc, cur, wr, wc, fr, fq, lds, wid, lane); S.done(cur); }
#undef PG8_SA
#undef PG8_SB
#undef PG8_STAGE
#undef PG8_LDA
#undef PG8_LDB
#undef PG8_MMA
#undef PG8_WAIT_V
#undef PG8_WAIT_L
#undef PG8_BAR
#undef PG8_SCHED
}
}

#define LAS __attribute__((address_space(3)))
typedef unsigned short bf16;
typedef unsigned char uchar;
typedef short bf16x8 __attribute__((ext_vector_type(8)));
typedef float f32x4 __attribute__((ext_vector_type(4)));
typedef unsigned v4u __attribute__((ext_vector_type(4)));
typedef unsigned v2u __attribute__((ext_vector_type(2)));

constexpr int DM = 1024, NBATCH = 4, SEQ = 4096, DEPTH = 4, CTXL = 256;
constexpr int ML = NBATCH * SEQ, MC = NBATCH * CTXL, MT = ML + MC;
constexpr int LP = 4096, NG = 3072, DFF = 2816, NIN = 6928, NINP = 7168, LBO = 1536;
constexpr int C_Q = 0, C_K = 512, C_V = 640, C_GLU = 768, C_QKM = 1792, C_VM = 2816, C_OM = 3328, C_GM = 3840;
constexpr int NCHUNK = 68;
constexpr float EPS = 1e-6f;
constexpr size_t MiB = 1u << 20;
constexpr size_t WS_MOD = 0, WS_ROPE = 512 * 1024, WS_BEND = 1 * MiB, WS_MU = WS_BEND + 16384, WS_MS = WS_MU + 16384, WS_NS = 2 * MiB;
constexpr size_t WS_XC = 4 * MiB, WS_WIN = 8 * MiB, WS_WP = 22 * MiB, WS_WO3 = 25 * MiB, WS_WGU = 31 * MiB, WS_WD = 42 * MiB;
constexpr size_t WS_BO = 48 * MiB, WS_P1 = 99 * MiB, WS_G = 235 * MiB, WS_ST = 337 * MiB, WS_END = 405 * MiB;
constexpr size_t WS_DBG = 768 * 1024, WS_BAR = 3 * MiB + 512 * 1024, BAR_BYTES = 16384;
constexpr int MISC_OFF = 155136;
constexpr int LDS_BYTES = 155648;
constexpr int NPHASE = 2 + 10 * DEPTH;

struct Params { const float* in[25]; float* out; uchar* ws; int ph_lo, ph_hi; };
enum { I_X = 0, I_C, I_CTX, I_CCTX, I_WADA, I_BADA, I_GMIX, I_GFFN, I_WIN, I_BMG, I_SINK, I_WATT, I_WDW, I_BDW, I_GCLN, I_BCLN, I_WPW, I_WMCONV, I_GMN, I_WMOUT, I_WOUT, I_WFG, I_WFU, I_WFD, I_GFIN };

__device__ __forceinline__ float bf2f(unsigned h) { return __uint_as_float(h << 16); }
typedef __bf16 bf16x2_t __attribute__((ext_vector_type(2)));
typedef float f32x2_t __attribute__((ext_vector_type(2)));
__device__ __forceinline__ unsigned pk2(float lo, float hi) { f32x2_t v = {lo, hi}; bf16x2_t b = __builtin_convertvector(v, bf16x2_t); return __builtin_bit_cast(unsigned, b); }
__device__ __forceinline__ float sigmoidf_(float x) { return __builtin_amdgcn_rcpf(1.0f + __expf(-x)); }
__device__ __forceinline__ float siluf_(float x) { return x * __builtin_amdgcn_rcpf(1.0f + __expf(-x)); }
__device__ __forceinline__ float logsigf_(float x) { return fminf(x, 0.f) - __logf(1.0f + __expf(-fabsf(x))); }
__device__ __forceinline__ int olane() { int l = __builtin_amdgcn_mbcnt_hi(-1, __builtin_amdgcn_mbcnt_lo(-1, 0)); asm volatile("" : "+v"(l)); return l; }
__device__ __forceinline__ float shi(float v, int src) { return __builtin_bit_cast(float, __builtin_amdgcn_ds_bpermute(src << 2, __builtin_bit_cast(int, v))); }
__device__ __forceinline__ float shx(float v, int o) { return shi(v, olane() ^ o); }
__device__ __forceinline__ float wave_sum(float v) {
    const int l = olane();
#pragma unroll
    for (int o = 1; o < 64; o <<= 1) v += shi(v, l ^ o);
    return v;
}
#define DPPF(v, ctrl) __builtin_bit_cast(float, __builtin_amdgcn_update_dpp(0, __builtin_bit_cast(int, (v)), (ctrl), 0xf, 0xf, false))
__device__ __forceinline__ void wave_sum8(float (&v)[8]) {
#pragma unroll
    for (int t = 0; t < 8; ++t) { v[t] += DPPF(v[t], 0x128); v[t] += DPPF(v[t], 0x124); v[t] += DPPF(v[t], 0x122); v[t] += DPPF(v[t], 0x121); }
    const int l = olane();
#pragma unroll
    for (int t = 0; t < 8; ++t) v[t] += shi(v[t], l ^ 16);
#pragma unroll
    for (int t = 0; t < 8; ++t) v[t] += shi(v[t], l ^ 32);
}
__device__ __forceinline__ float wave_max(float v) {
    const int l = olane();
#pragma unroll
    for (int o = 1; o < 64; o <<= 1) v = fmaxf(v, shi(v, l ^ o));
    return v;
}
__device__ __forceinline__ float scan_add(float v, int lane) {
#pragma unroll
    for (int o = 1; o < 64; o <<= 1) { const float t = shi(v, lane >= o ? lane - o : lane); if (lane >= o) v += t; }
    return v;
}
__device__ __forceinline__ float scan_max(float v, int lane) {
#pragma unroll
    for (int o = 1; o < 64; o <<= 1) { const float t = shi(v, lane >= o ? lane - o : lane); if (lane >= o) v = fmaxf(v, t); }
    return v;
}
__device__ __forceinline__ void unpack8(v4u w, float (&f)[8]) {
    f[0] = bf2f(w.x & 0xffffu); f[1] = bf2f(w.x >> 16); f[2] = bf2f(w.y & 0xffffu); f[3] = bf2f(w.y >> 16);
    f[4] = bf2f(w.z & 0xffffu); f[5] = bf2f(w.z >> 16); f[6] = bf2f(w.w & 0xffffu); f[7] = bf2f(w.w >> 16);
}
__device__ __forceinline__ v4u pack8(const float (&f)[8]) { v4u w; w.x = pk2(f[0], f[1]); w.y = pk2(f[2], f[3]); w.z = pk2(f[4], f[5]); w.w = pk2(f[6], f[7]); return w; }
#define LDS_FENCE() asm volatile("s_waitcnt lgkmcnt(0)" ::: "memory")
#define MFMA16(a, b, c) __builtin_amdgcn_mfma_f32_16x16x32_bf16((a), (b), (c), 0, 0, 0)
#define DBGF(cond, code) do { if (cond) atomicMin((int*)(c.ws + WS_DBG), (code)); } while (0)

__device__ __forceinline__ int otid() { int t = threadIdx.x; asm volatile("" : "+v"(t)); return t; }
#define TLW const int tid_ = otid(), lane_ = tid_ & 63, wave_ = __builtin_amdgcn_readfirstlane(tid_ >> 6); (void)lane_; (void)wave_
__device__ __forceinline__ f32x4 zero4() { float z0, z1, z2, z3; asm volatile("v_mov_b32 %0, 0\n\tv_mov_b32 %1, 0\n\tv_mov_b32 %2, 0\n\tv_mov_b32 %3, 0" : "=v"(z0), "=v"(z1), "=v"(z2), "=v"(z3)); return (f32x4){z0, z1, z2, z3}; }
__device__ __forceinline__ v4u zero4u() { unsigned z0, z1, z2, z3; asm volatile("v_mov_b32 %0, 0\n\tv_mov_b32 %1, 0\n\tv_mov_b32 %2, 0\n\tv_mov_b32 %3, 0" : "=v"(z0), "=v"(z1), "=v"(z2), "=v"(z3)); return (v4u){z0, z1, z2, z3}; }
struct Ctx {
    const __attribute__((address_space(4))) Params* p; LAS uchar* lds; int bid, nblk;
    uchar* ws; float* xl;
};

#define XB_TMO      128
#define XB_XCNT(j)  (256  + 64 * (j))
#define XB_XSUB(j)  (1280 + 64 * (j))
#define XB_XGEN(j)  (2304 + 64 * (j))
#define XB_TOP      3328
#define XB_TOPGEN   3392
#define XCD_BAR_WORDS 3456
#define XB_SPIN_CAP (1u << 18)

__device__ __forceinline__ unsigned xb_ld(unsigned* p)              { return __hip_atomic_load(p, __ATOMIC_RELAXED, __HIP_MEMORY_SCOPE_AGENT); }
__device__ __forceinline__ unsigned xb_add(unsigned* p, unsigned v) { return __hip_atomic_fetch_add(p, v, __ATOMIC_RELAXED, __HIP_MEMORY_SCOPE_AGENT); }
__device__ __forceinline__ unsigned xb_xcc_id() { return (unsigned)__builtin_amdgcn_s_getreg((3 << 11) | 20) & 0xFu; }
#define XB_SPIN(cond, bar) do { unsigned _sp = 0; while (cond) { __builtin_amdgcn_s_sleep(1); \
    if ((++_sp & 255u) == 0u) { if (xb_ld(&(bar)[XB_TMO])) break; if (_sp > XB_SPIN_CAP) { atomicAdd(&(bar)[XB_TMO], 1u); break; } } } } while (0)

struct XcdBarrier {
    unsigned* bar; unsigned x;
    volatile LAS unsigned* st;
};

__device__ __forceinline__ XcdBarrier xcd_barrier_post(unsigned* bar, volatile LAS unsigned* st) {
    XcdBarrier b; b.bar = bar; b.x = xb_xcc_id(); b.st = st;
    if (threadIdx.x == 0) (void)xb_add(&bar[XB_XCNT(b.x)], 1u);
    return b;
}
__device__ __forceinline__ void xcd_barrier_complete(unsigned* bar, unsigned x, unsigned& nloc, unsigned& nx) {
    const unsigned G = gridDim.x * gridDim.y * gridDim.z;
    unsigned sum, cnt, mine, sp = 0u;
    for (;;) {
        sum = 0u; cnt = 0u; mine = 0u;
#pragma unroll
        for (unsigned j = 0; j < 16; ++j) { const unsigned c = xb_ld(&bar[XB_XCNT(j)]); sum += c; cnt += (c > 0u) ? 1u : 0u; mine = (j == x) ? c : mine; }
        if (sum == G) break;
        __builtin_amdgcn_s_sleep(1);
        if ((++sp & 255u) == 0u) { if (xb_ld(&bar[XB_TMO])) break; if (sp > XB_SPIN_CAP) { atomicAdd(&bar[XB_TMO], 1u); break; } }
    }
    nloc = mine > 0u ? mine : 1u; nx = cnt > 0u ? cnt : 1u;
}

__device__ __forceinline__ void xcd_barrier(const XcdBarrier& b) {
    asm volatile("s_waitcnt vmcnt(0)" ::: "memory");
    __syncthreads();
    if (threadIdx.x == 0) {
        unsigned* bar = b.bar;
        __builtin_amdgcn_s_waitcnt(0);
        unsigned nloc = b.st[0], nx = b.st[1];
        if (nloc == 0u) { xcd_barrier_complete(bar, b.x, nloc, nx); b.st[0] = nloc; b.st[1] = nx; }
        const unsigned old = xb_add(&bar[XB_XSUB(b.x)], 1u);
        const unsigned gen = old / nloc;
        if (old + 1u == (gen + 1u) * nloc) {
            __builtin_amdgcn_fence(__ATOMIC_RELEASE, "agent");
            asm volatile("s_waitcnt vmcnt(0)" ::: "memory");
            const unsigned og = xb_add(&bar[XB_TOP], 1u);
            const unsigned tg = og / nx;
            if (og + 1u == (tg + 1u) * nx) xb_add(&bar[XB_TOPGEN], 1u);
            else XB_SPIN(xb_ld(&bar[XB_TOPGEN]) == tg, bar);
            __builtin_amdgcn_fence(__ATOMIC_ACQUIRE, "agent");
            xb_add(&bar[XB_XGEN(b.x)], 1u);
            asm volatile("s_waitcnt vmcnt(0)" ::: "memory");
        } else {
            XB_SPIN(xb_ld(&bar[XB_XGEN(b.x)]) == gen, bar);
            __builtin_amdgcn_fence(__ATOMIC_ACQUIRE, "agent");
            asm volatile("s_waitcnt vmcnt(0)" ::: "memory");
        }
    }
    __syncthreads();
}

struct EpiP1G {
    static constexpr bool PERM = true, AFTER_DRAIN = false;
    bf16* P1; bf16* G;
    __device__ __forceinline__ void operator()(const f32x4 (&acc)[2][2][4][2], const pg8::Unit& u, int wr, int wc, int fr, int fq) const {
        { const int l_ = olane(); fr = l_ & 15; fq = l_ >> 4; }
        const int row0 = u.pm * 256 + wr * 64 + fr; const bool sg = u.pn >= 16, glu = u.pn >= 3 && u.pn < 7;
        bf16* base = sg ? G : P1; const int ldc = sg ? NG : LP; const int col0 = (sg ? u.pn - 16 : u.pn) * 256 + wc * 32 + 8 * fq;
#pragma unroll
        for (int ai = 0; ai < 2; ++ai)
#pragma unroll
            for (int m = 0; m < 4; ++m) { bf16* rowp = base + (size_t)(row0 + ai * 128 + m * 16) * ldc + col0;
                if (glu) {
                    bf16* zp = P1 + (size_t)(row0 + ai * 128 + m * 16) * LP + C_GLU + (u.pn - 3) * 128 + wc * 16 + 4 * fq;
#pragma unroll
                    for (int bj = 0; bj < 2; ++bj) { const f32x4 v0 = acc[ai][bj][m][0], v1 = acc[ai][bj][m][1];
                        v2u w; w.x = pk2(v0[0] * sigmoidf_(v0[1]), v0[2] * sigmoidf_(v0[3])); w.y = pk2(v1[0] * sigmoidf_(v1[1]), v1[2] * sigmoidf_(v1[3]));
                        *(v2u*)(zp + bj * 64) = w; }
                    continue; }
#pragma unroll
                for (int bj = 0; bj < 2; ++bj) { f32x4 v0 = acc[ai][bj][m][0], v1 = acc[ai][bj][m][1];
                    if (sg) {
#pragma unroll
                        for (int e = 0; e < 4; ++e) { v0[e] = sigmoidf_(v0[e]); v1[e] = sigmoidf_(v1[e]); } }
                    v4u w; w.x = pk2(v0[0], v0[1]); w.y = pk2(v0[2], v0[3]); w.z = pk2(v1[0], v1[1]); w.w = pk2(v1[2], v1[3]);
                    *(v4u*)(rowp + bj * 128) = w; } }
    }
};
struct EpiGateMul {
    static constexpr bool PERM = true, AFTER_DRAIN = false;
    bf16* G;
    __device__ __forceinline__ void operator()(const f32x4 (&acc)[2][2][4][2], const pg8::Unit& u, int wr, int wc, int fr, int fq) const {
        { const int l_ = olane(); fr = l_ & 15; fq = l_ >> 4; }
        const int row0 = u.pm * 256 + wr * 64 + fr, col0 = u.pn * 256 + wc * 32 + 8 * fq;
#pragma unroll
        for (int ai = 0; ai < 2; ++ai)
#pragma unroll
            for (int m = 0; m < 4; ++m) { bf16* rowp = G + (size_t)(row0 + ai * 128 + m * 16) * NG + col0;
#pragma unroll
                for (int bj = 0; bj < 2; ++bj) { const f32x4 v0 = acc[ai][bj][m][0], v1 = acc[ai][bj][m][1];
                    const v4u gv = *(const v4u*)(rowp + bj * 128); float gf[8]; unpack8(gv, gf);
                    v4u w; w.x = pk2(v0[0] * gf[0], v0[1] * gf[1]); w.y = pk2(v0[2] * gf[2], v0[3] * gf[3]); w.z = pk2(v1[0] * gf[4], v1[1] * gf[5]); w.w = pk2(v1[2] * gf[6], v1[3] * gf[7]);
                    *(v4u*)(rowp + bj * 128) = w; } }
    }
};
struct EpiResid {
    static constexpr bool PERM = false, AFTER_DRAIN = false;
    float* xl; float* xc; const float* gate; const float* xsrc;
    __device__ __forceinline__ void operator()(const f32x4 (&acc)[2][2][4][2], const pg8::Unit& u, int wr, int wc, int fr, int fq) const {
        { const int l_ = olane(); fr = l_ & 15; fq = l_ >> 4; }
        const int row0 = u.pm * 256 + wr * 64 + fr, col0 = u.pn * 256 + wc * 32 + 4 * fq;
        const bool lat = u.pm < 64; float* xb = lat ? xl : xc - (size_t)ML * DM; const float* xs = lat ? xsrc : xc - (size_t)ML * DM; const float* gp = gate + (lat ? (u.pm >> 4) : 4) * 6144 + col0;
#pragma unroll
        for (int ai = 0; ai < 2; ++ai)
#pragma unroll
            for (int m = 0; m < 4; ++m) { float* rowp = xb + (size_t)(row0 + ai * 128 + m * 16) * DM + col0; const float* srcp = xs + (size_t)(row0 + ai * 128 + m * 16) * DM + col0;
#pragma unroll
                for (int bj = 0; bj < 2; ++bj)
#pragma unroll
                    for (int n = 0; n < 2; ++n) { f32x4 x = *(const f32x4*)(srcp + bj * 128 + n * 16); const f32x4 gvv = *(const f32x4*)(gp + bj * 128 + n * 16); x = x + gvv * acc[ai][bj][m][n]; *(f32x4*)(rowp + bj * 128 + n * 16) = x; }
                asm volatile("" ::: "memory"); }
    }
};
struct EpiMerge {
    static constexpr bool PERM = true, AFTER_DRAIN = false;
    const bf16* G; bf16* MG;
    __device__ __forceinline__ void operator()(const f32x4 (&acc)[2][2][4][2], const pg8::Unit& u, int wr, int wc, int fr, int fq) const {
        { const int l_ = olane(); fr = l_ & 15; fq = l_ >> 4; }
        const int row0 = u.pm * 256 + wr * 64 + fr, col0 = u.pn * 256 + wc * 32 + 8 * fq;
#pragma unroll
        for (int ai = 0; ai < 2; ++ai)
#pragma unroll
            for (int m = 0; m < 4; ++m) { const size_t row = (size_t)(row0 + ai * 128 + m * 16); const bf16* gp = G + row * NG + u.z * 1024 + col0; bf16* mp = MG + row * DM + col0;
#pragma unroll
                for (int bj = 0; bj < 2; ++bj) { const f32x4 v0 = acc[ai][bj][m][0], v1 = acc[ai][bj][m][1];
                    float gf[8]; unpack8(*(const v4u*)(gp + bj * 128), gf);
                    float r[8] = {v0[0] * gf[0], v0[1] * gf[1], v0[2] * gf[2], v0[3] * gf[3], v1[0] * gf[4], v1[1] * gf[5], v1[2] * gf[6], v1[3] * gf[7]};
                    if (u.z > 0) { float of[8]; unpack8(*(const v4u*)(mp + bj * 128), of);
#pragma unroll
                        for (int e = 0; e < 8; ++e) r[e] += of[e]; }
                    *(v4u*)(mp + bj * 128) = pack8(r); }
                asm volatile("" ::: "memory"); }
    }
};
struct EpiPartial {
    static constexpr bool PERM = false, AFTER_DRAIN = false;
    float* PART;
    __device__ __forceinline__ void operator()(const f32x4 (&acc)[2][2][4][2], const pg8::Unit& u, int wr, int wc, int fr, int fq) const {
        { const int l_ = olane(); fr = l_ & 15; fq = l_ >> 4; }
        const int row0 = u.pm * 256 + wr * 64 + fr, col0 = (u.pn & 3) * 256 + wc * 32 + 4 * fq;
        float* base = PART + (size_t)(u.pn >> 2) * MC * DM;
#pragma unroll
        for (int ai = 0; ai < 2; ++ai)
#pragma unroll
            for (int m = 0; m < 4; ++m) { float* rowp = base + (size_t)(row0 + ai * 128 + m * 16) * DM + col0;
#pragma unroll
                for (int bj = 0; bj < 2; ++bj)
#pragma unroll
                    for (int n = 0; n < 2; ++n) *(f32x4*)(rowp + bj * 128 + n * 16) = acc[ai][bj][m][n]; }
    }
};
struct EpiSwiGLU {
    static constexpr bool PERM = true, AFTER_DRAIN = false;
    bf16* HID;
    __device__ __forceinline__ void operator()(const f32x4 (&acc)[2][2][4][2], const pg8::Unit& u, int wr, int wc, int fr, int fq) const {
        { const int l_ = olane(); fr = l_ & 15; fq = l_ >> 4; }
        const int row0 = u.pm * 256 + wr * 64 + fr, col0 = u.pn * 128 + wc * 16 + 4 * fq;
#pragma unroll
        for (int ai = 0; ai < 2; ++ai)
#pragma unroll
            for (int m = 0; m < 4; ++m) { bf16* rowp = HID + (size_t)(row0 + ai * 128 + m * 16) * DFF + col0;
#pragma unroll
                for (int bj = 0; bj < 2; ++bj) { const f32x4 v0 = acc[ai][bj][m][0], v1 = acc[ai][bj][m][1];
                    v2u w; w.x = pk2(siluf_(v0[0]) * v0[1], siluf_(v0[2]) * v0[3]); w.y = pk2(siluf_(v1[0]) * v1[1], siluf_(v1[2]) * v1[3]);
                    *(v2u*)(rowp + bj * 64) = w; } }
    }
};

__device__ __forceinline__ void phase_init(Ctx& c) {
    TLW;
    const __attribute__((address_space(4))) Params& p = *c.p;
    {
      const f32x4* sc = (const f32x4*)((const float*)(const __attribute__((address_space(1))) float*)p.in[I_CTX]); f32x4* dc = (f32x4*)((float*)(c.ws + WS_XC)); const int m4 = MC * DM / 4;
      for (int i = c.bid * 512 + tid_; i < m4; i += c.nblk * 512) dc[i] = sc[i]; }
    if (c.bid == 0) { for (int i = tid_; i < 1024; i += 512) { const int pos = i >> 4, f = i & 15; const float inv = __builtin_amdgcn_exp2f(-(float)f * (13.287712379549449f / 16.0f)); const float ang = (float)pos * inv;
        ((float*)(c.ws + WS_ROPE))[pos * 32 + f] = __cosf(ang); ((float*)(c.ws + WS_ROPE))[pos * 32 + 16 + f] = __sinf(ang); } }
    LAS float* sc = (LAS float*)c.lds;
    LAS float* part = (LAS float*)(c.lds + 20480);
    for (int i = tid_; i < 5120; i += 512) { const int r = i >> 10, k = i & 1023; const float v = r < 4 ? ((const float*)(const __attribute__((address_space(1))) float*)p.in[I_C])[r * 1024 + k] : ((const float*)(const __attribute__((address_space(1))) float*)p.in[I_CCTX])[k]; sc[i] = siluf_(v); }
    __syncthreads();
    for (int u = c.bid; u < DEPTH * 96; u += c.nblk) {
        const int l = u / 96, n0 = (u % 96) * 64;
        const float* w = ((const float*)(const __attribute__((address_space(1))) float*)p.in[I_WADA]) + (size_t)l * DM * 6144 + n0 + lane_;
        float a0 = 0.f, a1 = 0.f, a2 = 0.f, a3 = 0.f, a4 = 0.f;
        const int kb = wave_ * 128;
#pragma unroll 32
        for (int k = 0; k < 128; ++k) { const float wv = w[(size_t)(kb + k) * 6144];
            a0 += sc[kb + k] * wv; a1 += sc[1024 + kb + k] * wv; a2 += sc[2048 + kb + k] * wv; a3 += sc[3072 + kb + k] * wv; a4 += sc[4096 + kb + k] * wv; }
        LAS float* pw = part + wave_ * 320 + lane_; pw[0] = a0; pw[64] = a1; pw[128] = a2; pw[192] = a3; pw[256] = a4;
        __syncthreads();
        if (tid_ < 320) { float s = 0.f;
#pragma unroll
            for (int wv = 0; wv < 8; ++wv) s += part[wv * 320 + tid_];
            const int r = tid_ >> 6, ln = tid_ & 63; ((float*)(c.ws + WS_MOD))[((size_t)l * 5 + r) * 6144 + n0 + ln] = s + ((const float*)(const __attribute__((address_space(1))) float*)p.in[I_BADA])[l * 6144 + n0 + ln]; }
        __syncthreads();
    }
}

__device__ __forceinline__ void tr_item(const float* src, int lds_, int k0, int n0, bf16* dst, int ldd, int drow0, int rmul, int ncopy, LAS float* scr, int lane) {
#pragma unroll 4
    for (int i = 0; i < 16; ++i) { const int kk = 4 * i + (lane >> 4), nn = lane & 15; scr[kk * 17 + nn] = src[(size_t)(k0 + kk) * lds_ + n0 + nn]; }
    LDS_FENCE();
    const int n = lane >> 2, kc = (lane & 3) * 16;
#pragma unroll
    for (int h = 0; h < 2; ++h) { const LAS float* s = scr + (kc + 8 * h) * 17 + n;
        v4u o; o.x = pk2(s[0], s[17]); o.y = pk2(s[34], s[51]); o.z = pk2(s[68], s[85]); o.w = pk2(s[102], s[119]);
        bf16* d = dst + (size_t)(drow0 + rmul * n) * ldd + k0 + kc + 8 * h;
        for (int cpy = 0; cpy < ncopy; ++cpy) *(v4u*)(d + cpy * 1024) = o; }
    LDS_FENCE();
}
__device__ __forceinline__ void convert_weights(Ctx& c, int l) {
    TLW;
    const __attribute__((address_space(4))) Params& p = *c.p;
    LAS float* scr = (LAS float*)(c.lds + wave_ * 4608);
    const int gw = c.bid * 8 + wave_, ngw = c.nblk * 8;
    constexpr int I_IN = 16 * 433, I_P = 8 * 64, I_O = 16 * 64, I_F = 16 * 176, I_D = 44 * 64;
    constexpr int TOT = I_IN + 3 * I_P + I_O + 2 * I_F + I_D;
    for (int it = gw; it < TOT; it += ngw) {
        int r = it;
        if (r < I_IN) { const int kb = r / 433, nb = r % 433, n0 = nb * 16; const bool isv = n0 >= 768 && n0 < 1280, isg = n0 >= 1280 && n0 < 1792;
            tr_item(((const float*)(const __attribute__((address_space(1))) float*)p.in[I_WIN]) + (size_t)l * DM * NIN, NIN, kb * 64, n0, ((bf16*)(c.ws + WS_WIN)), DM, isv ? 768 + 2 * (n0 - 768) : isg ? 769 + 2 * (n0 - 1280) : n0 < 3856 ? n0 : n0 + 240, (isv || isg) ? 2 : 1, 1, scr, lane_); continue; } r -= I_IN;
        if (r < 3 * I_P) { const int br = r / I_P, q = r % I_P, kb = q / 64, nb = q % 64; const float* src = (br == 0 ? ((const float*)(const __attribute__((address_space(1))) float*)p.in[I_WATT]) : br == 1 ? ((const float*)(const __attribute__((address_space(1))) float*)p.in[I_WPW]) : ((const float*)(const __attribute__((address_space(1))) float*)p.in[I_WMOUT])) + (size_t)l * 512 * DM;
            tr_item(src, DM, kb * 64, nb * 16, ((bf16*)(c.ws + WS_WP)), 512, br * 1024 + nb * 16, 1, 1, scr, lane_); continue; } r -= 3 * I_P;
        if (r < I_O) { const int kb = r / 64, nb = r % 64; tr_item(((const float*)(const __attribute__((address_space(1))) float*)p.in[I_WOUT]) + (size_t)l * DM * DM, DM, kb * 64, nb * 16, ((bf16*)(c.ws + WS_WO3)), 3072, nb * 16, 1, 3, scr, lane_); continue; } r -= I_O;
        if (r < 2 * I_F) { const int gu = r / I_F, q = r % I_F, kb = q / 176, nb = q % 176; const float* src = (gu == 0 ? ((const float*)(const __attribute__((address_space(1))) float*)p.in[I_WFG]) : ((const float*)(const __attribute__((address_space(1))) float*)p.in[I_WFU])) + (size_t)l * DM * DFF;
            tr_item(src, DFF, kb * 64, nb * 16, ((bf16*)(c.ws + WS_WGU)), DM, 2 * nb * 16 + gu, 2, 1, scr, lane_); continue; } r -= 2 * I_F;
        { const int kb = r / 64, nb = r % 64; tr_item(((const float*)(const __attribute__((address_space(1))) float*)p.in[I_WFD]) + (size_t)l * DFF * DM, DM, kb * 64, nb * 16, ((bf16*)(c.ws + WS_WD)), DFF, nb * 16, 1, 1, scr, lane_); }
    }
    { v4u* z = (v4u*)(((bf16*)(c.ws + WS_WIN)) + (size_t)3856 * DM); const int nz = 240 * DM / 8; for (int i = c.bid * 512 + tid_; i < nz; i += c.nblk * 512) z[i] = zero4u(); }
}
__device__ __forceinline__ void phase_norm(Ctx& c, int l, int which, int nrows, const float* part, int nsl, const float* pgate, const float* xin) {
    TLW;
    const __attribute__((address_space(4))) Params& p = *c.p;
    const float* g = p.in[which ? I_GFFN : I_GMIX] + l * DM;
    const float* modl = ((float*)(c.ws + WS_MOD)) + (size_t)l * 5 * 6144 + (which ? 3072 : 0);
    bf16* H = ((bf16*)(c.ws + WS_BO));
    const int gw = c.bid * 8 + wave_, ngw = c.nblk * 8;
    f32x4 gv[4];
#pragma unroll
    for (int j = 0; j < 4; ++j) gv[j] = ((const f32x4*)g)[64 * j + lane_];
    constexpr int NR = 4;
    for (int rb = gw; rb < nrows; rb += NR * ngw) {
        f32x4 v[NR][4]; float ss[NR];
#pragma unroll
        for (int k = 0; k < NR; ++k) { const int r = rb + k * ngw; ss[k] = 0.f;
            if (r < nrows) {
                float* xr = r < ML ? (xin != nullptr ? const_cast<float*>(xin) : c.xl) + (size_t)r * DM : ((float*)(c.ws + WS_XC)) + (size_t)(r - ML) * DM;
#pragma unroll
                for (int j = 0; j < 4; ++j) { v[k][j] = ((const f32x4*)xr)[64 * j + lane_];
                    if (part != nullptr && r >= ML) {
                        f32x4 a = zero4();
                        for (int sidx = 0; sidx < nsl; ++sidx) a = a + ((const f32x4*)(part + ((size_t)sidx * MC + (r - ML)) * DM))[64 * j + lane_];
                        v[k][j] = v[k][j] + ((const f32x4*)pgate)[64 * j + lane_] * a; ((f32x4*)xr)[64 * j + lane_] = v[k][j]; }
                    ss[k] += (v[k][j].x * v[k][j].x + v[k][j].y * v[k][j].y) + (v[k][j].z * v[k][j].z + v[k][j].w * v[k][j].w); } } }
        { const int ol = olane();
#pragma unroll
          for (int k = 0; k < NR; ++k) { ss[k] += DPPF(ss[k], 0x128); ss[k] += DPPF(ss[k], 0x124); ss[k] += DPPF(ss[k], 0x122); ss[k] += DPPF(ss[k], 0x121); }
#pragma unroll
          for (int k = 0; k < NR; ++k) ss[k] += shi(ss[k], ol ^ 16);
#pragma unroll
          for (int k = 0; k < NR; ++k) ss[k] += shi(ss[k], ol ^ 32); }
#pragma unroll
        for (int k = 0; k < NR; ++k) { const int r = rb + k * ngw;
            if (r < nrows) {
                const float* mr = modl + (r < ML ? (r >> 12) : 4) * 6144;
                const float rstd = rsqrtf(ss[k] * (1.0f / DM) + EPS);
                v2u* o = (v2u*)(H + (size_t)r * DM);
#pragma unroll
                for (int j = 0; j < 4; ++j) { const f32x4 sh = ((const f32x4*)mr)[64 * j + lane_], scl = ((const f32x4*)(mr + 1024))[64 * j + lane_];
                    f32x4 y = v[k][j] * rstd * gv[j]; y = y * (scl + 1.0f) + sh;
                    v2u w; w.x = pk2(y.x, y.y); w.y = pk2(y.z, y.w); o[64 * j + lane_] = w; } } }
    }
}
__device__ __forceinline__ void phase_final(Ctx& c) {
    TLW;
    const float* g = ((const float*)(const __attribute__((address_space(1))) float*)c.p->in[I_GFIN]);
    const int gw = c.bid * 8 + wave_, ngw = c.nblk * 8;
    for (int r = gw; r < ML; r += ngw) {
        f32x4* xr = (f32x4*)(c.xl + (size_t)r * DM);
        f32x4 v[4]; float ss = 0.f;
#pragma unroll
        for (int j = 0; j < 4; ++j) { v[j] = xr[64 * j + lane_]; ss += (v[j].x * v[j].x + v[j].y * v[j].y) + (v[j].z * v[j].z + v[j].w * v[j].w); }
        const float rstd = rsqrtf(wave_sum(ss) * (1.0f / DM) + EPS);
#pragma unroll
        for (int j = 0; j < 4; ++j) { f32x4 o = v[j] * rstd * ((const f32x4*)g)[64 * j + lane_];
#ifdef DBGSCAN
            { const int code = *(const int*)(c.ws + WS_DBG); if (code != 0x7fffffff) { const float cv = sqrtf(2.0f * (float)code); o = (f32x4){cv, cv, cv, cv}; } }
#endif
            xr[64 * j + lane_] = o; }
    }
}

__device__ __forceinline__ void attn_unit(Ctx& c, int l, int b, int h, int qblk, bool ictx) {
    TLW;
    const __attribute__((address_space(4))) Params& p = *c.p;
    LAS bf16* Qs = (LAS bf16*)c.lds;
    LAS bf16* Ks = (LAS bf16*)(c.lds + 18432);
    LAS bf16* Vt = (LAS bf16*)(c.lds + 27648);
    LAS bf16* Ps = (LAS bf16*)(c.lds + 36864) + wave_ * (16 * 72);
    const int tid = tid_, lane = lane_, w = wave_, lr = lane & 15, lg = lane >> 4;
    const int hk = h >> 2;
    const size_t qrow0 = ictx ? (size_t)ML + b * CTXL + qblk * 128 : (size_t)b * SEQ + qblk * 128;
    {
        const int row = tid >> 2, part = tid & 3, d0 = (part & 1) * 8 + (part >> 1) * 32;
        const bf16* src = ((bf16*)(c.ws + WS_P1)) + (qrow0 + row) * LP + C_Q + h * 64 + d0;
        float lo[8], hi[8]; unpack8(*(const v4u*)src, lo); unpack8(*(const v4u*)(src + 16), hi);
        if (!ictx) { const int t = qblk * 128 + row, pos = (part >> 1) ? (t & 63) : (t >> 6); const float* rt = ((const float*)(c.ws + WS_ROPE)) + pos * 32 + (d0 & 15);
#pragma unroll
            for (int j = 0; j < 8; ++j) { const float cs = rt[j], sn = rt[16 + j]; const float a = lo[j], bb = hi[j]; lo[j] = a * cs - bb * sn; hi[j] = bb * cs + a * sn; } }
        *(LAS v4u*)(Qs + row * 72 + d0) = pack8(lo); *(LAS v4u*)(Qs + row * 72 + d0 + 16) = pack8(hi);
    }
    __syncthreads();
    bf16x8 qa[2];
#pragma unroll
    for (int ks = 0; ks < 2; ++ks) qa[ks] = *(const LAS bf16x8*)(Qs + (16 * w + lr) * 72 + ks * 32 + lg * 8);
    const float sink = ((const float*)(const __attribute__((address_space(1))) float*)p.in[I_SINK])[l * 8 + h];
    float mrow[4], lrow[4]; f32x4 oacc[4];
#pragma unroll
    for (int j = 0; j < 4; ++j) { mrow[j] = sink; lrow[j] = (lr == 0) ? 1.0f : 0.0f; }
#pragma unroll
    for (int db = 0; db < 4; ++db) oacc[db] = zero4();
    const int ntile = ictx ? 4 : 10;
    for (int kt = 0; kt < ntile; ++kt) {
        const bool band = !ictx && kt < 6;
        const int kpos0 = (qblk - 1) * 128 + kt * 64;
        if (band && (kpos0 < 0 || kpos0 >= SEQ)) continue;
        const size_t krow0 = band ? (size_t)b * SEQ + kpos0 : (size_t)ML + b * CTXL + (ictx ? kt : kt - 6) * 64;
        __syncthreads();
        if (tid < 256) {
            const int row = tid >> 2, part = tid & 3, d0 = (part & 1) * 8 + (part >> 1) * 32;
            const bf16* src = ((bf16*)(c.ws + WS_P1)) + (krow0 + row) * LP + C_K + hk * 64 + d0;
            float lo[8], hi[8]; unpack8(*(const v4u*)src, lo); unpack8(*(const v4u*)(src + 16), hi);
            if (band) { const int t = kpos0 + row, pos = (part >> 1) ? (t & 63) : (t >> 6); const float* rt = ((const float*)(c.ws + WS_ROPE)) + pos * 32 + (d0 & 15);
#pragma unroll
                for (int j = 0; j < 8; ++j) { const float cs = rt[j], sn = rt[16 + j]; const float a = lo[j], bb = hi[j]; lo[j] = a * cs - bb * sn; hi[j] = bb * cs + a * sn; } }
            *(LAS v4u*)(Ks + row * 72 + d0) = pack8(lo); *(LAS v4u*)(Ks + row * 72 + d0 + 16) = pack8(hi);
        }
        {
            const int key = tid >> 3, dg = tid & 7;
            const v4u vv = *(const v4u*)(((bf16*)(c.ws + WS_P1)) + (krow0 + key) * LP + C_V + hk * 64 + dg * 8);
            LAS bf16* d = Vt + (dg * 8) * 72 + key;
            d[0] = (bf16)(vv.x & 0xffffu); d[72] = (bf16)(vv.x >> 16); d[144] = (bf16)(vv.y & 0xffffu); d[216] = (bf16)(vv.y >> 16);
            d[288] = (bf16)(vv.z & 0xffffu); d[360] = (bf16)(vv.z >> 16); d[432] = (bf16)(vv.w & 0xffffu); d[504] = (bf16)(vv.w >> 16);
        }
        __syncthreads();
        f32x4 s[4];
#pragma unroll
        for (int nb = 0; nb < 4; ++nb) { s[nb] = zero4();
#pragma unroll
            for (int ks = 0; ks < 2; ++ks) { const bf16x8 kb = *(const LAS bf16x8*)(Ks + (nb * 16 + lr) * 72 + ks * 32 + lg * 8); s[nb] = MFMA16(qa[ks], kb, s[nb]); } }
        float mx[4];
#pragma unroll
        for (int j = 0; j < 4; ++j) mx[j] = -3.0e38f;
#pragma unroll
        for (int nb = 0; nb < 4; ++nb)
#pragma unroll
            for (int j = 0; j < 4; ++j) { float v = s[nb][j] * 0.125f;
                if (band) { const int kp = kpos0 + nb * 16 + lr, qp = qblk * 128 + 16 * w + lg * 4 + j; const int dd = kp - qp; if (dd > 128 || dd < -128) v = -1.0e30f; }
                s[nb][j] = v; mx[j] = fmaxf(mx[j], v); DBGF(!(fabsf(v) < 1e31f), 7); }
        float corr[4];
#pragma unroll
        for (int j = 0; j < 4; ++j) { float v = mx[j]; v = fmaxf(v, shx(v, 1)); v = fmaxf(v, shx(v, 2)); v = fmaxf(v, shx(v, 4)); v = fmaxf(v, shx(v, 8));
            const float mn = fmaxf(mrow[j], v); corr[j] = __expf(mrow[j] - mn); mrow[j] = mn; lrow[j] *= corr[j]; }
#pragma unroll
        for (int nb = 0; nb < 4; ++nb)
#pragma unroll
            for (int j = 0; j < 4; ++j) { const float pv = __expf(s[nb][j] - mrow[j]); lrow[j] += pv; DBGF(!(pv <= 1.0f && pv >= 0.f), 8); Ps[(lg * 4 + j) * 72 + nb * 16 + lr] = (bf16)(pk2(pv, 0.f) & 0xffffu); }
#pragma unroll
        for (int db = 0; db < 4; ++db)
#pragma unroll
            for (int j = 0; j < 4; ++j) oacc[db][j] *= corr[j];
        LDS_FENCE();
        bf16x8 pa[2];
#pragma unroll
        for (int ks = 0; ks < 2; ++ks) pa[ks] = *(const LAS bf16x8*)(Ps + lr * 72 + ks * 32 + lg * 8);
#pragma unroll
        for (int db = 0; db < 4; ++db)
#pragma unroll
            for (int ks = 0; ks < 2; ++ks) { const bf16x8 vb = *(const LAS bf16x8*)(Vt + (db * 16 + lr) * 72 + ks * 32 + lg * 8); oacc[db] = MFMA16(pa[ks], vb, oacc[db]); }
        LDS_FENCE();
    }
#pragma unroll
    for (int j = 0; j < 4; ++j) { float v = lrow[j]; v += shx(v, 1); v += shx(v, 2); v += shx(v, 4); v += shx(v, 8); DBGF(!(v >= 0.999f), 9); lrow[j] = 1.0f / v; }
    for (int db = 0; db < 4; ++db) for (int j = 0; j < 4; ++j) DBGF(!(fabsf(oacc[db][j]) < 16384.f), 10);
#pragma unroll
    for (int db = 0; db < 4; ++db)
#pragma unroll
        for (int j = 0; j < 4; ++j) ((bf16*)(c.ws + WS_BO))[(qrow0 + 16 * w + lg * 4 + j) * LBO + h * 64 + db * 16 + lr] = (bf16)(pk2(oacc[db][j] * lrow[j], 0.f) & 0xffffu);
    __syncthreads();
}

#define DPP_ROR(v, n) __builtin_bit_cast(float, __builtin_amdgcn_update_dpp(0, __builtin_bit_cast(int, (v)), 0x120 + (n), 0xf, 0xf, false))
__device__ __forceinline__ float row16_max(float v) { v = fmaxf(v, DPP_ROR(v, 8)); v = fmaxf(v, DPP_ROR(v, 4)); v = fmaxf(v, DPP_ROR(v, 2)); v = fmaxf(v, DPP_ROR(v, 1)); return v; }
__device__ __forceinline__ float row16_sum(float v) { v += DPP_ROR(v, 8); v += DPP_ROR(v, 4); v += DPP_ROR(v, 2); v += DPP_ROR(v, 1); return v; }
__device__ __forceinline__ void rope8(const float* rt, float (&lo)[8], float (&hi)[8]) {
    const f32x4 c0 = *(const f32x4*)rt, c1 = *(const f32x4*)(rt + 4), s0 = *(const f32x4*)(rt + 16), s1 = *(const f32x4*)(rt + 20);
    const float cs[8] = {c0.x, c0.y, c0.z, c0.w, c1.x, c1.y, c1.z, c1.w}, sn[8] = {s0.x, s0.y, s0.z, s0.w, s1.x, s1.y, s1.z, s1.w};
#pragma unroll
    for (int j = 0; j < 8; ++j) { const float a = lo[j], bb = hi[j]; lo[j] = a * cs[j] - bb * sn[j]; hi[j] = bb * cs[j] + a * sn[j]; }
}
__device__ __forceinline__ void attn_stage(const bf16* p1, const float* rope, int tid, int b, int hk, int qblk, bool ictx, int kt, LAS bf16* Ks, LAS bf16* Vt) {
    const bool band = !ictx && kt < 6; const int kpos0 = (qblk - 1) * 128 + kt * 64;
    const size_t krow0 = band ? (size_t)b * SEQ + kpos0 : (size_t)ML + b * CTXL + (ictx ? kt : kt - 6) * 64;
    if (tid < 256) {
        const int row = tid >> 2, part = tid & 3, d0 = (part & 1) * 8 + (part >> 1) * 32;
        const bf16* src = p1 + (krow0 + row) * LP + C_K + hk * 64 + d0;
        float lo[8], hi[8]; unpack8(*(const v4u*)src, lo); unpack8(*(const v4u*)(src + 16), hi);
        if (band) { const int t = kpos0 + row, pos = (part >> 1) ? (t & 63) : (t >> 6); rope8(rope + pos * 32 + (d0 & 15), lo, hi); }
        *(LAS v4u*)(Ks + row * 72 + d0) = pack8(lo); *(LAS v4u*)(Ks + row * 72 + d0 + 16) = pack8(hi);
    }
    { const int key = tid >> 3, dg = tid & 7;
      const v4u vv = *(const v4u*)(p1 + (krow0 + key) * LP + C_V + hk * 64 + dg * 8);
      LAS bf16* d = Vt + (dg * 8) * 72 + key;
      d[0] = (bf16)(vv.x & 0xffffu); d[72] = (bf16)(vv.x >> 16); d[144] = (bf16)(vv.y & 0xffffu); d[216] = (bf16)(vv.y >> 16);
      d[288] = (bf16)(vv.z & 0xffffu); d[360] = (bf16)(vv.z >> 16); d[432] = (bf16)(vv.w & 0xffffu); d[504] = (bf16)(vv.w >> 16); }
}
struct AttnPre { v4u k0, k1, v; };
__device__ __forceinline__ void attn_load(const bf16* p1, int tid, int b, int hk, int qblk, bool ictx, int kt, AttnPre& r) {
    const bool band = !ictx && kt < 6; const int kpos0 = (qblk - 1) * 128 + kt * 64;
    const size_t krow0 = band ? (size_t)b * SEQ + kpos0 : (size_t)ML + b * CTXL + (ictx ? kt : kt - 6) * 64;
    { const int row = (tid & 255) >> 2, part = tid & 3, d0 = (part & 1) * 8 + (part >> 1) * 32; const bf16* src = p1 + (krow0 + row) * LP + C_K + hk * 64 + d0; r.k0 = *(const v4u*)src; r.k1 = *(const v4u*)(src + 16); }
    { const int key = tid >> 3, dg = tid & 7; r.v = *(const v4u*)(p1 + (krow0 + key) * LP + C_V + hk * 64 + dg * 8); }
}
__device__ __forceinline__ void attn_commit(const float* rope, int tid, int qblk, bool ictx, int kt, const AttnPre& r, LAS bf16* Ks, LAS bf16* Vt) {
    const bool band = !ictx && kt < 6; const int kpos0 = (qblk - 1) * 128 + kt * 64;
    if (tid < 256) {
        const int row = tid >> 2, part = tid & 3, d0 = (part & 1) * 8 + (part >> 1) * 32;
        float lo[8], hi[8]; unpack8(r.k0, lo); unpack8(r.k1, hi);
        if (band) { const int t = kpos0 + row, pos = (part >> 1) ? (t & 63) : (t >> 6); rope8(rope + pos * 32 + (d0 & 15), lo, hi); }
        *(LAS v4u*)(Ks + row * 72 + d0) = pack8(lo); *(LAS v4u*)(Ks + row * 72 + d0 + 16) = pack8(hi);
    }
    { const int key = tid >> 3, dg = tid & 7; const v4u vv = r.v;
      LAS bf16* d = Vt + (dg * 8) * 72 + key;
      d[0] = (bf16)(vv.x & 0xffffu); d[72] = (bf16)(vv.x >> 16); d[144] = (bf16)(vv.y & 0xffffu); d[216] = (bf16)(vv.y >> 16);
      d[288] = (bf16)(vv.z & 0xffffu); d[360] = (bf16)(vv.z >> 16); d[432] = (bf16)(vv.w & 0xffffu); d[504] = (bf16)(vv.w >> 16); }
}
__device__ __forceinline__ bool attn_tile_ok(bool ictx, int qblk, int kt) { if (ictx || kt >= 6) return true; const int kpos0 = (qblk - 1) * 128 + kt * 64; return kpos0 >= 0 && kpos0 < SEQ; }
__device__ __forceinline__ void attn_unit4(Ctx& c, int l, int b, int hk, int qblk, bool ictx) {
    TLW;
    const __attribute__((address_space(4))) Params& p = *c.p;
    LAS bf16* Qs = (LAS bf16*)c.lds;
    LAS bf16* KB = (LAS bf16*)(c.lds + 73728);
    LAS bf16* VB = (LAS bf16*)(c.lds + 73728 + 18432);
    LAS bf16* Ps = (LAS bf16*)(c.lds + 73728 + 36864) + wave_ * (16 * 72);
    const int tid = tid_, lane = lane_, w = wave_, lr = lane & 15, lg = lane >> 4, g = w >> 1, half = w & 1;
    const bf16* p1 = ((bf16*)(c.ws + WS_P1)); const float* rope = ((const float*)(c.ws + WS_ROPE));
    const size_t qrow0 = ictx ? (size_t)ML + b * CTXL + qblk * 128 : (size_t)b * SEQ + qblk * 128;
#pragma unroll
    for (int rep = 0; rep < 4; ++rep) {
        const int it = tid + rep * 512, hh = it >> 9, row = (it >> 2) & 127, part = it & 3, d0 = (part & 1) * 8 + (part >> 1) * 32;
        const bf16* src = p1 + (qrow0 + row) * LP + C_Q + (hk * 4 + hh) * 64 + d0;
        float lo[8], hi[8]; unpack8(*(const v4u*)src, lo); unpack8(*(const v4u*)(src + 16), hi);
        if (!ictx) { const int t = qblk * 128 + row, pos = (part >> 1) ? (t & 63) : (t >> 6); rope8(rope + pos * 32 + (d0 & 15), lo, hi); }
        *(LAS v4u*)(Qs + (hh * 128 + row) * 72 + d0) = pack8(lo); *(LAS v4u*)(Qs + (hh * 128 + row) * 72 + d0 + 16) = pack8(hi);
    }
    const int ntile = ictx ? 4 : 10;
    int kt = 0; while (!attn_tile_ok(ictx, qblk, kt)) ++kt;
    attn_stage(p1, rope, tid, b, hk, qblk, ictx, kt, KB, VB);
    __syncthreads();
    constexpr float L2E = 1.4426950408889634f, QSC = 0.125f * L2E;
    const int ol_ = olane();
    const float sink2 = ((const float*)(const __attribute__((address_space(1))) float*)p.in[I_SINK])[l * 8 + hk * 4 + g] * L2E;
    float mrow[4], lrow[4]; f32x4 oacc[4][4];
#pragma unroll
    for (int rb = 0; rb < 4; ++rb) { mrow[rb] = sink2; lrow[rb] = (lg == 0) ? 1.0f : 0.0f;
#pragma unroll
        for (int db = 0; db < 4; ++db) oacc[rb][db] = zero4(); }
    int buf = 0;
    while (kt < ntile) {
        int kn = kt + 1; while (kn < ntile && !attn_tile_ok(ictx, qblk, kn)) ++kn;
        AttnPre pre; if (kn < ntile) attn_load(p1, tid, b, hk, qblk, ictx, kn, pre);
        const LAS bf16* Ks = KB + buf * (64 * 72); const LAS bf16* Vt = VB + buf * (64 * 72);
        const bool msk = !ictx && (kt < 2 || kt == 4 || kt == 5); const int kpos0 = (qblk - 1) * 128 + kt * 64;
        bf16x8 vf[4][2];
#pragma unroll
        for (int db = 0; db < 4; ++db)
#pragma unroll
            for (int ks = 0; ks < 2; ++ks) { const v2u a0 = *(const LAS v2u*)(Vt + (db * 16 + lr) * 72 + ks * 32 + lg * 4), a1 = *(const LAS v2u*)(Vt + (db * 16 + lr) * 72 + ks * 32 + 16 + lg * 4);
                vf[db][ks] = __builtin_bit_cast(bf16x8, (v4u){a0.x, a0.y, a1.x, a1.y}); }
#pragma unroll
        for (int rb = 0; rb < 4; ++rb) {
            if (msk) { const int q0_ = qblk * 128 + half * 64 + rb * 16; if (kpos0 > q0_ + 15 + 128 || kpos0 + 63 < q0_ - 128) continue; }
            f32x4 st[4];
            const bf16x8 qa0 = *(const LAS bf16x8*)(Qs + (g * 128 + half * 64 + rb * 16 + lr) * 72 + lg * 8), qa1 = *(const LAS bf16x8*)(Qs + (g * 128 + half * 64 + rb * 16 + lr) * 72 + 32 + lg * 8);
#pragma unroll
            for (int nb = 0; nb < 4; ++nb) { const bf16x8 kb0 = *(const LAS bf16x8*)(Ks + (nb * 16 + lr) * 72 + lg * 8), kb1 = *(const LAS bf16x8*)(Ks + (nb * 16 + lr) * 72 + 32 + lg * 8);
                st[nb] = MFMA16(kb0, qa0, ((f32x4){0.f, 0.f, 0.f, 0.f})); st[nb] = MFMA16(kb1, qa1, st[nb]); }
            float mx = -3.0e38f;
#pragma unroll
            for (int nb = 0; nb < 4; ++nb)
#pragma unroll
                for (int j = 0; j < 4; ++j) { float v = st[nb][j] * QSC;
                    if (msk) { const int kp = kpos0 + nb * 16 + lg * 4 + j, qp = qblk * 128 + half * 64 + rb * 16 + lr; const int dd = kp - qp; if (dd > 128 || dd < -128) v = -1.0e30f; }
                    st[nb][j] = v; mx = fmaxf(mx, v); }
            mx = fmaxf(mx, shi(mx, ol_ ^ 16)); mx = fmaxf(mx, shi(mx, ol_ ^ 32));
            const float mn = fmaxf(mrow[rb], mx), corr = __builtin_amdgcn_exp2f(mrow[rb] - mn); mrow[rb] = mn;
            float ls = 0.f;
#pragma unroll
            for (int nb = 0; nb < 4; ++nb)
#pragma unroll
                for (int j = 0; j < 4; ++j) { const float pv = __builtin_amdgcn_exp2f(st[nb][j] - mn); st[nb][j] = pv; ls += pv; }
            lrow[rb] = lrow[rb] * corr + ls;
            bf16x8 pb[2];
#pragma unroll
            for (int ks = 0; ks < 2; ++ks) pb[ks] = __builtin_bit_cast(bf16x8, (v4u){pk2(st[2 * ks][0], st[2 * ks][1]), pk2(st[2 * ks][2], st[2 * ks][3]), pk2(st[2 * ks + 1][0], st[2 * ks + 1][1]), pk2(st[2 * ks + 1][2], st[2 * ks + 1][3])});
#pragma unroll
            for (int db = 0; db < 4; ++db) { oacc[rb][db] = oacc[rb][db] * corr;
#pragma unroll
                for (int ks = 0; ks < 2; ++ks) oacc[rb][db] = MFMA16(vf[db][ks], pb[ks], oacc[rb][db]); }
        }
        if (kn < ntile) attn_commit(rope, tid, qblk, ictx, kn, pre, KB + (buf ^ 1) * (64 * 72), VB + (buf ^ 1) * (64 * 72));
        __syncthreads();
        kt = kn; buf ^= 1;
    }
    bf16* bo = ((bf16*)(c.ws + WS_BO));
#pragma unroll
    for (int rb = 0; rb < 4; ++rb) {
        float lt = lrow[rb]; lt += shi(lt, ol_ ^ 16); lt += shi(lt, ol_ ^ 32);
        const float inv = 1.0f / lt;
#pragma unroll
        for (int db = 0; db < 4; ++db) { v2u o; o.x = pk2(oacc[rb][db][0] * inv, oacc[rb][db][1] * inv); o.y = pk2(oacc[rb][db][2] * inv, oacc[rb][db][3] * inv);
            *(v2u*)(bo + (qrow0 + half * 64 + rb * 16 + lr) * LBO + (hk * 4 + g) * 64 + db * 16 + lg * 4) = o; }
    }
    __syncthreads();
}

__device__ __forceinline__ void conv_unit(Ctx& c, int l, int u) {
    TLW;
    const __attribute__((address_space(4))) Params& p = *c.p;
    LAS bf16* Zs = (LAS bf16*)c.lds;
    const int r0 = u * 64;
    const int seq_lo = r0 < ML ? (r0 / SEQ) * SEQ : ML + ((r0 - ML) / CTXL) * CTXL, seq_hi = seq_lo + (r0 < ML ? SEQ : CTXL);
    for (int it = tid_; it < 94 * 64; it += 512) {
        const int zr = it >> 6, cg8 = (it & 63) * 8; const int g = r0 - 15 + zr;
        v4u o = zero4u();
        if (g >= seq_lo && g < seq_hi) o = *(const v4u*)(((bf16*)(c.ws + WS_P1)) + (size_t)g * LP + C_GLU + cg8);
        *(LAS v4u*)(Zs + zr * 520 + cg8) = o;
    }
    __syncthreads();
    const int c0 = lane_ * 8, t0 = wave_ * 8;
    const float* wdw = ((const float*)(const __attribute__((address_space(1))) float*)p.in[I_WDW]) + (size_t)l * 31 * 512 + c0;
    float acc[8][8];
    { const f32x4 b0 = *(const f32x4*)(((const float*)(const __attribute__((address_space(1))) float*)p.in[I_BDW]) + l * 512 + c0), b1 = *(const f32x4*)(((const float*)(const __attribute__((address_space(1))) float*)p.in[I_BDW]) + l * 512 + c0 + 4);
#pragma unroll
      for (int t = 0; t < 8; ++t) { acc[t][0] = b0.x; acc[t][1] = b0.y; acc[t][2] = b0.z; acc[t][3] = b0.w; acc[t][4] = b1.x; acc[t][5] = b1.y; acc[t][6] = b1.z; acc[t][7] = b1.w; } }
    float zw[8][8];
#pragma unroll
    for (int t = 0; t < 7; ++t) unpack8(*(const LAS v4u*)(Zs + (t0 + t) * 520 + c0), zw[t]);
    f32x4 wa = *(const f32x4*)(wdw), wb = *(const f32x4*)(wdw + 4);
#pragma unroll 1
    for (int j0 = 0; j0 < 32; j0 += 8) {
#pragma unroll
        for (int jj = 0; jj < 8; ++jj) {
            const int j = j0 + jj;
            if (j <= 30) {
                unpack8(*(const LAS v4u*)(Zs + (t0 + j + 7) * 520 + c0), zw[(jj + 7) & 7]);
                const float wv[8] = {wa.x, wa.y, wa.z, wa.w, wb.x, wb.y, wb.z, wb.w};
                if (j < 30) { wa = *(const f32x4*)(wdw + (j + 1) * 512); wb = *(const f32x4*)(wdw + (j + 1) * 512 + 4); }
#pragma unroll
                for (int t = 0; t < 8; ++t)
#pragma unroll
                    for (int i = 0; i < 8; ++i) acc[t][i] += wv[i] * zw[(jj + t) & 7][i];
            }
        }
    }
    const f32x4 g0 = *(const f32x4*)(((const float*)(const __attribute__((address_space(1))) float*)p.in[I_GCLN]) + l * 512 + c0), g1 = *(const f32x4*)(((const float*)(const __attribute__((address_space(1))) float*)p.in[I_GCLN]) + l * 512 + c0 + 4);
    const f32x4 e0 = *(const f32x4*)(((const float*)(const __attribute__((address_space(1))) float*)p.in[I_BCLN]) + l * 512 + c0), e1 = *(const f32x4*)(((const float*)(const __attribute__((address_space(1))) float*)p.in[I_BCLN]) + l * 512 + c0 + 4);
    const float gg[8] = {g0.x, g0.y, g0.z, g0.w, g1.x, g1.y, g1.z, g1.w}, ee[8] = {e0.x, e0.y, e0.z, e0.w, e1.x, e1.y, e1.z, e1.w};
    float sm[8], sq[8];
#pragma unroll
    for (int t = 0; t < 8; ++t) { float s = 0.f;
#pragma unroll
        for (int i = 0; i < 8; ++i) s += acc[t][i];
        sm[t] = s; }
    wave_sum8(sm);
#pragma unroll
    for (int t = 0; t < 8; ++t) { const float mean = sm[t] * (1.0f / 512.0f); float q = 0.f;
#pragma unroll
        for (int i = 0; i < 8; ++i) { acc[t][i] -= mean; q += acc[t][i] * acc[t][i]; }
        sq[t] = q; }
    wave_sum8(sq);
#pragma unroll
    for (int t = 0; t < 8; ++t) {
        const float rstd = rsqrtf(sq[t] * (1.0f / 512.0f) + EPS);
        float y[8];
#pragma unroll
        for (int i = 0; i < 8; ++i) { const float v = acc[t][i] * rstd * gg[i] + ee[i]; y[i] = siluf_(v); }
        *(v4u*)(((bf16*)(c.ws + WS_BO)) + (size_t)(r0 + t0 + t) * LBO + 512 + c0) = pack8(y);
    }
    __syncthreads();
}

__device__ __forceinline__ void qk_conv8(const bf16* p1, const float* wmc, int row, int seq_lo, int seq_hi, int col, float scale, float (&o)[8]) {
    float xm[8], x0[8], xp[8];
    const bool hm = row - 1 >= seq_lo, hp = row + 1 < seq_hi;
    const v4u r0_ = *(const v4u*)(p1 + (size_t)row * LP + C_QKM + col), rm_ = *(const v4u*)(p1 + (size_t)(hm ? row - 1 : row) * LP + C_QKM + col), rp_ = *(const v4u*)(p1 + (size_t)(hp ? row + 1 : row) * LP + C_QKM + col);
    unpack8(r0_, x0); unpack8(rm_, xm); unpack8(rp_, xp);
#pragma unroll
    for (int i = 0; i < 8; ++i) { xm[i] = hm ? xm[i] : 0.f; xp[i] = hp ? xp[i] : 0.f; }
    const f32x4 wa0 = *(const f32x4*)(wmc + col), wa1 = *(const f32x4*)(wmc + col + 4), wb0 = *(const f32x4*)(wmc + 1024 + col), wb1 = *(const f32x4*)(wmc + 1024 + col + 4), wc0 = *(const f32x4*)(wmc + 2048 + col), wc1 = *(const f32x4*)(wmc + 2048 + col + 4);
    const float wa[8] = {wa0.x, wa0.y, wa0.z, wa0.w, wa1.x, wa1.y, wa1.z, wa1.w}, wb[8] = {wb0.x, wb0.y, wb0.z, wb0.w, wb1.x, wb1.y, wb1.z, wb1.w}, wc[8] = {wc0.x, wc0.y, wc0.z, wc0.w, wc1.x, wc1.y, wc1.z, wc1.w};
#pragma unroll
    for (int i = 0; i < 8; ++i) { const float v = wa[i] * xm[i] + wb[i] * x0[i] + wc[i] * xp[i]; o[i] = siluf_(v) * scale; }
}
__device__ __forceinline__ void chunk_rows(int b, int jc, int& r0, int& seq_lo, int& seq_hi) {
    if (jc < 4) { seq_lo = ML + b * CTXL; seq_hi = seq_lo + CTXL; r0 = seq_lo + jc * 64; } else { seq_lo = b * SEQ; seq_hi = seq_lo + SEQ; r0 = seq_lo + (jc - 4) * 64; }
}
__device__ __forceinline__ void m1_unit(Ctx& c, int l, int b, int h, int jc) {
    TLW;
    const __attribute__((address_space(4))) Params& p = *c.p;
    LAS bf16* Vt = (LAS bf16*)c.lds;
    LAS bf16* Kt = (LAS bf16*)(c.lds + 18432);
    LAS float* wts = (LAS float*)(c.lds + 36864);
    const int tid = tid_, lane = lane_, w = wave_, lr = lane & 15, lg = lane >> 4;
    const bf16* p1 = ((bf16*)(c.ws + WS_P1));
    int r0, seq_lo, seq_hi; chunk_rows(b, jc, r0, seq_lo, seq_hi);
    const int chf = (b * 4 + h) * 2, chb = chf + 1, pf = jc, pb = jc < 4 ? 3 - jc : 71 - jc;
    if (w == 0) {
        const bf16* gp = p1 + (size_t)(r0 + lane) * LP + C_GM + h; const float* bm = ((const float*)(const __attribute__((address_space(1))) float*)p.in[I_BMG]) + l * 16 + h;
        const float i_f = bf2f(gp[0]) + bm[0], i_b = bf2f(gp[4]) + bm[4], lf_f = logsigf_(bf2f(gp[8]) + bm[8]), lf_b = logsigf_(bf2f(gp[12]) + bm[12]);
        const float cf = scan_add(lf_f, lane), cb = scan_add(lf_b, lane);
        const float bend_f = shi(cf, 63), bend_b = shi(cb, 63);
        const float g_f = bend_f - cf + i_f, g_b = (cb - lf_b) + i_b;
        const float mu_f = wave_max(g_f), mu_b = wave_max(g_b);
        wts[lane] = __expf(g_f - mu_f); wts[64 + lane] = __expf(g_b - mu_b);
        if (lane == 0) { float* be = ((float*)(c.ws + WS_BEND)); float* mu = ((float*)(c.ws + WS_MU)); be[chf * NCHUNK + pf] = bend_f; mu[chf * NCHUNK + pf] = mu_f; be[chb * NCHUNK + pb] = bend_b; mu[chb * NCHUNK + pb] = mu_b; }
    } else {
        const float* wmc = ((const float*)(const __attribute__((address_space(1))) float*)p.in[I_WMCONV]) + (size_t)l * 3 * 1024;
#pragma unroll
        for (int k_ = 0; k_ < 3; ++k_) { const int it0 = tid - 64 + k_ * 448; const bool ok = it0 < 1024; const int it = ok ? it0 : 1023;
            const int W = it >> 6, ln = it & 63, cg8 = ((ln >> 4) + 4 * (W & 3)) * 8, s = (ln & 15) + 16 * (W >> 2);
            const v4u vv = *(const v4u*)(p1 + (size_t)(r0 + s) * LP + C_VM + h * 128 + cg8);
            float k[8]; qk_conv8(p1, wmc, r0 + s, seq_lo, seq_hi, 512 + h * 128 + cg8, 0.08838834764831845f, k);
            if (!ok) continue;
            LAS bf16* d = Vt + cg8 * 72 + s;
            d[0] = (bf16)(vv.x & 0xffffu); d[72] = (bf16)(vv.x >> 16); d[144] = (bf16)(vv.y & 0xffffu); d[216] = (bf16)(vv.y >> 16);
            d[288] = (bf16)(vv.z & 0xffffu); d[360] = (bf16)(vv.z >> 16); d[432] = (bf16)(vv.w & 0xffffu); d[504] = (bf16)(vv.w >> 16);
            const v4u kk = pack8(k); LAS bf16* e = Kt + cg8 * 72 + s;
            e[0] = (bf16)(kk.x & 0xffffu); e[72] = (bf16)(kk.x >> 16); e[144] = (bf16)(kk.y & 0xffffu); e[216] = (bf16)(kk.y >> 16);
            e[288] = (bf16)(kk.z & 0xffffu); e[360] = (bf16)(kk.z >> 16); e[432] = (bf16)(kk.w & 0xffffu); e[504] = (bf16)(kk.w >> 16);
        }
    }
    __syncthreads();
    bf16x8 vaf[2], vab[2];
#pragma unroll
    for (int ks = 0; ks < 2; ++ks) {
        float vf[8]; unpack8(*(const LAS v4u*)(Vt + (16 * w + lr) * 72 + ks * 32 + lg * 8), vf);
        const f32x4 f0 = *(const LAS f32x4*)(wts + ks * 32 + lg * 8), f1 = *(const LAS f32x4*)(wts + ks * 32 + lg * 8 + 4), b0 = *(const LAS f32x4*)(wts + 64 + ks * 32 + lg * 8), b1 = *(const LAS f32x4*)(wts + 64 + ks * 32 + lg * 8 + 4);
        const float xf[8] = {vf[0] * f0.x, vf[1] * f0.y, vf[2] * f0.z, vf[3] * f0.w, vf[4] * f1.x, vf[5] * f1.y, vf[6] * f1.z, vf[7] * f1.w};
        const float xb[8] = {vf[0] * b0.x, vf[1] * b0.y, vf[2] * b0.z, vf[3] * b0.w, vf[4] * b1.x, vf[5] * b1.y, vf[6] * b1.z, vf[7] * b1.w};
        vaf[ks] = __builtin_bit_cast(bf16x8, pack8(xf)); vab[ks] = __builtin_bit_cast(bf16x8, pack8(xb));
    }
    bf16* stf = ((bf16*)(c.ws + WS_ST)) + ((size_t)chf * NCHUNK + pf) * 16384; bf16* stb = ((bf16*)(c.ws + WS_ST)) + ((size_t)chb * NCHUNK + pb) * 16384;
#pragma unroll
    for (int m = 0; m < 4; ++m) {
        f32x4 af[2], ab[2];
#pragma unroll
        for (int hh = 0; hh < 2; ++hh) { af[hh] = zero4(); ab[hh] = zero4();
            const int dkrow = 32 * m + 8 * (lr >> 2) + 4 * hh + (lr & 3);
#pragma unroll
            for (int ks = 0; ks < 2; ++ks) { const bf16x8 kb = *(const LAS bf16x8*)(Kt + dkrow * 72 + ks * 32 + lg * 8); af[hh] = MFMA16(kb, vaf[ks], af[hh]); ab[hh] = MFMA16(kb, vab[ks], ab[hh]); } }
        const float rf[8] = {af[0][0], af[0][1], af[0][2], af[0][3], af[1][0], af[1][1], af[1][2], af[1][3]}, rbk[8] = {ab[0][0], ab[0][1], ab[0][2], ab[0][3], ab[1][0], ab[1][1], ab[1][2], ab[1][3]};
        *(v4u*)(stf + (16 * w + lr) * 128 + 32 * m + 8 * lg) = pack8(rf); *(v4u*)(stb + (16 * w + lr) * 128 + 32 * m + 8 * lg) = pack8(rbk);
    }
    if (tid < 256) { const int dir = tid >> 7, dk = tid & 127; const LAS bf16* Kd = Kt + dk * 72; const LAS float* wd = wts + dir * 64; float sm = 0.f;
#pragma unroll 8
        for (int i = 0; i < 64; ++i) sm += bf2f(Kd[i]) * wd[i];
        ((float*)(c.ws + WS_NS))[((size_t)(dir ? chb : chf) * NCHUNK + (dir ? pb : pf)) * 128 + dk] = sm; }
    __syncthreads();
}
__device__ __forceinline__ void phase_m2(Ctx& c) {
    TLW;
    for (int gid = c.bid * 512 + tid_; gid < 32 * 4096; gid += c.nblk * 512) {
        const int ch = gid >> 12, e4 = gid & 4095;
        v2u* sp = (v2u*)(((bf16*)(c.ws + WS_ST)) + (size_t)ch * NCHUNK * 16384) + e4;
        f32x4* np = (f32x4*)(((float*)(c.ws + WS_NS)) + (size_t)ch * NCHUNK * 128) + (e4 & 31);
        const float* be = ((float*)(c.ws + WS_BEND)) + ch * NCHUNK; const float* mu = ((float*)(c.ws + WS_MU)) + ch * NCHUNK; float* ms = ((float*)(c.ws + WS_MS)) + ch * NCHUNK;
        const bool do_n = e4 < 32;
        float m = -1.0e30f; f32x4 cs = zero4(), nsv = zero4();
#pragma unroll 1
        for (int q0 = 0; q0 < NCHUNK - 1; q0 += 16) {
            v2u uv[16]; float bq[16], mq[16]; f32x4 nv[16];
#pragma unroll
            for (int i = 0; i < 16; ++i) if (q0 + i < NCHUNK - 1) { uv[i] = sp[(size_t)(q0 + i) * 4096]; bq[i] = be[q0 + i]; mq[i] = mu[q0 + i]; if (do_n) nv[i] = np[(q0 + i) * 32]; }
#pragma unroll
            for (int i = 0; i < 16; ++i) if (q0 + i < NCHUNK - 1) {
                const float mn = fmaxf(bq[i] + m, mq[i]), dec = __expf(bq[i] + m - mn), sc = __expf(mq[i] - mn);
                cs.x = dec * cs.x + sc * bf2f(uv[i].x & 0xffffu); cs.y = dec * cs.y + sc * bf2f(uv[i].x >> 16); cs.z = dec * cs.z + sc * bf2f(uv[i].y & 0xffffu); cs.w = dec * cs.w + sc * bf2f(uv[i].y >> 16);
                v2u o; o.x = pk2(cs.x, cs.y); o.y = pk2(cs.z, cs.w); sp[(size_t)(q0 + i) * 4096] = o;
                if (do_n) { nsv = nsv * dec + nv[i] * sc; np[(q0 + i) * 32] = nsv; }
                if (e4 == 0) ms[q0 + i] = mn;
                m = mn;
            }
        }
    }
}
__device__ __forceinline__ void m3_unit(Ctx& c, int l, int b, int h, int jc) {
    TLW;
    const __attribute__((address_space(4))) Params& p = *c.p;
    LAS bf16* Qs = (LAS bf16*)c.lds;
    LAS bf16* Ks = (LAS bf16*)(c.lds + 17408);
    LAS bf16* Vt = (LAS bf16*)(c.lds + 34816);
    LAS bf16* Cs = (LAS bf16*)(c.lds + 53248);
    LAS float* HB = (LAS float*)(c.lds + 53248);
    LAS bf16* Ps = (LAS bf16*)(c.lds + 122880) + wave_ * (16 * 72);
    LAS float* sca = (LAS float*)(c.lds + 141312);
    LAS float* nin = (LAS float*)(c.lds + 143360);
    const int tid = tid_, lane = lane_, w = wave_, lr = lane & 15, lg = lane >> 4;
    int r0, seq_lo, seq_hi; chunk_rows(b, jc, r0, seq_lo, seq_hi);
    const int chf = (b * 4 + h) * 2, chb = chf + 1, pf = jc, pb = jc < 4 ? 3 - jc : 71 - jc;
    if (w < 2) {
        const int dir = w, ch = dir ? chb : chf, pp = dir ? pb : pf;
        const bf16* gp = ((bf16*)(c.ws + WS_P1)) + (size_t)(r0 + lane) * LP + C_GM + h + 4 * dir; const float* bm = ((const float*)(const __attribute__((address_space(1))) float*)p.in[I_BMG]) + l * 16 + h + 4 * dir;
        const float ig = bf2f(gp[0]) + bm[0], lf = logsigf_(bf2f(gp[8]) + bm[8]);
        const float m_in = pp > 0 ? ((float*)(c.ws + WS_MS))[ch * NCHUNK + pp - 1] : -1.0e30f;
        const int sl = dir ? 63 - lane : lane;
        const float lfp = shi(lf, sl), igp = shi(ig, sl);
        const float bcum = scan_add(lfp, lane);
        const float beta = igp - bcum;
        const float pmx = scan_max(beta, lane);
        const float a_t = bcum + m_in, mt = fmaxf(a_t, bcum + pmx);
        const float alpha = bcum - mt, wint = __expf(a_t - mt), emt = __expf(-mt);
        LAS float* s = sca + dir * 256;
        s[sl] = alpha; s[64 + sl] = beta; s[128 + sl] = wint; s[192 + sl] = emt;
    }
    if (w >= 2) {
        const float* wmc = ((const float*)(const __attribute__((address_space(1))) float*)p.in[I_WMCONV]) + (size_t)l * 3 * 1024;
        const bf16* p1 = ((bf16*)(c.ws + WS_P1));
#pragma unroll
        for (int k_ = 0; k_ < 6; ++k_) { const int it0 = tid - 128 + k_ * 384; const bool ok = it0 < 2048; const int it = ok ? it0 : 2047;
            const int isk = it >> 10, s = (it >> 4) & 63, cg8 = (it & 15) * 8;
            float o[8]; qk_conv8(p1, wmc, r0 + s, seq_lo, seq_hi, isk * 512 + h * 128 + cg8, isk ? 0.08838834764831845f : 1.0f, o);
            if (ok) *(LAS v4u*)((isk ? Ks : Qs) + s * 136 + cg8) = pack8(o);
        }
#pragma unroll
        for (int k_ = 0; k_ < 3; ++k_) { const int it0 = tid - 128 + k_ * 384; const bool ok = it0 < 1024; const int it = ok ? it0 : 1023;
            const int W = it >> 6, ln = it & 63, cg8 = ((ln >> 4) + 4 * (W & 3)) * 8, s = (ln & 15) + 16 * (W >> 2);
            const v4u vv = *(const v4u*)(p1 + (size_t)(r0 + s) * LP + C_VM + h * 128 + cg8);
            if (!ok) continue;
            LAS bf16* d = Vt + cg8 * 72 + s;
            d[0] = (bf16)(vv.x & 0xffffu); d[72] = (bf16)(vv.x >> 16); d[144] = (bf16)(vv.y & 0xffffu); d[216] = (bf16)(vv.y >> 16);
            d[288] = (bf16)(vv.z & 0xffffu); d[360] = (bf16)(vv.z >> 16); d[432] = (bf16)(vv.w & 0xffffu); d[504] = (bf16)(vv.w >> 16);
        }
#pragma unroll
        for (int dir = 0; dir < 2; ++dir) {
            const int ch = dir ? chb : chf, pp = dir ? pb : pf;
            const v4u* src = (const v4u*)(((bf16*)(c.ws + WS_ST)) + ((size_t)ch * NCHUNK + (pp > 0 ? pp - 1 : 0)) * 16384);
#pragma unroll
            for (int k_ = 0; k_ < 6; ++k_) { const int it0 = tid - 128 + k_ * 384; const bool ok = it0 < 2048; const int it = ok ? it0 : 2047; const int dv = it >> 4, ck = (it & 15) * 8; v4u v = src[it]; if (pp <= 0) v = zero4u();
                if (ok) *(LAS v4u*)(Cs + dir * (128 * 136) + dv * 136 + ck) = v; }
        }
        if (tid - 128 < 256) { const int q = tid - 128, dir = q >> 7, k = q & 127, ch = dir ? chb : chf, pp = dir ? pb : pf; nin[q] = pp > 0 ? ((float*)(c.ws + WS_NS))[((size_t)ch * NCHUNK + pp - 1) * 128 + k] : 0.f; }
    }
    __syncthreads();
    const int dir = w >> 2, rb = w & 3;
    const LAS float* sd = sca + dir * 256;
    const int t = 16 * rb + lr;
    const float al = sd[t], wi = sd[128 + t], em = sd[192 + t];
    bf16x8 qa[4];
#pragma unroll
    for (int ks = 0; ks < 4; ++ks) qa[ks] = *(const LAS bf16x8*)(Qs + t * 136 + ks * 32 + lg * 8);
    f32x4 st[4]; float rs = 0.f;
#pragma unroll
    for (int nb = 0; nb < 4; ++nb) { f32x4 a = zero4();
#pragma unroll
        for (int ks = 0; ks < 4; ++ks) { const bf16x8 kb = *(const LAS bf16x8*)(Ks + (nb * 16 + lr) * 136 + ks * 32 + lg * 8); a = MFMA16(kb, qa[ks], a); }
        const f32x4 be = *(const LAS f32x4*)(sd + 64 + nb * 16 + lg * 4);
#pragma unroll
        for (int j = 0; j < 4; ++j) { const int s_ = nb * 16 + lg * 4 + j; const bool valid = dir ? (s_ >= t) : (s_ <= t);
            const float pv = valid ? a[j] * __expf(al + be[j]) : 0.f; rs += pv; a[j] = pv; }
        st[nb] = a; }
    bf16x8 pfr[2];
#pragma unroll
    for (int ks = 0; ks < 2; ++ks) pfr[ks] = __builtin_bit_cast(bf16x8, (v4u){pk2(st[2 * ks][0], st[2 * ks][1]), pk2(st[2 * ks][2], st[2 * ks][3]), pk2(st[2 * ks + 1][0], st[2 * ks + 1][1]), pk2(st[2 * ks + 1][2], st[2 * ks + 1][3])});
    f32x4 oacc[8];
#pragma unroll
    for (int db = 0; db < 8; ++db) { f32x4 a = zero4();
#pragma unroll
        for (int ks = 0; ks < 4; ++ks) { const bf16x8 cb = *(const LAS bf16x8*)(Cs + dir * (128 * 136) + (db * 16 + lr) * 136 + ks * 32 + lg * 8); a = MFMA16(cb, qa[ks], a); }
        a = a * wi;
#pragma unroll
        for (int ks = 0; ks < 2; ++ks) { const v2u a0 = *(const LAS v2u*)(Vt + (db * 16 + lr) * 72 + ks * 32 + lg * 4), a1 = *(const LAS v2u*)(Vt + (db * 16 + lr) * 72 + ks * 32 + 16 + lg * 4);
            a = MFMA16(__builtin_bit_cast(bf16x8, (v4u){a0.x, a0.y, a1.x, a1.y}), pfr[ks], a); }
        oacc[db] = a; }
    float qn = 0.f;
    { const LAS bf16* qr = Qs + t * 136 + lg * 32; const LAS float* nn = nin + dir * 128 + lg * 32;
#pragma unroll
      for (int k8 = 0; k8 < 4; ++k8) { float qf[8]; unpack8(*(const LAS v4u*)(qr + k8 * 8), qf);
#pragma unroll
          for (int i = 0; i < 8; ++i) qn += qf[i] * nn[k8 * 8 + i]; } }
    { const int ol = olane(); const float q1 = shi(qn, ol ^ 16), r1 = shi(rs, ol ^ 16); qn += q1; rs += r1; const float q2 = shi(qn, ol ^ 32), r2 = shi(rs, ol ^ 32); qn += q2; rs += r2; }
    const float inv = 1.0f / fmaxf(fabsf(wi * qn + rs), em);
    __syncthreads();
#pragma unroll
    for (int db = 0; db < 8; ++db) *(LAS f32x4*)(HB + dir * (64 * 132) + t * 132 + db * 16 + lg * 4) = oacc[db] * inv;
    __syncthreads();
    const float g0 = ((const float*)(const __attribute__((address_space(1))) float*)p.in[I_GMN])[l * 512 + h * 128 + 2 * lane], g1 = ((const float*)(const __attribute__((address_space(1))) float*)p.in[I_GMN])[l * 512 + h * 128 + 2 * lane + 1];
    float v0[8], v1[8], sm[8], sq[8];
#pragma unroll
    for (int tt = 0; tt < 8; ++tt) {
        const int t = 8 * w + tt;
        const unsigned ov = *(const unsigned*)(((bf16*)(c.ws + WS_P1)) + (size_t)(r0 + t) * LP + C_OM + h * 128 + 2 * lane);
        float a0 = HB[t * 132 + 2 * lane] + HB[64 * 132 + t * 132 + 2 * lane], a1 = HB[t * 132 + 2 * lane + 1] + HB[64 * 132 + t * 132 + 2 * lane + 1];
        a0 *= sigmoidf_(bf2f(ov & 0xffffu)); a1 *= sigmoidf_(bf2f(ov >> 16));
        v0[tt] = a0; v1[tt] = a1; sm[tt] = a0 + a1;
    }
    wave_sum8(sm);
#pragma unroll
    for (int tt = 0; tt < 8; ++tt) { const float mean = sm[tt] * (1.0f / 128.0f); v0[tt] -= mean; v1[tt] -= mean; sq[tt] = v0[tt] * v0[tt] + v1[tt] * v1[tt]; }
    wave_sum8(sq);
#pragma unroll
    for (int tt = 0; tt < 8; ++tt) { const float rstd = rsqrtf(sq[tt] * (1.0f / 128.0f) + EPS);
        *(unsigned*)(((bf16*)(c.ws + WS_BO)) + (size_t)(r0 + 8 * w + tt) * LBO + 1024 + h * 128 + 2 * lane) = pk2(v0[tt] * rstd * g0, v1[tt] * rstd * g1); }
    __syncthreads();
}


#ifdef DBGSCAN
__device__ __forceinline__ void scan16(Ctx& c, const bf16* p, size_t rows, int cols, int ld, int code) {
    TLW;
    const int c8 = cols / 8; const size_t n = rows * c8; bool bad = false;
    for (size_t i = (size_t)c.bid * 512 + tid_; i < n; i += (size_t)c.nblk * 512) { const size_t r = i / c8; const int cc = (int)(i % c8) * 8; const v4u v = *(const v4u*)(p + r * ld + cc);
        bad |= ((v.x & 0x7FFFu) > 0x4680u) | (((v.x >> 16) & 0x7FFFu) > 0x4680u) | ((v.y & 0x7FFFu) > 0x4680u) | (((v.y >> 16) & 0x7FFFu) > 0x4680u) | ((v.z & 0x7FFFu) > 0x4680u) | (((v.z >> 16) & 0x7FFFu) > 0x4680u) | ((v.w & 0x7FFFu) > 0x4680u) | (((v.w >> 16) & 0x7FFFu) > 0x4680u); }
    if (bad) atomicMin((int*)(c.ws + WS_DBG), code);
}
__device__ __forceinline__ void scan32(Ctx& c, const float* p, size_t n, int code) {
    TLW;
    bool bad = false;
    for (size_t i = (size_t)c.bid * 512 + tid_; i < n; i += (size_t)c.nblk * 512) { bad |= !(fabsf(p[i]) < 16384.0f); }
    if (bad) atomicMin((int*)(c.ws + WS_DBG), code);
}
__device__ __forceinline__ void dbg_scan(Ctx& c, int ph) {
    TLW;
    if (ph == 0) { if (c.bid == 0 && tid_ == 0) *(int*)(c.ws + WS_DBG) = 0x7fffffff; return; }
    if (ph >= NPHASE - 1) return;
    const int sp = (ph - 1) % 10, code = ph > 11 ? 56 + ph : 20 + ph * 4;
    if (sp == 0) { scan16(c, ((bf16*)(c.ws + WS_BO)), MT, 1024, 1024, code); scan16(c, ((bf16*)(c.ws + WS_WIN)), 7168, 1024, 1024, code + 1); scan16(c, ((bf16*)(c.ws + WS_WP)), 3072, 512, 512, code + 1);
        scan16(c, ((bf16*)(c.ws + WS_WO3)), 1024, 3072, 3072, code + 1); scan16(c, ((bf16*)(c.ws + WS_WGU)), 5632, 1024, 1024, code + 1); scan16(c, ((bf16*)(c.ws + WS_WD)), 1024, 2816, 2816, code + 1);
        scan32(c, (const float*)(c.ws + WS_MOD), 4 * 5 * 6144, code + 2); scan32(c, c.xl, (size_t)ML * DM, code + 3); scan32(c, (const float*)(c.ws + WS_XC), (size_t)MC * DM, code + 3); }
    else if (sp == 1) { scan16(c, ((bf16*)(c.ws + WS_P1)), MT, 4096, 4096, code); scan16(c, ((bf16*)(c.ws + WS_G)), MT, 3072, 3072, code + 1); }
    else if (sp == 2) { scan16(c, ((bf16*)(c.ws + WS_BO)), MT, 512, 1536, code); scan16(c, ((bf16*)(c.ws + WS_BO)) + 512, MT, 512, 1536, code + 1); scan16(c, ((bf16*)(c.ws + WS_ST)), 32 * 68 * 128, 128, 128, code + 2);
        scan32(c, (const float*)(c.ws + WS_NS), 32 * 68 * 128, code + 3); scan32(c, (const float*)(c.ws + WS_BEND), 32 * 68, code + 3); scan32(c, (const float*)(c.ws + WS_MU), 32 * 68, code + 3); }
    else if (sp == 3) { for (int ch = 0; ch < 32; ++ch) { scan16(c, ((bf16*)(c.ws + WS_ST)) + (size_t)ch * 68 * 16384, 67 * 128, 128, 128, code); scan32(c, (const float*)(c.ws + WS_NS) + ch * 68 * 128, 67 * 128, code + 1); scan32(c, (const float*)(c.ws + WS_MS) + ch * 68, 67, code + 2); } }
    else if (sp == 4) scan16(c, ((bf16*)(c.ws + WS_BO)) + 1024, MT, 512, 1536, code);
    else if (sp == 5) scan16(c, ((bf16*)(c.ws + WS_G)), MT, 3072, 3072, code);
    else if (sp == 6 || sp == 9) { scan32(c, c.xl, (size_t)ML * DM, code); scan32(c, (const float*)(c.ws + WS_XC), (size_t)MC * DM, code + 1); }
    else if (sp == 7) scan16(c, ((bf16*)(c.ws + WS_BO)), MT, 1024, 1024, code);
    else if (sp == 8) scan16(c, ((bf16*)(c.ws + WS_P1)), MT, 2816, 2816, code);
}
#endif
template <class Epi, class Sched = pg8::StaticOrder>
__device__ __forceinline__ void run_gemm(Ctx& c, const bf16* A, int lda, int mode, const bf16* Bt, int ldb, int M, int N, int K, const Epi& E) {
    pg8::Gemm g{A, Bt, M, N, K, lda, ldb, mode}; Sched S; S.init(M, N, c.nblk, c.bid);
    pg8::gemm_phase<Epi, Sched, true, true>(c.lds, g, S, E);
}

__global__ void __launch_bounds__(512, 2) mk_fwd(Params prm) {
    extern __shared__ __attribute__((aligned(16))) uchar lds_raw[];
    cg::grid_group grid = cg::this_grid();
    Ctx c; c.p = (const __attribute__((address_space(4))) Params*)__builtin_amdgcn_kernarg_segment_ptr(); c.lds = (LAS uchar*)lds_raw; c.bid = blockIdx.x; c.nblk = gridDim.x;
    { LAS unsigned* misc = (LAS unsigned*)(c.lds + MISC_OFF); if (threadIdx.x < 4) misc[threadIdx.x] = 0u; }
    __syncthreads();
    const XcdBarrier xbar = xcd_barrier_post((unsigned*)(prm.ws + WS_BAR), (volatile LAS unsigned*)(c.lds + MISC_OFF));
    for (int ph = prm.ph_lo; ph < prm.ph_hi; ++ph) {
        { const __attribute__((address_space(4))) Params* pp_ = (const __attribute__((address_space(4))) Params*)__builtin_amdgcn_kernarg_segment_ptr(); asm volatile("" : "+s"(pp_)); c.p = pp_; }
        { __attribute__((address_space(1))) uchar* w_ = (__attribute__((address_space(1))) uchar*)prm.ws; asm volatile("" : "+s"(w_)); c.ws = (uchar*)w_;
          __attribute__((address_space(1))) float* x_ = (__attribute__((address_space(1))) float*)prm.out; asm volatile("" : "+s"(x_)); c.xl = (float*)x_; }
        if (ph == 0) {
#ifndef NO_INIT
 phase_init(c);
#endif
 }
        else if (ph == NPHASE - 1) phase_final(c);
        else {
            const int l = (ph - 1) / 10, sp = (ph - 1) % 10; const bool wctx = l < DEPTH - 1; const int Mx = wctx ? MT : ML;
            if (sp == 0) {
#ifndef NO_CONV
 convert_weights(c, l);
#endif
 phase_norm(c, l, 0, MT, l > 0 ? (const float*)(c.ws + WS_G) : nullptr, 11, ((float*)(c.ws + WS_MOD)) + (size_t)(l > 0 ? l - 1 : 0) * 5 * 6144 + 4 * 6144 + 5120, l == 0 ? ((const float*)(const __attribute__((address_space(1))) float*)c.p->in[I_X]) : nullptr); }
            else if (sp == 1) { EpiP1G E{((bf16*)(c.ws + WS_P1)), ((bf16*)(c.ws + WS_G))}; run_gemm(c, ((bf16*)(c.ws + WS_BO)), DM, 0, ((bf16*)(c.ws + WS_WIN)), DM, MT, NINP, DM, E); }
            else if (sp == 2) {
                const int n_att = 256 + (wctx ? 16 : 0), n_m1 = 16 * NCHUNK, n_conv = Mx / 64;
                if (c.nblk == 256 && wctx) {
                    const int w_ = c.bid;
                    attn_unit4(c, l, w_ >> 6, (w_ >> 5) & 1, w_ & 31, false);
                    if (w_ < 16) attn_unit4(c, l, w_ >> 2, (w_ >> 1) & 1, w_ & 1, true);
                    conv_unit(c, l, w_);
                    if (w_ >= 16 && w_ < 32) conv_unit(c, l, 256 + (w_ - 16));
                    if (w_ < 32) { for (int m = w_; m < 64; m += 32) m1_unit(c, l, m / (4 * NCHUNK), (m / NCHUNK) & 3, m % NCHUNK); }
                    else { for (int m = 64 + (w_ - 32); m < n_m1; m += 224) m1_unit(c, l, m / (4 * NCHUNK), (m / NCHUNK) & 3, m % NCHUNK); }
                } else
                for (int u = c.bid; u < n_att + n_m1 + n_conv; u += c.nblk) {
                    if (u < n_att) { if (u < 256) attn_unit4(c, l, u >> 6, (u >> 5) & 1, u & 31, false); else { const int q = u - 256; attn_unit4(c, l, q >> 2, (q >> 1) & 1, q & 1, true); } }
                    else if (u < n_att + n_m1) { const int m = u - n_att; m1_unit(c, l, m / (4 * NCHUNK), (m / NCHUNK) & 3, m % NCHUNK); }
                    else conv_unit(c, l, u - n_att - n_m1);
                }
            }
            else if (sp == 3) {
#ifndef NO_M2
 phase_m2(c);
#endif
 }
            else if (sp == 4) {
                const int jlo = wctx ? 0 : 4, per = NCHUNK - jlo;
                #ifndef NO_M3
 for (int u = c.bid; u < 16 * per; u += c.nblk) m3_unit(c, l, u / (4 * per), (u / per) & 3, jlo + u % per);
#endif

            }
            else if (sp == 5) {
                { EpiMerge E{((const bf16*)(c.ws + WS_G)), ((bf16*)(c.ws + WS_P1))}; run_gemm<EpiMerge, pg8::Merge3Order>(c, ((bf16*)(c.ws + WS_BO)), LBO, 2, ((bf16*)(c.ws + WS_WP)), 512, ML, DM, 512, E); }
                if (wctx) { EpiGateMul E{((bf16*)(c.ws + WS_G)) + (size_t)ML * NG}; run_gemm(c, ((bf16*)(c.ws + WS_BO)) + (size_t)ML * LBO, LBO, 1, ((bf16*)(c.ws + WS_WP)), 512, MC, NG, 512, E); }
            }
            else if (sp == 6) {
                { EpiResid E{c.xl, ((float*)(c.ws + WS_XC)), ((float*)(c.ws + WS_MOD)) + (size_t)l * 5 * 6144 + 2048, l == 0 ? ((const float*)(const __attribute__((address_space(1))) float*)c.p->in[I_X]) : (const float*)c.xl}; run_gemm(c, ((bf16*)(c.ws + WS_P1)), DM, 0, ((bf16*)(c.ws + WS_WO3)), NG, ML, DM, DM, E); }
                if (wctx) { EpiPartial E{(float*)(c.ws + WS_P1 + 40 * MiB)}; run_gemm(c, ((bf16*)(c.ws + WS_G)) + (size_t)ML * NG, NG, 3, ((bf16*)(c.ws + WS_WO3)), NG, MC, DM * 12, 256, E); }
            }
            else if (sp == 7) phase_norm(c, l, 1, Mx, wctx ? (const float*)(c.ws + WS_P1 + 40 * MiB) : nullptr, 12, ((float*)(c.ws + WS_MOD)) + (size_t)l * 5 * 6144 + 4 * 6144 + 2048, nullptr);
            else if (sp == 8) { EpiSwiGLU E{((bf16*)(c.ws + WS_P1))}; run_gemm(c, ((bf16*)(c.ws + WS_BO)), DM, 0, ((bf16*)(c.ws + WS_WGU)), DM, Mx, 2 * DFF, DM, E); }
            else {
                { EpiResid E{c.xl, ((float*)(c.ws + WS_XC)), ((float*)(c.ws + WS_MOD)) + (size_t)l * 5 * 6144 + 5120, (const float*)c.xl}; run_gemm(c, ((bf16*)(c.ws + WS_P1)), DFF, 0, ((bf16*)(c.ws + WS_WD)), DFF, ML, DM, DFF, E); }
                if (wctx) { EpiPartial E{(float*)(c.ws + WS_G)}; run_gemm(c, ((bf16*)(c.ws + WS_P1)) + (size_t)ML * DFF, DFF, 3, ((bf16*)(c.ws + WS_WD)), DFF, MC, DM * 11, 256, E); }
            }
        }
        if (ph + 1 < prm.ph_hi) { asm volatile("s_waitcnt vmcnt(0) lgkmcnt(0)" ::: "memory"); __syncthreads(); if (ph == prm.ph_lo) grid.sync(); else { __attribute__((address_space(1))) unsigned* bp_ = (__attribute__((address_space(1))) unsigned*)(prm.ws + WS_BAR); asm volatile("" : "+s"(bp_)); XcdBarrier xb2; xb2.bar = (unsigned*)bp_; xb2.x = xbar.x; xb2.st = (volatile LAS unsigned*)(c.lds + MISC_OFF); xcd_barrier(xb2); }
#ifdef PROBE_SYNC2
            grid.sync();
#endif
#ifdef DBGSCAN
            dbg_scan(c, ph); asm volatile("s_waitcnt vmcnt(0) lgkmcnt(0)" ::: "memory"); __syncthreads(); grid.sync();
#endif
        }
    }
}

extern "C" void kernel_launch(void* const* d_in, const int* in_sizes, int n_in, void* d_out, int out_size, void* d_ws, size_t ws_size, hipStream_t stream) {
    static int grid = 0;
    if (grid == 0) {
        if (n_in != 25 || ws_size < WS_END) { fprintf(stderr, "kernel_launch: unexpected n_in %d / ws_size %zu (need %zu)\n", n_in, ws_size, (size_t)WS_END); grid = -1; return; }
        int dev = 0, cus = 0, per_cu = 0;
        hipGetDevice(&dev); hipDeviceGetAttribute(&cus, hipDeviceAttributeMultiprocessorCount, dev);
        if (hipFuncSetAttribute((const void*)mk_fwd, hipFuncAttributeMaxDynamicSharedMemorySize, LDS_BYTES) != hipSuccess) { fprintf(stderr, "kernel_launch: hipFuncSetAttribute failed\n"); }
        if (hipOccupancyMaxActiveBlocksPerMultiprocessor(&per_cu, (const void*)mk_fwd, 512, LDS_BYTES) != hipSuccess || per_cu < 1) { fprintf(stderr, "kernel_launch: occupancy query says %d\n", per_cu); per_cu = 1; }
        (void)hipGetLastError();
        grid = cus * 1;
        fprintf(stderr, "kernel_launch: grid %d (cus %d, per_cu %d)\n", grid, cus, per_cu);
    }
    if (grid < 0) return;
    if (hipMemsetAsync((char*)d_ws + WS_BAR, 0, BAR_BYTES, stream) != hipSuccess) fprintf(stderr, "kernel_launch: memset failed\n");
    Params prm{};
    for (int i = 0; i < 25; ++i) prm.in[i] = (const float*)d_in[i];
    prm.out = (float*)d_out; prm.ws = (uchar*)d_ws;
#if defined(MK_MULTI)
    for (int ph = 0; ph < NPHASE; ++ph) { prm.ph_lo = ph; prm.ph_hi = ph + 1; hipLaunchKernelGGL(mk_fwd, dim3(grid), dim3(512), LDS_BYTES, stream, prm); }
#else
    prm.ph_lo = 0; prm.ph_hi = NPHASE;
    void* args[] = {&prm};
    hipError_t e = hipLaunchCooperativeKernel((const void*)mk_fwd, dim3(grid), dim3(512), args, LDS_BYTES, stream);
    if (e != hipSuccess) fprintf(stderr, "kernel_launch: cooperative launch failed: %s (grid %d)\n", hipGetErrorString(e), grid);
#endif
}
```

```cpp
#include <hip/hip_runtime.h>
#include <hip/hip_cooperative_groups.h>
#include <cstdio>
#include <cstdint>
namespace cg = cooperative_groups;
namespace pg8 {
#define PG8_LAS __attribute__((address_space(3)))
typedef unsigned short bf16_t;
typedef short bf16x8 __attribute__((ext_vector_type(8)));
typedef float f32x4 __attribute__((ext_vector_type(4)));
typedef unsigned u32x4 __attribute__((ext_vector_type(4)));
constexpr int BM = 256, BK = 64, HALF = 128, HTB = HALF * BK * 2  , STAGE_BYTES = 8 * HTB, NXCD = 8, WGM = 8;

__host__ __device__ __forceinline__ int lds_byte(int r, int c) { const int st = (r >> 4) * 2 + (c >> 5), rr = r & 15, cc = c & 31, ob = rr * 64 + cc * 2; return st * 1024 + (ob ^ (((ob >> 9) & 1) << 5)); }
__host__ __device__ __forceinline__ void stage_rc(int b, int& R, int& C) { const int st = b / 1024, sb = b % 1024, swz = sb ^ (((sb >> 9) & 1) << 5); R = (st >> 1) * 16 + swz / 64; C = (st & 1) * 32 + (swz % 64) / 2; }
__host__ __device__ __forceinline__ int perm32(int rho) { const int n = rho >> 4, i = rho & 15; return 8 * (i >> 2) + 4 * n + (i & 3); }

struct Unit { int pm, pn, z; };
struct Gemm { const bf16_t* A; const bf16_t* Bt; int M, N, K, lda, ldb, mode; };
__device__ __forceinline__ size_t op_aoff(const Gemm& g, const Unit& u, size_t tstepA) { size_t o = (size_t)u.pm * tstepA; if (g.mode == 1) o += (size_t)(u.pn >> 2) * 1024; else if (g.mode == 2) o += (size_t)u.z * 1024; else if (g.mode == 3) o += (size_t)(u.pn >> 2) * 512; return o; }
__device__ __forceinline__ size_t op_boff(const Gemm& g, const Unit& u, size_t tstepB) { if (g.mode == 2) return (size_t)(u.z * 4 + u.pn) * tstepB; if (g.mode == 3) return (size_t)(u.pn & 3) * tstepB + (size_t)(u.pn >> 2) * 512; return (size_t)u.pn * tstepB; }

struct StaticOrder {
    int nM, nN, nwg, G, c;
    __host__ __device__ void init(int M, int N, int G_, int c_) { nM = M / BM; nN = N / BM; nwg = nM * nN; G = G_; c = c_; }
    __host__ __device__ bool next(int i, Unit& u) const {
        const long L = (long)i * G + c; if (L >= nwg) return false;
        int wgid = (int)L; { const int q = nwg / NXCD, r = nwg % NXCD, xcd = wgid % NXCD, off = wgid / NXCD; wgid = (xcd < r ? xcd * (q + 1) : r * (q + 1) + (xcd - r) * q) + off; }
        const int nig = WGM * nN, gid = wgid / nig, fm = gid * WGM, gsz = (nM - fm) < WGM ? (nM - fm) : WGM;
        u.pm = fm + ((wgid % nig) % gsz); u.pn = (wgid % nig) / gsz; u.z = 0; return true;
    }
    __device__ __forceinline__ void a_ready(const Unit&) const {}
    __device__ __forceinline__ void done(const Unit&) const {}
};

struct Merge3Order { StaticOrder base;
    __device__ void init(int M, int N, int G_, int c_) { base.init(M, N, G_, c_); }
    __device__ bool next(int i, Unit& u) const { const int r = i / 3; if (!base.next(r, u)) return false; u.z = i - 3 * r; return true; }
    __device__ __forceinline__ void a_ready(const Unit&) const {}
    __device__ __forceinline__ void done(const Unit&) const {}
};
__device__ __forceinline__ unsigned cvt_pk_bf16(float lo, float hi) { unsigned r; asm volatile("v_cvt_pk_bf16_f32 %0, %1, %2" : "=v"(r) : "v"(lo), "v"(hi)); return r; }
typedef float f32x2 __attribute__((ext_vector_type(2)));
template <class Epi, class Sched, bool ALIGN_EPI = false, bool SP2 = false>
__device__ __forceinline__ void gemm_phase(PG8_LAS unsigned char* lds, const Gemm g, const Sched& S, const Epi& E) {
    int tid = threadIdx.x; asm volatile("" : "+v"(tid));
    const int wid = __builtin_amdgcn_readfirstlane(tid >> 6), lane = tid & 63, wr = wid >> 2, wc = wid & 3, fr = lane & 15, fq = lane >> 4;
    const int K = g.K, nt = K / BK;
    unsigned voffA[2], voffB[2];
#pragma unroll
    for (int i = 0; i < 2; ++i) { int R, C; stage_rc(tid * 16 + i * 8192, R, C); const int Rb = Epi::PERM ? ((R & ~31) + perm32(R & 31)) : R;
        voffA[i] = (unsigned)(R * g.lda + C) * 2u; voffB[i] = (unsigned)(Rb * g.ldb + C) * 2u; }
    const size_t kstep = (size_t)(BK * 2);
    const size_t hstepA = (size_t)HALF * g.lda * 2, hstepB = (size_t)HALF * g.ldb * 2;
    const size_t tstepA = 2 * hstepA, tstepB = 2 * hstepB;
    const unsigned ldsw = (unsigned)wid * 1024u;
    const int aoff = lds_byte(wr * 64 + fr, fq * 8), boff = lds_byte(wc * 32 + fr, fq * 8);
#define PG8_SA(b, h) (((b) * 2 + (h)) * HTB)
#define PG8_SB(b, h) ((4 + (b) * 2 + (h)) * HTB)
#define PG8_STAGE(bufoff, gbase, voff) do { _Pragma("unroll") for (int _i = 0; _i < 2; ++_i) \
        __builtin_amdgcn_global_load_lds((const unsigned*)((const char*)(gbase) + (voff)[_i]), (PG8_LAS unsigned*)(lds + (bufoff) + ldsw + _i * 8192), 16, 0, 0); } while (0)
#define PG8_LDA(dst, b, h) do { _Pragma("unroll") for (int m = 0; m < 4; ++m) _Pragma("unroll") for (int k = 0; k < 2; ++k) dst[m][k] = *(const PG8_LAS bf16x8*)(lds + PG8_SA(b, h) + aoff + m * 2048 + k * 1024); } while (0)
#define PG8_LDB(dst, b, h) do { _Pragma("unroll") for (int n = 0; n < 2; ++n) _Pragma("unroll") for (int k = 0; k < 2; ++k) dst[n][k] = *(const PG8_LAS bf16x8*)(lds + PG8_SB(b, h) + boff + n * 2048 + k * 1024); } while (0)
#define PG8_MMA(ai, bj, At, Bt) do { __builtin_amdgcn_s_setprio(1); _Pragma("unroll") for (int m = 0; m < 4; ++m) _Pragma("unroll") for (int n = 0; n < 2; ++n) _Pragma("unroll") for (int k = 0; k < 2; ++k) \
        acc[ai][bj][m][n] = __builtin_amdgcn_mfma_f32_16x16x32_bf16(Bt[n][k], At[m][k], acc[ai][bj][m][n], 0, 0, 0); __builtin_amdgcn_s_setprio(0); } while (0)
#define PG8_WAIT_V(n) asm volatile("s_waitcnt vmcnt(" #n ")" ::: "memory")
#define PG8_WAIT_L(n) asm volatile("s_waitcnt lgkmcnt(" #n ")" ::: "memory")
#define PG8_BAR __builtin_amdgcn_s_barrier()
#define PG8_SCHED __builtin_amdgcn_sched_barrier(0)
    Unit cur, nxt; int ui = 0;
    if (!S.next(0, cur)) return;
    f32x4 acc[2][2][4][2];
#pragma unroll
    for (int a = 0; a < 2; ++a)
#pragma unroll
        for (int b = 0; b < 2; ++b)
#pragma unroll
            for (int m = 0; m < 4; ++m)
#pragma unroll
                for (int n = 0; n < 2; ++n) { float z0, z1, z2, z3; asm volatile("v_mov_b32 %0, 0\n\tv_mov_b32 %1, 0\n\tv_mov_b32 %2, 0\n\tv_mov_b32 %3, 0" : "=v"(z0), "=v"(z1), "=v"(z2), "=v"(z3)); acc[a][b][m][n] = (f32x4){z0, z1, z2, z3}; }
    bf16x8 At[4][2], B0[2][2], B1[2][2];
    const char* cA = (const char*)g.A + op_aoff(g, cur, tstepA); const char* cB = (const char*)g.Bt + op_boff(g, cur, tstepB);
    S.a_ready(cur);
    if constexpr (SP2) {
        PG8_STAGE(PG8_SB(0, 0), cB, voffB); PG8_STAGE(PG8_SB(0, 1), cB + hstepB, voffB); PG8_STAGE(PG8_SA(0, 0), cA, voffA); PG8_STAGE(PG8_SA(0, 1), cA + hstepA, voffA);
        if (wr == 1) PG8_BAR;
        PG8_WAIT_V(2); PG8_BAR;
        PG8_STAGE(PG8_SB(1, 0), cB + kstep, voffB); PG8_STAGE(PG8_SA(1, 0), cA + kstep, voffA); PG8_STAGE(PG8_SB(1, 1), cB + hstepB + kstep, voffB);
        PG8_WAIT_V(6); PG8_BAR;
    } else {
        PG8_STAGE(PG8_SB(0, 0), cB, voffB); PG8_STAGE(PG8_SA(0, 0), cA, voffA); PG8_STAGE(PG8_SB(0, 1), cB + hstepB, voffB); PG8_STAGE(PG8_SA(0, 1), cA + hstepA, voffA);
        if (wr == 1) PG8_BAR;
        PG8_WAIT_V(4); PG8_BAR;
        PG8_STAGE(PG8_SB(1, 0), cB + kstep, voffB); PG8_STAGE(PG8_SA(1, 0), cA + kstep, voffA); PG8_STAGE(PG8_SB(1, 1), cB + hstepB + kstep, voffB);
        PG8_WAIT_V(6); PG8_BAR;
    }
    for (;;) {
        const bool has_next = S.next(ui + 1, nxt);
        const char* nA = has_next ? (const char*)g.A + op_aoff(g, nxt, tstepA) : cA; const char* nB = has_next ? (const char*)g.Bt + op_boff(g, nxt, tstepB) : cB;
        for (int t = 0; t < nt; t += 2) {
            const bool last = (t == nt - 2);
            const char* a1 = cA + (size_t)(t + 1) * kstep;
            const char* a2 = last ? nA : cA + (size_t)(t + 2) * kstep; const char* b2 = last ? nB : cB + (size_t)(t + 2) * kstep;
            const char* a3 = a2 + kstep; const char* b3 = b2 + kstep;
            if (last && has_next) S.a_ready(nxt);
            if constexpr (SP2) {
            PG8_LDB(B0, 0, 0); PG8_LDB(B1, 0, 1); PG8_SCHED; PG8_LDA(At, 0, 0); PG8_STAGE(PG8_SA(1, 1), a1 + hstepA, voffA);
            PG8_WAIT_V(8); PG8_WAIT_L(0); PG8_BAR; PG8_MMA(0, 0, At, B0); PG8_MMA(0, 1, At, B1); PG8_BAR; PG8_SCHED;
            PG8_LDA(At, 0, 1); PG8_STAGE(PG8_SB(0, 0), b2, voffB); PG8_STAGE(PG8_SB(0, 1), b2 + hstepB, voffB); PG8_STAGE(PG8_SA(0, 0), a2, voffA);
            PG8_WAIT_V(8); PG8_WAIT_L(0); PG8_BAR; PG8_MMA(1, 0, At, B0); PG8_MMA(1, 1, At, B1); PG8_BAR; PG8_SCHED;
            PG8_LDB(B0, 1, 0); PG8_LDB(B1, 1, 1); PG8_SCHED; PG8_LDA(At, 1, 0); PG8_STAGE(PG8_SA(0, 1), a2 + hstepA, voffA);
            PG8_WAIT_V(8); PG8_WAIT_L(0); PG8_BAR; PG8_MMA(0, 0, At, B0); PG8_MMA(0, 1, At, B1); PG8_BAR; PG8_SCHED;
            PG8_LDA(At, 1, 1); PG8_STAGE(PG8_SB(1, 0), b3, voffB); PG8_STAGE(PG8_SB(1, 1), b3 + hstepB, voffB); PG8_STAGE(PG8_SA(1, 0), a3, voffA);
            PG8_WAIT_V(8); PG8_WAIT_L(0); PG8_BAR; PG8_MMA(1, 0, At, B0); PG8_MMA(1, 1, At, B1); PG8_BAR; PG8_SCHED;
            } else {
            PG8_LDB(B0, 0, 0); PG8_SCHED; PG8_LDA(At, 0, 0); PG8_STAGE(PG8_SA(1, 1), a1 + hstepA, voffA);
            PG8_WAIT_L(8); PG8_BAR; PG8_WAIT_L(0); PG8_MMA(0, 0, At, B0); PG8_BAR; PG8_SCHED;
            PG8_LDB(B1, 0, 1); PG8_STAGE(PG8_SB(0, 0), b2, voffB);
            PG8_BAR; PG8_WAIT_L(0); PG8_MMA(0, 1, At, B1); PG8_BAR;
            PG8_LDA(At, 0, 1); PG8_STAGE(PG8_SA(0, 0), a2, voffA);
            PG8_BAR; PG8_WAIT_L(0); PG8_MMA(1, 0, At, B0); PG8_BAR; PG8_SCHED;
            PG8_STAGE(PG8_SB(0, 1), b2 + hstepB, voffB);
            PG8_WAIT_V(6); PG8_BAR; PG8_MMA(1, 1, At, B1); PG8_BAR;
            PG8_LDB(B0, 1, 0); PG8_SCHED; PG8_LDA(At, 1, 0); PG8_STAGE(PG8_SA(0, 1), a2 + hstepA, voffA);
            PG8_WAIT_L(8); PG8_BAR; PG8_WAIT_L(0); PG8_MMA(0, 0, At, B0); PG8_BAR; PG8_SCHED;
            PG8_LDB(B1, 1, 1); PG8_STAGE(PG8_SB(1, 0), b3, voffB);
            PG8_BAR; PG8_WAIT_L(0); PG8_MMA(0, 1, At, B1); PG8_BAR;
            PG8_LDA(At, 1, 1); PG8_STAGE(PG8_SA(1, 0), a3, voffA);
            PG8_BAR; PG8_WAIT_L(0); PG8_MMA(1, 0, At, B0); PG8_BAR; PG8_SCHED;
            PG8_STAGE(PG8_SB(1, 1), b3 + hstepB, voffB);
            PG8_WAIT_V(6); PG8_BAR; PG8_MMA(1, 1, At, B1); PG8_BAR;
            }
        }
        if constexpr (ALIGN_EPI) { if (wr == 0) PG8_BAR; }
        if constexpr (!Epi::AFTER_DRAIN) { E(acc, cur, wr, wc, fr, fq); S.done(cur); }
        if (!has_next) break;
#pragma unroll
        for (int a = 0; a < 2; ++a)
#pragma unroll
        for (int b = 0; b < 2; ++b)
#pragma unroll
            for (int m = 0; m < 4; ++m)
#pragma unroll
                for (int n = 0; n < 2; ++n) { float z0, z1, z2, z3; asm volatile("v_mov_b32 %0, 0\n\tv_mov_b32 %1, 0\n\tv_mov_b32 %2, 0\n\tv_mov_b32 %3, 0" : "=v"(z0), "=v"(z1), "=v"(z2), "=v"(z3)); acc[a][b][m][n] = (f32x4){z0, z1, z2, z3}; }
        cur = nxt; cA = nA; cB = nB; ++ui;
        if constexpr (ALIGN_EPI) { if (wr == 1) PG8_BAR; }
    }
    PG8_WAIT_V(0);
    if constexpr (!ALIGN_EPI) { if (wr == 0) PG8_BAR; }
    PG8_BAR;
    if constexpr (Epi::AFTER_DRAIN) { E.fused(acc, cur, wr, wc, fr, fq, lds, wid, lane); S.done(cur); }
#undef PG8_SA
#undef PG8_SB
#undef PG8_STAGE
#undef PG8_LDA
#undef PG8_LDB
#undef PG8_MMA
#undef PG8_WAIT_V
#undef PG8_WAIT_L
#undef PG8_BAR
#undef PG8_SCHED
}
}

#define LAS __attribute__((address_space(3)))
typedef unsigned short bf16;
typedef unsigned char uchar;
typedef short bf16x8 __attribute__((ext_vector_type(8)));
typedef float f32x4 __attribute__((ext_vector_type(4)));
typedef unsigned v4u __attribute__((ext_vector_type(4)));
typedef unsigned v2u __attribute__((ext_vector_type(2)));

constexpr int DM = 1024, NBATCH = 4, SEQ = 4096, DEPTH = 4, CTXL = 256;
constexpr int ML = NBATCH * SEQ, MC = NBATCH * CTXL, MT = ML + MC;
constexpr int LP = 4096, NG = 3072, DFF = 2816, NIN = 6928, NINP = 7168, LBO = 1536;
constexpr int C_Q = 0, C_K = 512, C_V = 640, C_GLU = 768, C_QKM = 1792, C_VM = 2816, C_OM = 3328, C_GM = 3840;
constexpr int NCHUNK = 68;
constexpr float EPS = 1e-6f;
constexpr size_t MiB = 1u << 20;
constexpr size_t WS_MOD = 0, WS_ROPE = 512 * 1024, WS_BEND = 1 * MiB, WS_MU = WS_BEND + 16384, WS_MS = WS_MU + 16384, WS_NS = 2 * MiB;
constexpr size_t WS_XC = 4 * MiB, WS_WIN = 8 * MiB, WS_WP = 22 * MiB, WS_WO3 = 25 * MiB, WS_WGU = 31 * MiB, WS_WD = 42 * MiB;
constexpr size_t WS_BO = 48 * MiB, WS_P1 = 99 * MiB, WS_G = 235 * MiB, WS_ST = 337 * MiB, WS_END = 405 * MiB;
constexpr size_t WS_DBG = 768 * 1024, WS_BAR = 3 * MiB + 512 * 1024, BAR_BYTES = 16384;
constexpr int MISC_OFF = 155136;
constexpr int LDS_BYTES = 155648;
constexpr int NPHASE = 2 + 10 * DEPTH;

struct Params { const float* in[25]; float* out; uchar* ws; int ph_lo, ph_hi; };
enum { I_X = 0, I_C, I_CTX, I_CCTX, I_WADA, I_BADA, I_GMIX, I_GFFN, I_WIN, I_BMG, I_SINK, I_WATT, I_WDW, I_BDW, I_GCLN, I_BCLN, I_WPW, I_WMCONV, I_GMN, I_WMOUT, I_WOUT, I_WFG, I_WFU, I_WFD, I_GFIN };

__device__ __forceinline__ float bf2f(unsigned h) { return __uint_as_float(h << 16); }
typedef __bf16 bf16x2_t __attribute__((ext_vector_type(2)));
typedef float f32x2_t __attribute__((ext_vector_type(2)));
__device__ __forceinline__ unsigned pk2(float lo, float hi) { f32x2_t v = {lo, hi}; bf16x2_t b = __builtin_convertvector(v, bf16x2_t); return __builtin_bit_cast(unsigned, b); }
__device__ __forceinline__ float sigmoidf_(float x) { return __builtin_amdgcn_rcpf(1.0f + __expf(-x)); }
__device__ __forceinline__ float siluf_(float x) { return x * __builtin_amdgcn_rcpf(1.0f + __expf(-x)); }
__device__ __forceinline__ float logsigf_(float x) { return fminf(x, 0.f) - __logf(1.0f + __expf(-fabsf(x))); }
__device__ __forceinline__ int olane() { int l = __builtin_amdgcn_mbcnt_hi(-1, __builtin_amdgcn_mbcnt_lo(-1, 0)); asm volatile("" : "+v"(l)); return l; }
__device__ __forceinline__ float shi(float v, int src) { return __builtin_bit_cast(float, __builtin_amdgcn_ds_bpermute(src << 2, __builtin_bit_cast(int, v))); }
__device__ __forceinline__ float shx(float v, int o) { return shi(v, olane() ^ o); }
__device__ __forceinline__ float wave_sum(float v) {
    const int l = olane();
#pragma unroll
    for (int o = 1; o < 64; o <<= 1) v += shi(v, l ^ o);
    return v;
}
#define DPPF(v, ctrl) __builtin_bit_cast(float, __builtin_amdgcn_update_dpp(0, __builtin_bit_cast(int, (v)), (ctrl), 0xf, 0xf, false))
__device__ __forceinline__ void wave_sum8(float (&v)[8]) {
#pragma unroll
    for (int t = 0; t < 8; ++t) { v[t] += DPPF(v[t], 0x128); v[t] += DPPF(v[t], 0x124); v[t] += DPPF(v[t], 0x122); v[t] += DPPF(v[t], 0x121); }
    const int l = olane();
#pragma unroll
    for (int t = 0; t < 8; ++t) v[t] += shi(v[t], l ^ 16);
#pragma unroll
    for (int t = 0; t < 8; ++t) v[t] += shi(v[t], l ^ 32);
}
__device__ __forceinline__ float wave_max(float v) {
    const int l = olane();
#pragma unroll
    for (int o = 1; o < 64; o <<= 1) v = fmaxf(v, shi(v, l ^ o));
    return v;
}
__device__ __forceinline__ float scan_add(float v, int lane) {
#pragma unroll
    for (int o = 1; o < 64; o <<= 1) { const float t = shi(v, lane >= o ? lane - o : lane); if (lane >= o) v += t; }
    return v;
}
__device__ __forceinline__ float scan_max(float v, int lane) {
#pragma unroll
    for (int o = 1; o < 64; o <<= 1) { const float t = shi(v, lane >= o ? lane - o : lane); if (lane >= o) v = fmaxf(v, t); }
    return v;
}
__device__ __forceinline__ void unpack8(v4u w, float (&f)[8]) {
    f[0] = bf2f(w.x & 0xffffu); f[1] = bf2f(w.x >> 16); f[2] = bf2f(w.y & 0xffffu); f[3] = bf2f(w.y >> 16);
    f[4] = bf2f(w.z & 0xffffu); f[5] = bf2f(w.z >> 16); f[6] = bf2f(w.w & 0xffffu); f[7] = bf2f(w.w >> 16);
}
__device__ __forceinline__ v4u pack8(const float (&f)[8]) { v4u w; w.x = pk2(f[0], f[1]); w.y = pk2(f[2], f[3]); w.z = pk2(f[4], f[5]); w.w = pk2(f[6], f[7]); return w; }
#define LDS_FENCE() asm volatile("s_waitcnt lgkmcnt(0)" ::: "memory")
#define MFMA16(a, b, c) __builtin_amdgcn_mfma_f32_16x16x32_bf16((a), (b), (c), 0, 0, 0)
#define DBGF(cond, code) do { if (cond) atomicMin((int*)(c.ws + WS_DBG), (code)); } while (0)

__device__ __forceinline__ int otid() { int t = threadIdx.x; asm volatile("" : "+v"(t)); return t; }
#define TLW const int tid_ = otid(), lane_ = tid_ & 63, wave_ = __builtin_amdgcn_readfirstlane(tid_ >> 6); (void)lane_; (void)wave_
__device__ __forceinline__ f32x4 zero4() { float z0, z1, z2, z3; asm volatile("v_mov_b32 %0, 0\n\tv_mov_b32 %1, 0\n\tv_mov_b32 %2, 0\n\tv_mov_b32 %3, 0" : "=v"(z0), "=v"(z1), "=v"(z2), "=v"(z3)); return (f32x4){z0, z1, z2, z3}; }
__device__ __forceinline__ v4u zero4u() { unsigned z0, z1, z2, z3; asm volatile("v_mov_b32 %0, 0\n\tv_mov_b32 %1, 0\n\tv_mov_b32 %2, 0\n\tv_mov_b32 %3, 0" : "=v"(z0), "=v"(z1), "=v"(z2), "=v"(z3)); return (v4u){z0, z1, z2, z3}; }
struct Ctx {
    const __attribute__((address_space(4))) Params* p; LAS uchar* lds; int bid, nblk;
    uchar* ws; float* xl;
};

#define XB_TMO      128
#define XB_XCNT(j)  (256  + 64 * (j))
#define XB_XSUB(j)  (1280 + 64 * (j))
#define XB_XGEN(j)  (2304 + 64 * (j))
#define XB_TOP      3328
#define XB_TOPGEN   3392
#define XCD_BAR_WORDS 3456
#define XB_SPIN_CAP (1u << 18)

__device__ __forceinline__ unsigned xb_ld(unsigned* p)              { return __hip_atomic_load(p, __ATOMIC_RELAXED, __HIP_MEMORY_SCOPE_AGENT); }
__device__ __forceinline__ unsigned xb_add(unsigned* p, unsigned v) { return __hip_atomic_fetch_add(p, v, __ATOMIC_RELAXED, __HIP_MEMORY_SCOPE_AGENT); }
__device__ __forceinline__ unsigned xb_xcc_id() { return (unsigned)__builtin_amdgcn_s_getreg((3 << 11) | 20) & 0xFu; }
#define XB_SPIN(cond, bar) do { unsigned _sp = 0; while (cond) { __builtin_amdgcn_s_sleep(1); \
    if ((++_sp & 255u) == 0u) { if (xb_ld(&(bar)[XB_TMO])) break; if (_sp > XB_SPIN_CAP) { atomicAdd(&(bar)[XB_TMO], 1u); break; } } } } while (0)

struct XcdBarrier {
    unsigned* bar; unsigned x;
    volatile LAS unsigned* st;
};

__device__ __forceinline__ XcdBarrier xcd_barrier_post(unsigned* bar, volatile LAS unsigned* st) {
    XcdBarrier b; b.bar = bar; b.x = xb_xcc_id(); b.st = st;
    if (threadIdx.x == 0) (void)xb_add(&bar[XB_XCNT(b.x)], 1u);
    return b;
}
__device__ __forceinline__ void xcd_barrier_complete(unsigned* bar, unsigned x, unsigned& nloc, unsigned& nx) {
    const unsigned G = gridDim.x * gridDim.y * gridDim.z;
    unsigned sum, cnt, mine, sp = 0u;
    for (;;) {
        sum = 0u; cnt = 0u; mine = 0u;
#pragma unroll
        for (unsigned j = 0; j < 16; ++j) { const unsigned c = xb_ld(&bar[XB_XCNT(j)]); sum += c; cnt += (c > 0u) ? 1u : 0u; mine = (j == x) ? c : mine; }
        if (sum == G) break;
        __builtin_amdgcn_s_sleep(1);
        if ((++sp & 255u) == 0u) { if (xb_ld(&bar[XB_TMO])) break; if (sp > XB_SPIN_CAP) { atomicAdd(&bar[XB_TMO], 1u); break; } }
    }
    nloc = mine > 0u ? mine : 1u; nx = cnt > 0u ? cnt : 1u;
}

__device__ __forceinline__ void xcd_barrier(const XcdBarrier& b) {
    asm volatile("s_waitcnt vmcnt(0)" ::: "memory");
    __syncthreads();
    if (threadIdx.x == 0) {
        unsigned* bar = b.bar;
        __builtin_amdgcn_s_waitcnt(0);
        unsigned nloc = b.st[0], nx = b.st[1];
        if (nloc == 0u) { xcd_barrier_complete(bar, b.x, nloc, nx); b.st[0] = nloc; b.st[1] = nx; }
        const unsigned old = xb_add(&bar[XB_XSUB(b.x)], 1u);
        const unsigned gen = old / nloc;
        if (old + 1u == (gen + 1u) * nloc) {
            __builtin_amdgcn_fence(__ATOMIC_RELEASE, "agent");
            asm volatile("s_waitcnt vmcnt(0)" ::: "memory");
            const unsigned og = xb_add(&bar[XB_TOP], 1u);
            const unsigned tg = og / nx;
            if (og + 1u == (tg + 1u) * nx) xb_add(&bar[XB_TOPGEN], 1u);
            else XB_SPIN(xb_ld(&bar[XB_TOPGEN]) == tg, bar);
            __builtin_amdgcn_fence(__ATOMIC_ACQUIRE, "agent");
            xb_add(&bar[XB_XGEN(b.x)], 1u);
            asm volatile("s_waitcnt vmcnt(0)" ::: "memory");
        } else {
            XB_SPIN(xb_ld(&bar[XB_XGEN(b.x)]) == gen, bar);
            __builtin_amdgcn_fence(__ATOMIC_ACQUIRE, "agent");
            asm volatile("s_waitcnt vmcnt(0)" ::: "memory");
        }
    }
    __syncthreads();
}

struct EpiP1G {
    static constexpr bool PERM = true, AFTER_DRAIN = false;
    bf16* P1; bf16* G;
    __device__ __forceinline__ void operator()(const f32x4 (&acc)[2][2][4][2], const pg8::Unit& u, int wr, int wc, int fr, int fq) const {
        { const int l_ = olane(); fr = l_ & 15; fq = l_ >> 4; }
        const int row0 = u.pm * 256 + wr * 64 + fr; const bool sg = u.pn >= 16, glu = u.pn >= 3 && u.pn < 7;
        bf16* base = sg ? G : P1; const int ldc = sg ? NG : LP; const int col0 = (sg ? u.pn - 16 : u.pn) * 256 + wc * 32 + 8 * fq;
#pragma unroll
        for (int ai = 0; ai < 2; ++ai)
#pragma unroll
            for (int m = 0; m < 4; ++m) { bf16* rowp = base + (size_t)(row0 + ai * 128 + m * 16) * ldc + col0;
                if (glu) {
                    bf16* zp = P1 + (size_t)(row0 + ai * 128 + m * 16) * LP + C_GLU + (u.pn - 3) * 128 + wc * 16 + 4 * fq;
#pragma unroll
                    for (int bj = 0; bj < 2; ++bj) { const f32x4 v0 = acc[ai][bj][m][0], v1 = acc[ai][bj][m][1];
                        v2u w; w.x = pk2(v0[0] * sigmoidf_(v0[1]), v0[2] * sigmoidf_(v0[3])); w.y = pk2(v1[0] * sigmoidf_(v1[1]), v1[2] * sigmoidf_(v1[3]));
                        *(v2u*)(zp + bj * 64) = w; }
                    continue; }
#pragma unroll
                for (int bj = 0; bj < 2; ++bj) { f32x4 v0 = acc[ai][bj][m][0], v1 = acc[ai][bj][m][1];
                    if (sg) {
#pragma unroll
                        for (int e = 0; e < 4; ++e) { v0[e] = sigmoidf_(v0[e]); v1[e] = sigmoidf_(v1[e]); } }
                    v4u w; w.x = pk2(v0[0], v0[1]); w.y = pk2(v0[2], v0[3]); w.z = pk2(v1[0], v1[1]); w.w = pk2(v1[2], v1[3]);
                    *(v4u*)(rowp + bj * 128) = w; } }
    }
};
struct EpiGateMul {
    static constexpr bool PERM = true, AFTER_DRAIN = false;
    bf16* G;
    __device__ __forceinline__ void operator()(const f32x4 (&acc)[2][2][4][2], const pg8::Unit& u, int wr, int wc, int fr, int fq) const {
        { const int l_ = olane(); fr = l_ & 15; fq = l_ >> 4; }
        const int row0 = u.pm * 256 + wr * 64 + fr, col0 = u.pn * 256 + wc * 32 + 8 * fq;
#pragma unroll
        for (int ai = 0; ai < 2; ++ai)
#pragma unroll
            for (int m = 0; m < 4; ++m) { bf16* rowp = G + (size_t)(row0 + ai * 128 + m * 16) * NG + col0;
#pragma unroll
                for (int bj = 0; bj < 2; ++bj) { const f32x4 v0 = acc[ai][bj][m][0], v1 = acc[ai][bj][m][1];
                    const v4u gv = *(const v4u*)(rowp + bj * 128); float gf[8]; unpack8(gv, gf);
                    v4u w; w.x = pk2(v0[0] * gf[0], v0[1] * gf[1]); w.y = pk2(v0[2] * gf[2], v0[3] * gf[3]); w.z = pk2(v1[0] * gf[4], v1[1] * gf[5]); w.w = pk2(v1[2] * gf[6], v1[3] * gf[7]);
                    *(v4u*)(rowp + bj * 128) = w; } }
    }
};
struct EpiResid {
    static constexpr bool PERM = false, AFTER_DRAIN = false;
    float* xl; float* xc; const float* gate; const float* xsrc;
    __device__ __forceinline__ void operator()(const f32x4 (&acc)[2][2][4][2], const pg8::Unit& u, int wr, int wc, int fr, int fq) const {
        { const int l_ = olane(); fr = l_ & 15; fq = l_ >> 4; }
        const int row0 = u.pm * 256 + wr * 64 + fr, col0 = u.pn * 256 + wc * 32 + 4 * fq;
        const bool lat = u.pm < 64; float* xb = lat ? xl : xc - (size_t)ML * DM; const float* xs = lat ? xsrc : xc - (size_t)ML * DM; const float* gp = gate + (lat ? (u.pm >> 4) : 4) * 6144 + col0;
#pragma unroll
        for (int ai = 0; ai < 2; ++ai)
#pragma unroll
            for (int m = 0; m < 4; ++m) { float* rowp = xb + (size_t)(row0 + ai * 128 + m * 16) * DM + col0; const float* srcp = xs + (size_t)(row0 + ai * 128 + m * 16) * DM + col0;
#pragma unroll
                for (int bj = 0; bj < 2; ++bj)
#pragma unroll
                    for (int n = 0; n < 2; ++n) { f32x4 x = *(const f32x4*)(srcp + bj * 128 + n * 16); const f32x4 gvv = *(const f32x4*)(gp + bj * 128 + n * 16); x = x + gvv * acc[ai][bj][m][n]; *(f32x4*)(rowp + bj * 128 + n * 16) = x; }
                asm volatile("" ::: "memory"); }
    }
};
struct EpiMerge {
    static constexpr bool PERM = true, AFTER_DRAIN = false;
    const bf16* G; bf16* MG;
    __device__ __forceinline__ void operator()(const f32x4 (&acc)[2][2][4][2], const pg8::Unit& u, int wr, int wc, int fr, int fq) const {
        { const int l_ = olane(); fr = l_ & 15; fq = l_ >> 4; }
        const int row0 = u.pm * 256 + wr * 64 + fr, col0 = u.pn * 256 + wc * 32 + 8 * fq;
#pragma unroll
        for (int ai = 0; ai < 2; ++ai)
#pragma unroll
            for (int m = 0; m < 4; ++m) { const size_t row = (size_t)(row0 + ai * 128 + m * 16); const bf16* gp = G + row * NG + u.z * 1024 + col0; bf16* mp = MG + row * DM + col0;
#pragma unroll
                for (int bj = 0; bj < 2; ++bj) { const f32x4 v0 = acc[ai][bj][m][0], v1 = acc[ai][bj][m][1];
                    float gf[8]; unpack8(*(const v4u*)(gp + bj * 128), gf);
                    float r[8] = {v0[0] * gf[0], v0[1] * gf[1], v0[2] * gf[2], v0[3] * gf[3], v1[0] * gf[4], v1[1] * gf[5], v1[2] * gf[6], v1[3] * gf[7]};
                    if (u.z > 0) { float of[8]; unpack8(*(const v4u*)(mp + bj * 128), of);
#pragma unroll
                        for (int e = 0; e < 8; ++e) r[e] += of[e]; }
                    *(v4u*)(mp + bj * 128) = pack8(r); }
                asm volatile("" ::: "memory"); }
    }
};
struct EpiPartial {
    static constexpr bool PERM = false, AFTER_DRAIN = false;
    float* PART;
    __device__ __forceinline__ void operator()(const f32x4 (&acc)[2][2][4][2], const pg8::Unit& u, int wr, int wc, int fr, int fq) const {
        { const int l_ = olane(); fr = l_ & 15; fq = l_ >> 4; }
        const int row0 = u.pm * 256 + wr * 64 + fr, col0 = (u.pn & 3) * 256 + wc * 32 + 4 * fq;
        float* base = PART + (size_t)(u.pn >> 2) * MC * DM;
#pragma unroll
        for (int ai = 0; ai < 2; ++ai)
#pragma unroll
            for (int m = 0; m < 4; ++m) { float* rowp = base + (size_t)(row0 + ai * 128 + m * 16) * DM + col0;
#pragma unroll
                for (int bj = 0; bj < 2; ++bj)
#pragma unroll
                    for (int n = 0; n < 2; ++n) *(f32x4*)(rowp + bj * 128 + n * 16) = acc[ai][bj][m][n]; }
    }
};
struct EpiSwiGLU {
    static constexpr bool PERM = true, AFTER_DRAIN = false;
    bf16* HID;
    __device__ __forceinline__ void operator()(const f32x4 (&acc)[2][2][4][2], const pg8::Unit& u, int wr, int wc, int fr, int fq) const {
        { const int l_ = olane(); fr = l_ & 15; fq = l_ >> 4; }
        const int row0 = u.pm * 256 + wr * 64 + fr, col0 = u.pn * 128 + wc * 16 + 4 * fq;
#pragma unroll
        for (int ai = 0; ai < 2; ++ai)
#pragma unroll
            for (int m = 0; m < 4; ++m) { bf16* rowp = HID + (size_t)(row0 + ai * 128 + m * 16) * DFF + col0;
#pragma unroll
                for (int bj = 0; bj < 2; ++bj) { const f32x4 v0 = acc[ai][bj][m][0], v1 = acc[ai][bj][m][1];
                    v2u w; w.x = pk2(siluf_(v0[0]) * v0[1], siluf_(v0[2]) * v0[3]); w.y = pk2(siluf_(v1[0]) * v1[1], siluf_(v1[2]) * v1[3]);
                    *(v2u*)(rowp + bj * 64) = w; } }
    }
};

__device__ __forceinline__ void phase_init(Ctx& c) {
    TLW;
    const __attribute__((address_space(4))) Params& p = *c.p;
    {
      const f32x4* sc = (const f32x4*)((const float*)(const __attribute__((address_space(1))) float*)p.in[I_CTX]); f32x4* dc = (f32x4*)((float*)(c.ws + WS_XC)); const int m4 = MC * DM / 4;
      for (int i = c.bid * 512 + tid_; i < m4; i += c.nblk * 512) dc[i] = sc[i]; }
    if (c.bid == 0) { for (int i = tid_; i < 1024; i += 512) { const int pos = i >> 4, f = i & 15; const float inv = __builtin_amdgcn_exp2f(-(float)f * (13.287712379549449f / 16.0f)); const float ang = (float)pos * inv;
        ((float*)(c.ws + WS_ROPE))[pos * 32 + f] = __cosf(ang); ((float*)(c.ws + WS_ROPE))[pos * 32 + 16 + f] = __sinf(ang); } }
    LAS float* sc = (LAS float*)c.lds;
    LAS float* part = (LAS float*)(c.lds + 20480);
    for (int i = tid_; i < 5120; i += 512) { const int r = i >> 10, k = i & 1023; const float v = r < 4 ? ((const float*)(const __attribute__((address_space(1))) float*)p.in[I_C])[r * 1024 + k] : ((const float*)(const __attribute__((address_space(1))) float*)p.in[I_CCTX])[k]; sc[i] = siluf_(v); }
    __syncthreads();
    for (int u = c.bid; u < DEPTH * 96; u += c.nblk) {
        const int l = u / 96, n0 = (u % 96) * 64;
        const float* w = ((const float*)(const __attribute__((address_space(1))) float*)p.in[I_WADA]) + (size_t)l * DM * 6144 + n0 + lane_;
        float a0 = 0.f, a1 = 0.f, a2 = 0.f, a3 = 0.f, a4 = 0.f;
        const int kb = wave_ * 128;
#pragma unroll 32
        for (int k = 0; k < 128; ++k) { const float wv = w[(size_t)(kb + k) * 6144];
            a0 += sc[kb + k] * wv; a1 += sc[1024 + kb + k] * wv; a2 += sc[2048 + kb + k] * wv; a3 += sc[3072 + kb + k] * wv; a4 += sc[4096 + kb + k] * wv; }
        LAS float* pw = part + wave_ * 320 + lane_; pw[0] = a0; pw[64] = a1; pw[128] = a2; pw[192] = a3; pw[256] = a4;
        __syncthreads();
        if (tid_ < 320) { float s = 0.f;
#pragma unroll
            for (int wv = 0; wv < 8; ++wv) s += part[wv * 320 + tid_];
            const int r = tid_ >> 6, ln = tid_ & 63; ((float*)(c.ws + WS_MOD))[((size_t)l * 5 + r) * 6144 + n0 + ln] = s + ((const float*)(const __attribute__((address_space(1))) float*)p.in[I_BADA])[l * 6144 + n0 + ln]; }
        __syncthreads();
    }
}

__device__ __forceinline__ void tr_item(const float* src, int lds_, int k0, int n0, bf16* dst, int ldd, int drow0, int rmul, int ncopy, LAS float* scr, int lane) {
#pragma unroll 4
    for (int i = 0; i < 16; ++i) { const int kk = 4 * i + (lane >> 4), nn = lane & 15; scr[kk * 17 + nn] = src[(size_t)(k0 + kk) * lds_ + n0 + nn]; }
    LDS_FENCE();
    const int n = lane >> 2, kc = (lane & 3) * 16;
#pragma unroll
    for (int h = 0; h < 2; ++h) { const LAS float* s = scr + (kc + 8 * h) * 17 + n;
        v4u o; o.x = pk2(s[0], s[17]); o.y = pk2(s[34], s[51]); o.z = pk2(s[68], s[85]); o.w = pk2(s[102], s[119]);
        bf16* d = dst + (size_t)(drow0 + rmul * n) * ldd + k0 + kc + 8 * h;
        for (int cpy = 0; cpy < ncopy; ++cpy) *(v4u*)(d + cpy * 1024) = o; }
    LDS_FENCE();
}
__device__ __forceinline__ void convert_weights(Ctx& c, int l) {
    TLW;
    const __attribute__((address_space(4))) Params& p = *c.p;
    LAS float* scr = (LAS float*)(c.lds + wave_ * 4608);
    const int gw = c.bid * 8 + wave_, ngw = c.nblk * 8;
    constexpr int I_IN = 16 * 433, I_P = 8 * 64, I_O = 16 * 64, I_F = 16 * 176, I_D = 44 * 64;
    constexpr int TOT = I_IN + 3 * I_P + I_O + 2 * I_F + I_D;
    for (int it = gw; it < TOT; it += ngw) {
        int r = it;
        if (r < I_IN) { const int kb = r / 433, nb = r % 433, n0 = nb * 16; const bool isv = n0 >= 768 && n0 < 1280, isg = n0 >= 1280 && n0 < 1792;
            tr_item(((const float*)(const __attribute__((address_space(1))) float*)p.in[I_WIN]) + (size_t)l * DM * NIN, NIN, kb * 64, n0, ((bf16*)(c.ws + WS_WIN)), DM, isv ? 768 + 2 * (n0 - 768) : isg ? 769 + 2 * (n0 - 1280) : n0 < 3856 ? n0 : n0 + 240, (isv || isg) ? 2 : 1, 1, scr, lane_); continue; } r -= I_IN;
        if (r < 3 * I_P) { const int br = r / I_P, q = r % I_P, kb = q / 64, nb = q % 64; const float* src = (br == 0 ? ((const float*)(const __attribute__((address_space(1))) float*)p.in[I_WATT]) : br == 1 ? ((const float*)(const __attribute__((address_space(1))) float*)p.in[I_WPW]) : ((const float*)(const __attribute__((address_space(1))) float*)p.in[I_WMOUT])) + (size_t)l * 512 * DM;
            tr_item(src, DM, kb * 64, nb * 16, ((bf16*)(c.ws + WS_WP)), 512, br * 1024 + nb * 16, 1, 1, scr, lane_); continue; } r -= 3 * I_P;
        if (r < I_O) { const int kb = r / 64, nb = r % 64; tr_item(((const float*)(const __attribute__((address_space(1))) float*)p.in[I_WOUT]) + (size_t)l * DM * DM, DM, kb * 64, nb * 16, ((bf16*)(c.ws + WS_WO3)), 3072, nb * 16, 1, 3, scr, lane_); continue; } r -= I_O;
        if (r < 2 * I_F) { const int gu = r / I_F, q = r % I_F, kb = q / 176, nb = q % 176; const float* src = (gu == 0 ? ((const float*)(const __attribute__((address_space(1))) float*)p.in[I_WFG]) : ((const float*)(const __attribute__((address_space(1))) float*)p.in[I_WFU])) + (size_t)l * DM * DFF;
            tr_item(src, DFF, kb * 64, nb * 16, ((bf16*)(c.ws + WS_WGU)), DM, 2 * nb * 16 + gu, 2, 1, scr, lane_); continue; } r -= 2 * I_F;
        { const int kb = r / 64, nb = r % 64; tr_item(((const float*)(const __attribute__((address_space(1))) float*)p.in[I_WFD]) + (size_t)l * DFF * DM, DM, kb * 64, nb * 16, ((bf16*)(c.ws + WS_WD)), DFF, nb * 16, 1, 1, scr, lane_); }
    }
    { v4u* z = (v4u*)(((bf16*)(c.ws + WS_WIN)) + (size_t)3856 * DM); const int nz = 240 * DM / 8; for (int i = c.bid * 512 + tid_; i < nz; i += c.nblk * 512) z[i] = zero4u(); }
}
__device__ __forceinline__ void phase_norm(Ctx& c, int l, int which, int nrows, const float* part, int nsl, const float* pgate, const float* xin) {
    TLW;
    const __attribute__((address_space(4))) Params& p = *c.p;
    const float* g = p.in[which ? I_GFFN : I_GMIX] + l * DM;
    const float* modl = ((float*)(c.ws + WS_MOD)) + (size_t)l * 5 * 6144 + (which ? 3072 : 0);
    bf16* H = ((bf16*)(c.ws + WS_BO));
    const int gw = c.bid * 8 + wave_, ngw = c.nblk * 8;
    f32x4 gv[4];
#pragma unroll
    for (int j = 0; j < 4; ++j) gv[j] = ((const f32x4*)g)[64 * j + lane_];
    constexpr int NR = 4;
    for (int rb = gw; rb < nrows; rb += NR * ngw) {
        f32x4 v[NR][4]; float ss[NR];
#pragma unroll
        for (int k = 0; k < NR; ++k) { const int r = rb + k * ngw; ss[k] = 0.f;
            if (r < nrows) {
                float* xr = r < ML ? (xin != nullptr ? const_cast<float*>(xin) : c.xl) + (size_t)r * DM : ((float*)(c.ws + WS_XC)) + (size_t)(r - ML) * DM;
#pragma unroll
                for (int j = 0; j < 4; ++j) { v[k][j] = ((const f32x4*)xr)[64 * j + lane_];
                    if (part != nullptr && r >= ML) {
                        f32x4 a = zero4();
                        for (int sidx = 0; sidx < nsl; ++sidx) a = a + ((const f32x4*)(part + ((size_t)sidx * MC + (r - ML)) * DM))[64 * j + lane_];
                        v[k][j] = v[k][j] + ((const f32x4*)pgate)[64 * j + lane_] * a; ((f32x4*)xr)[64 * j + lane_] = v[k][j]; }
                    ss[k] += (v[k][j].x * v[k][j].x + v[k][j].y * v[k][j].y) + (v[k][j].z * v[k][j].z + v[k][j].w * v[k][j].w); } } }
        { const int ol = olane();
#pragma unroll
          for (int k = 0; k < NR; ++k) { ss[k] += DPPF(ss[k], 0x128); ss[k] += DPPF(ss[k], 0x124); ss[k] += DPPF(ss[k], 0x122); ss[k] += DPPF(ss[k], 0x121); }
#pragma unroll
          for (int k = 0; k < NR; ++k) ss[k] += shi(ss[k], ol ^ 16);
#pragma unroll
          for (int k = 0; k < NR; ++k) ss[k] += shi(ss[k], ol ^ 32); }
#pragma unroll
        for (int k = 0; k < NR; ++k) { const int r = rb + k * ngw;
            if (r < nrows) {
                const float* mr = modl + (r < ML ? (r >> 12) : 4) * 6144;
                const float rstd = rsqrtf(ss[k] * (1.0f / DM) + EPS);
                v2u* o = (v2u*)(H + (size_t)r * DM);
#pragma unroll
                for (int j = 0; j < 4; ++j) { const f32x4 sh = ((const f32x4*)mr)[64 * j + lane_], scl = ((const f32x4*)(mr + 1024))[64 * j + lane_];
                    f32x4 y = v[k][j] * rstd * gv[j]; y = y * (scl + 1.0f) + sh;
                    v2u w; w.x = pk2(y.x, y.y); w.y = pk2(y.z, y.w); o[64 * j + lane_] = w; } } }
    }
}
__device__ __forceinline__ void phase_final(Ctx& c) {
    TLW;
    const float* g = ((const float*)(const __attribute__((address_space(1))) float*)c.p->in[I_GFIN]);
    const int gw = c.bid * 8 + wave_, ngw = c.nblk * 8;
    for (int r = gw; r < ML; r += ngw) {
        f32x4* xr = (f32x4*)(c.xl + (size_t)r * DM);
        f32x4 v[4]; float ss = 0.f;
#pragma unroll
        for (int j = 0; j < 4; ++j) { v[j] = xr[64 * j + lane_]; ss += (v[j].x * v[j].x + v[j].y * v[j].y) + (v[j].z * v[j].z + v[j].w * v[j].w); }
        const float rstd = rsqrtf(wave_sum(ss) * (1.0f / DM) + EPS);
#pragma unroll
        for (int j = 0; j < 4; ++j) { f32x4 o = v[j] * rstd * ((const f32x4*)g)[64 * j + lane_];
#ifdef DBGSCAN
            { const int code = *(const int*)(c.ws + WS_DBG); if (code != 0x7fffffff) { const float cv = sqrtf(2.0f * (float)code); o = (f32x4){cv, cv, cv, cv}; } }
#endif
            xr[64 * j + lane_] = o; }
    }
}

__device__ __forceinline__ void attn_unit(Ctx& c, int l, int b, int h, int qblk, bool ictx) {
    TLW;
    const __attribute__((address_space(4))) Params& p = *c.p;
    LAS bf16* Qs = (LAS bf16*)c.lds;
    LAS bf16* Ks = (LAS bf16*)(c.lds + 18432);
    LAS bf16* Vt = (LAS bf16*)(c.lds + 27648);
    LAS bf16* Ps = (LAS bf16*)(c.lds + 36864) + wave_ * (16 * 72);
    const int tid = tid_, lane = lane_, w = wave_, lr = lane & 15, lg = lane >> 4;
    const int hk = h >> 2;
    const size_t qrow0 = ictx ? (size_t)ML + b * CTXL + qblk * 128 : (size_t)b * SEQ + qblk * 128;
    {
        const int row = tid >> 2, part = tid & 3, d0 = (part & 1) * 8 + (part >> 1) * 32;
        const bf16* src = ((bf16*)(c.ws + WS_P1)) + (qrow0 + row) * LP + C_Q + h * 64 + d0;
        float lo[8], hi[8]; unpack8(*(const v4u*)src, lo); unpack8(*(const v4u*)(src + 16), hi);
        if (!ictx) { const int t = qblk * 128 + row, pos = (part >> 1) ? (t & 63) : (t >> 6); const float* rt = ((const float*)(c.ws + WS_ROPE)) + pos * 32 + (d0 & 15);
#pragma unroll
            for (int j = 0; j < 8; ++j) { const float cs = rt[j], sn = rt[16 + j]; const float a = lo[j], bb = hi[j]; lo[j] = a * cs - bb * sn; hi[j] = bb * cs + a * sn; } }
        *(LAS v4u*)(Qs + row * 72 + d0) = pack8(lo); *(LAS v4u*)(Qs + row * 72 + d0 + 16) = pack8(hi);
    }
    __syncthreads();
    bf16x8 qa[2];
#pragma unroll
    for (int ks = 0; ks < 2; ++ks) qa[ks] = *(const LAS bf16x8*)(Qs + (16 * w + lr) * 72 + ks * 32 + lg * 8);
    const float sink = ((const float*)(const __attribute__((address_space(1))) float*)p.in[I_SINK])[l * 8 + h];
    float mrow[4], lrow[4]; f32x4 oacc[4];
#pragma unroll
    for (int j = 0; j < 4; ++j) { mrow[j] = sink; lrow[j] = (lr == 0) ? 1.0f : 0.0f; }
#pragma unroll
    for (int db = 0; db < 4; ++db) oacc[db] = zero4();
    const int ntile = ictx ? 4 : 10;
    for (int kt = 0; kt < ntile; ++kt) {
        const bool band = !ictx && kt < 6;
        const int kpos0 = (qblk - 1) * 128 + kt * 64;
        if (band && (kpos0 < 0 || kpos0 >= SEQ)) continue;
        const size_t krow0 = band ? (size_t)b * SEQ + kpos0 : (size_t)ML + b * CTXL + (ictx ? kt : kt - 6) * 64;
        __syncthreads();
        if (tid < 256) {
            const int row = tid >> 2, part = tid & 3, d0 = (part & 1) * 8 + (part >> 1) * 32;
            const bf16* src = ((bf16*)(c.ws + WS_P1)) + (krow0 + row) * LP + C_K + hk * 64 + d0;
            float lo[8], hi[8]; unpack8(*(const v4u*)src, lo); unpack8(*(const v4u*)(src + 16), hi);
            if (band) { const int t = kpos0 + row, pos = (part >> 1) ? (t & 63) : (t >> 6); const float* rt = ((const float*)(c.ws + WS_ROPE)) + pos * 32 + (d0 & 15);
#pragma unroll
                for (int j = 0; j < 8; ++j) { const float cs = rt[j], sn = rt[16 + j]; const float a = lo[j], bb = hi[j]; lo[j] = a * cs - bb * sn; hi[j] = bb * cs + a * sn; } }
            *(LAS v4u*)(Ks + row * 72 + d0) = pack8(lo); *(LAS v4u*)(Ks + row * 72 + d0 + 16) = pack8(hi);
        }
        {
            const int key = tid >> 3, dg = tid & 7;
            const v4u vv = *(const v4u*)(((bf16*)(c.ws + WS_P1)) + (krow0 + key) * LP + C_V + hk * 64 + dg * 8);
            LAS bf16* d = Vt + (dg * 8) * 72 + key;
            d[0] = (bf16)(vv.x & 0xffffu); d[72] = (bf16)(vv.x >> 16); d[144] = (bf16)(vv.y & 0xffffu); d[216] = (bf16)(vv.y >> 16);
            d[288] = (bf16)(vv.z & 0xffffu); d[360] = (bf16)(vv.z >> 16); d[432] = (bf16)(vv.w & 0xffffu); d[504] = (bf16)(vv.w >> 16);
        }
        __syncthreads();
        f32x4 s[4];
#pragma unroll
        for (int nb = 0; nb < 4; ++nb) { s[nb] = zero4();
#pragma unroll
            for (int ks = 0; ks < 2; ++ks) { const bf16x8 kb = *(const LAS bf16x8*)(Ks + (nb * 16 + lr) * 72 + ks * 32 + lg * 8); s[nb] = MFMA16(qa[ks], kb, s[nb]); } }
        float mx[4];
#pragma unroll
        for (int j = 0; j < 4; ++j) mx[j] = -3.0e38f;
#pragma unroll
        for (int nb = 0; nb < 4; ++nb)
#pragma unroll
            for (int j = 0; j < 4; ++j) { float v = s[nb][j] * 0.125f;
                if (band) { const int kp = kpos0 + nb * 16 + lr, qp = qblk * 128 + 16 * w + lg * 4 + j; const int dd = kp - qp; if (dd > 128 || dd < -128) v = -1.0e30f; }
                s[nb][j] = v; mx[j] = fmaxf(mx[j], v); DBGF(!(fabsf(v) < 1e31f), 7); }
        float corr[4];
#pragma unroll
        for (int j = 0; j < 4; ++j) { float v = mx[j]; v = fmaxf(v, shx(v, 1)); v = fmaxf(v, shx(v, 2)); v = fmaxf(v, shx(v, 4)); v = fmaxf(v, shx(v, 8));
            const float mn = fmaxf(mrow[j], v); corr[j] = __expf(mrow[j] - mn); mrow[j] = mn; lrow[j] *= corr[j]; }
#pragma unroll
        for (int nb = 0; nb < 4; ++nb)
#pragma unroll
            for (int j = 0; j < 4; ++j) { const float pv = __expf(s[nb][j] - mrow[j]); lrow[j] += pv; DBGF(!(pv <= 1.0f && pv >= 0.f), 8); Ps[(lg * 4 + j) * 72 + nb * 16 + lr] = (bf16)(pk2(pv, 0.f) & 0xffffu); }
#pragma unroll
        for (int db = 0; db < 4; ++db)
#pragma unroll
            for (int j = 0; j < 4; ++j) oacc[db][j] *= corr[j];
        LDS_FENCE();
        bf16x8 pa[2];
#pragma unroll
        for (int ks = 0; ks < 2; ++ks) pa[ks] = *(const LAS bf16x8*)(Ps + lr * 72 + ks * 32 + lg * 8);
#pragma unroll
        for (int db = 0; db < 4; ++db)
#pragma unroll
            for (int ks = 0; ks < 2; ++ks) { const bf16x8 vb = *(const LAS bf16x8*)(Vt + (db * 16 + lr) * 72 + ks * 32 + lg * 8); oacc[db] = MFMA16(pa[ks], vb, oacc[db]); }
        LDS_FENCE();
    }
#pragma unroll
    for (int j = 0; j < 4; ++j) { float v = lrow[j]; v += shx(v, 1); v += shx(v, 2); v += shx(v, 4); v += shx(v, 8); DBGF(!(v >= 0.999f), 9); lrow[j] = 1.0f / v; }
    for (int db = 0; db < 4; ++db) for (int j = 0; j < 4; ++j) DBGF(!(fabsf(oacc[db][j]) < 16384.f), 10);
#pragma unroll
    for (int db = 0; db < 4; ++db)
#pragma unroll
        for (int j = 0; j < 4; ++j) ((bf16*)(c.ws + WS_BO))[(qrow0 + 16 * w + lg * 4 + j) * LBO + h * 64 + db * 16 + lr] = (bf16)(pk2(oacc[db][j] * lrow[j], 0.f) & 0xffffu);
    __syncthreads();
}

#define DPP_ROR(v, n) __builtin_bit_cast(float, __builtin_amdgcn_update_dpp(0, __builtin_bit_cast(int, (v)), 0x120 + (n), 0xf, 0xf, false))
__device__ __forceinline__ float row16_max(float v) { v = fmaxf(v, DPP_ROR(v, 8)); v = fmaxf(v, DPP_ROR(v, 4)); v = fmaxf(v, DPP_ROR(v, 2)); v = fmaxf(v, DPP_ROR(v, 1)); return v; }
__device__ __forceinline__ float row16_sum(float v) { v += DPP_ROR(v, 8); v += DPP_ROR(v, 4); v += DPP_ROR(v, 2); v += DPP_ROR(v, 1); return v; }
__device__ __forceinline__ void rope8(const float* rt, float (&lo)[8], float (&hi)[8]) {
    const f32x4 c0 = *(const f32x4*)rt, c1 = *(const f32x4*)(rt + 4), s0 = *(const f32x4*)(rt + 16), s1 = *(const f32x4*)(rt + 20);
    const float cs[8] = {c0.x, c0.y, c0.z, c0.w, c1.x, c1.y, c1.z, c1.w}, sn[8] = {s0.x, s0.y, s0.z, s0.w, s1.x, s1.y, s1.z, s1.w};
#pragma unroll
    for (int j = 0; j < 8; ++j) { const float a = lo[j], bb = hi[j]; lo[j] = a * cs[j] - bb * sn[j]; hi[j] = bb * cs[j] + a * sn[j]; }
}
__device__ __forceinline__ void attn_stage(const bf16* p1, const float* rope, int tid, int b, int hk, int qblk, bool ictx, int kt, LAS bf16* Ks, LAS bf16* Vt) {
    const bool band = !ictx && kt < 6; const int kpos0 = (qblk - 1) * 128 + kt * 64;
    const size_t krow0 = band ? (size_t)b * SEQ + kpos0 : (size_t)ML + b * CTXL + (ictx ? kt : kt - 6) * 64;
    if (tid < 256) {
        const int row = tid >> 2, part = tid & 3, d0 = (part & 1) * 8 + (part >> 1) * 32;
        const bf16* src = p1 + (krow0 + row) * LP + C_K + hk * 64 + d0;
        float lo[8], hi[8]; unpack8(*(const v4u*)src, lo); unpack8(*(const v4u*)(src + 16), hi);
        if (band) { const int t = kpos0 + row, pos = (part >> 1) ? (t & 63) : (t >> 6); rope8(rope + pos * 32 + (d0 & 15), lo, hi); }
        *(LAS v4u*)(Ks + row * 72 + d0) = pack8(lo); *(LAS v4u*)(Ks + row * 72 + d0 + 16) = pack8(hi);
    }
    { const int key = tid >> 3, dg = tid & 7;
      const v4u vv = *(const v4u*)(p1 + (krow0 + key) * LP + C_V + hk * 64 + dg * 8);
      LAS bf16* d = Vt + (dg * 8) * 72 + key;
      d[0] = (bf16)(vv.x & 0xffffu); d[72] = (bf16)(vv.x >> 16); d[144] = (bf16)(vv.y & 0xffffu); d[216] = (bf16)(vv.y >> 16);
      d[288] = (bf16)(vv.z & 0xffffu); d[360] = (bf16)(vv.z >> 16); d[432] = (bf16)(vv.w & 0xffffu); d[504] = (bf16)(vv.w >> 16); }
}
struct AttnPre { v4u k0, k1, v; };
__device__ __forceinline__ void attn_load(const bf16* p1, int tid, int b, int hk, int qblk, bool ictx, int kt, AttnPre& r) {
    const bool band = !ictx && kt < 6; const int kpos0 = (qblk - 1) * 128 + kt * 64;
    const size_t krow0 = band ? (size_t)b * SEQ + kpos0 : (size_t)ML + b * CTXL + (ictx ? kt : kt - 6) * 64;
    { const int row = (tid & 255) >> 2, part = tid & 3, d0 = (part & 1) * 8 + (part >> 1) * 32; const bf16* src = p1 + (krow0 + row) * LP + C_K + hk * 64 + d0; r.k0 = *(const v4u*)src; r.k1 = *(const v4u*)(src + 16); }
    { const int key = tid >> 3, dg = tid & 7; r.v = *(const v4u*)(p1 + (krow0 + key) * LP + C_V + hk * 64 + dg * 8); }
}
__device__ __forceinline__ void attn_commit(const float* rope, int tid, int qblk, bool ictx, int kt, const AttnPre& r, LAS bf16* Ks, LAS bf16* Vt) {
    const bool band = !ictx && kt < 6; const int kpos0 = (qblk - 1) * 128 + kt * 64;
    if (tid < 256) {
        const int row = tid >> 2, part = tid & 3, d0 = (part & 1) * 8 + (part >> 1) * 32;
        float lo[8], hi[8]; unpack8(r.k0, lo); unpack8(r.k1, hi);
        if (band) { const int t = kpos0 + row, pos = (part >> 1) ? (t & 63) : (t >> 6); rope8(rope + pos * 32 + (d0 & 15), lo, hi); }
        *(LAS v4u*)(Ks + row * 72 + d0) = pack8(lo); *(LAS v4u*)(Ks + row * 72 + d0 + 16) = pack8(hi);
    }
    { const int key = tid >> 3, dg = tid & 7; const v4u vv = r.v;
      LAS bf16* d = Vt + (dg * 8) * 72 + key;
      d[0] = (bf16)(vv.x & 0xffffu); d[72] = (bf16)(vv.x >> 16); d[144] = (bf16)(vv.y & 0xffffu); d[216] = (bf16)(vv.y >> 16);
      d[288] = (bf16)(vv.z & 0xffffu); d[360] = (bf16)(vv.z >> 16); d[432] = (bf16)(vv.w & 0xffffu); d[504] = (bf16)(vv.w >> 16); }
}
__device__ __forceinline__ bool attn_tile_ok(bool ictx, int qblk, int kt) { if (ictx || kt >= 6) return true; const int kpos0 = (qblk - 1) * 128 + kt * 64; return kpos0 >= 0 && kpos0 < SEQ; }
__device__ __forceinline__ void attn_unit4(Ctx& c, int l, int b, int hk, int qblk, bool ictx) {
    TLW;
    const __attribute__((address_space(4))) Params& p = *c.p;
    LAS bf16* Qs = (LAS bf16*)c.lds;
    LAS bf16* KB = (LAS bf16*)(c.lds + 73728);
    LAS bf16* VB = (LAS bf16*)(c.lds + 73728 + 18432);
    LAS bf16* Ps = (LAS bf16*)(c.lds + 73728 + 36864) + wave_ * (16 * 72);
    const int tid = tid_, lane = lane_, w = wave_, lr = lane & 15, lg = lane >> 4, g = w >> 1, half = w & 1;
    const bf16* p1 = ((bf16*)(c.ws + WS_P1)); const float* rope = ((const float*)(c.ws + WS_ROPE));
    const size_t qrow0 = ictx ? (size_t)ML + b * CTXL + qblk * 128 : (size_t)b * SEQ + qblk * 128;
#pragma unroll
    for (int rep = 0; rep < 4; ++rep) {
        const int it = tid + rep * 512, hh = it >> 9, row = (it >> 2) & 127, part = it & 3, d0 = (part & 1) * 8 + (part >> 1) * 32;
        const bf16* src = p1 + (qrow0 + row) * LP + C_Q + (hk * 4 + hh) * 64 + d0;
        float lo[8], hi[8]; unpack8(*(const v4u*)src, lo); unpack8(*(const v4u*)(src + 16), hi);
        if (!ictx) { const int t = qblk * 128 + row, pos = (part >> 1) ? (t & 63) : (t >> 6); rope8(rope + pos * 32 + (d0 & 15), lo, hi); }
        *(LAS v4u*)(Qs + (hh * 128 + row) * 72 + d0) = pack8(lo); *(LAS v4u*)(Qs + (hh * 128 + row) * 72 + d0 + 16) = pack8(hi);
    }
    const int ntile = ictx ? 4 : 10;
    int kt = 0; while (!attn_tile_ok(ictx, qblk, kt)) ++kt;
    attn_stage(p1, rope, tid, b, hk, qblk, ictx, kt, KB, VB);
    __syncthreads();
    constexpr float L2E = 1.4426950408889634f, QSC = 0.125f * L2E;
    const int ol_ = olane();
    const float sink2 = ((const float*)(const __attribute__((address_space(1))) float*)p.in[I_SINK])[l * 8 + hk * 4 + g] * L2E;
    float mrow[4], lrow[4]; f32x4 oacc[4][4];
#pragma unroll
    for (int rb = 0; rb < 4; ++rb) { mrow[rb] = sink2; lrow[rb] = (lg == 0) ? 1.0f : 0.0f;
#pragma unroll
        for (int db = 0; db < 4; ++db) oacc[rb][db] = zero4(); }
    int buf = 0;
    while (kt < ntile) {
        int kn = kt + 1; while (kn < ntile && !attn_tile_ok(ictx, qblk, kn)) ++kn;
        AttnPre pre; if (kn < ntile) attn_load(p1, tid, b, hk, qblk, ictx, kn, pre);
        const LAS bf16* Ks = KB + buf * (64 * 72); const LAS bf16* Vt = VB + buf * (64 * 72);
        const bool msk = !ictx && (kt < 2 || kt == 4 || kt == 5); const int kpos0 = (qblk - 1) * 128 + kt * 64;
        bf16x8 vf[4][2];
#pragma unroll
        for (int db = 0; db < 4; ++db)
#pragma unroll
            for (int ks = 0; ks < 2; ++ks) { const v2u a0 = *(const LAS v2u*)(Vt + (db * 16 + lr) * 72 + ks * 32 + lg * 4), a1 = *(const LAS v2u*)(Vt + (db * 16 + lr) * 72 + ks * 32 + 16 + lg * 4);
                vf[db][ks] = __builtin_bit_cast(bf16x8, (v4u){a0.x, a0.y, a1.x, a1.y}); }
#pragma unroll
        for (int rb = 0; rb < 4; ++rb) {
            if (msk) { const int q0_ = qblk * 128 + half * 64 + rb * 16; if (kpos0 > q0_ + 15 + 128 || kpos0 + 63 < q0_ - 128) continue; }
            f32x4 st[4];
            const bf16x8 qa0 = *(const LAS bf16x8*)(Qs + (g * 128 + half * 64 + rb * 16 + lr) * 72 + lg * 8), qa1 = *(const LAS bf16x8*)(Qs + (g * 128 + half * 64 + rb * 16 + lr) * 72 + 32 + lg * 8);
#pragma unroll
            for (int nb = 0; nb < 4; ++nb) { const bf16x8 kb0 = *(const LAS bf16x8*)(Ks + (nb * 16 + lr) * 72 + lg * 8), kb1 = *(const LAS bf16x8*)(Ks + (nb * 16 + lr) * 72 + 32 + lg * 8);
                st[nb] = MFMA16(kb0, qa0, ((f32x4){0.f, 0.f, 0.f, 0.f})); st[nb] = MFMA16(kb1, qa1, st[nb]); }
            float mx = -3.0e38f;
#pragma unroll
            for (int nb = 0; nb < 4; ++nb)
#pragma unroll
                for (int j = 0; j < 4; ++j) { float v = st[nb][j] * QSC;
                    if (msk) { const int kp = kpos0 + nb * 16 + lg * 4 + j, qp = qblk * 128 + half * 64 + rb * 16 + lr; const int dd = kp - qp; if (dd > 128 || dd < -128) v = -1.0e30f; }
                    st[nb][j] = v; mx = fmaxf(mx, v); }
            mx = fmaxf(mx, shi(mx, ol_ ^ 16)); mx = fmaxf(mx, shi(mx, ol_ ^ 32));
            const float mn = fmaxf(mrow[rb], mx), corr = __builtin_amdgcn_exp2f(mrow[rb] - mn); mrow[rb] = mn;
            float ls = 0.f;
#pragma unroll
            for (int nb = 0; nb < 4; ++nb)
#pragma unroll
                for (int j = 0; j < 4; ++j) { const float pv = __builtin_amdgcn_exp2f(st[nb][j] - mn); st[nb][j] = pv; ls += pv; }
            lrow[rb] = lrow[rb] * corr + ls;
            bf16x8 pb[2];
#pragma unroll
            for (int ks = 0; ks < 2; ++ks) pb[ks] = __builtin_bit_cast(bf16x8, (v4u){pk2(st[2 * ks][0], st[2 * ks][1]), pk2(st[2 * ks][2], st[2 * ks][3]), pk2(st[2 * ks + 1][0], st[2 * ks + 1][1]), pk2(st[2 * ks + 1][2], st[2 * ks + 1][3])});
#pragma unroll
            for (int db = 0; db < 4; ++db) { oacc[rb][db] = oacc[rb][db] * corr;
#pragma unroll
                for (int ks = 0; ks < 2; ++ks) oacc[rb][db] = MFMA16(vf[db][ks], pb[ks], oacc[rb][db]); }
        }
        if (kn < ntile) attn_commit(rope, tid, qblk, ictx, kn, pre, KB + (buf ^ 1) * (64 * 72), VB + (buf ^ 1) * (64 * 72));
        __syncthreads();
        kt = kn; buf ^= 1;
    }
    bf16* bo = ((bf16*)(c.ws + WS_BO));
#pragma unroll
    for (int rb = 0; rb < 4; ++rb) {
        float lt = lrow[rb]; lt += shi(lt, ol_ ^ 16); lt += shi(lt, ol_ ^ 32);
        const float inv = 1.0f / lt;
#pragma unroll
        for (int db = 0; db < 4; ++db) { v2u o; o.x = pk2(oacc[rb][db][0] * inv, oacc[rb][db][1] * inv); o.y = pk2(oacc[rb][db][2] * inv, oacc[rb][db][3] * inv);
            *(v2u*)(bo + (qrow0 + half * 64 + rb * 16 + lr) * LBO + (hk * 4 + g) * 64 + db * 16 + lg * 4) = o; }
    }
    __syncthreads();
}

__device__ __forceinline__ void conv_unit(Ctx& c, int l, int u) {
    TLW;
    const __attribute__((address_space(4))) Params& p = *c.p;
    LAS bf16* Zs = (LAS bf16*)c.lds;
    const int r0 = u * 64;
    const int seq_lo = r0 < ML ? (r0 / SEQ) * SEQ : ML + ((r0 - ML) / CTXL) * CTXL, seq_hi = seq_lo + (r0 < ML ? SEQ : CTXL);
    {
        const bf16* p1c = ((bf16*)(c.ws + WS_P1));
#pragma unroll 1
        for (int k0 = 0; k0 < 12; k0 += 4) {
            v4u vz[4];
#pragma unroll
            for (int k = 0; k < 4; ++k) { int it = tid_ + (k0 + k) * 512; it = it < 94 * 64 ? it : 94 * 64 - 1; const int zr = it >> 6, cg8 = (it & 63) * 8; int g = r0 - 15 + zr; g = g < seq_lo ? seq_lo : (g >= seq_hi ? seq_hi - 1 : g);
                vz[k] = *(const v4u*)(p1c + (size_t)g * LP + C_GLU + cg8); }
#pragma unroll
            for (int k = 0; k < 4; ++k) { const int it = tid_ + (k0 + k) * 512; if (it < 94 * 64) { const int zr = it >> 6, cg8 = (it & 63) * 8; const int g = r0 - 15 + zr;
                v4u o = vz[k]; if (!(g >= seq_lo && g < seq_hi)) o = zero4u();
                *(LAS v4u*)(Zs + zr * 520 + cg8) = o; } }
        }
    }
    __syncthreads();
    const int c0 = lane_ * 8, t0 = wave_ * 8;
    const float* wdw = ((const float*)(const __attribute__((address_space(1))) float*)p.in[I_WDW]) + (size_t)l * 31 * 512 + c0;
    float acc[8][8];
    { const f32x4 b0 = *(const f32x4*)(((const float*)(const __attribute__((address_space(1))) float*)p.in[I_BDW]) + l * 512 + c0), b1 = *(const f32x4*)(((const float*)(const __attribute__((address_space(1))) float*)p.in[I_BDW]) + l * 512 + c0 + 4);
#pragma unroll
      for (int t = 0; t < 8; ++t) { acc[t][0] = b0.x; acc[t][1] = b0.y; acc[t][2] = b0.z; acc[t][3] = b0.w; acc[t][4] = b1.x; acc[t][5] = b1.y; acc[t][6] = b1.z; acc[t][7] = b1.w; } }
    float zw[8][8];
#pragma unroll
    for (int t = 0; t < 7; ++t) unpack8(*(const LAS v4u*)(Zs + (t0 + t) * 520 + c0), zw[t]);
    f32x4 wa = *(const f32x4*)(wdw), wb = *(const f32x4*)(wdw + 4);
#pragma unroll 1
    for (int j0 = 0; j0 < 32; j0 += 8) {
#pragma unroll
        for (int jj = 0; jj < 8; ++jj) {
            const int j = j0 + jj;
            if (j <= 30) {
                unpack8(*(const LAS v4u*)(Zs + (t0 + j + 7) * 520 + c0), zw[(jj + 7) & 7]);
                const float wv[8] = {wa.x, wa.y, wa.z, wa.w, wb.x, wb.y, wb.z, wb.w};
                if (j < 30) { wa = *(const f32x4*)(wdw + (j + 1) * 512); wb = *(const f32x4*)(wdw + (j + 1) * 512 + 4); }
#pragma unroll
                for (int t = 0; t < 8; ++t)
#pragma unroll
                    for (int i = 0; i < 8; ++i) acc[t][i] += wv[i] * zw[(jj + t) & 7][i];
            }
        }
    }
    const f32x4 g0 = *(const f32x4*)(((const float*)(const __attribute__((address_space(1))) float*)p.in[I_GCLN]) + l * 512 + c0), g1 = *(const f32x4*)(((const float*)(const __attribute__((address_space(1))) float*)p.in[I_GCLN]) + l * 512 + c0 + 4);
    const f32x4 e0 = *(const f32x4*)(((const float*)(const __attribute__((address_space(1))) float*)p.in[I_BCLN]) + l * 512 + c0), e1 = *(const f32x4*)(((const float*)(const __attribute__((address_space(1))) float*)p.in[I_BCLN]) + l * 512 + c0 + 4);
    const float gg[8] = {g0.x, g0.y, g0.z, g0.w, g1.x, g1.y, g1.z, g1.w}, ee[8] = {e0.x, e0.y, e0.z, e0.w, e1.x, e1.y, e1.z, e1.w};
    float sm[8], sq[8];
#pragma unroll
    for (int t = 0; t < 8; ++t) { float s = 0.f;
#pragma unroll
        for (int i = 0; i < 8; ++i) s += acc[t][i];
        sm[t] = s; }
    wave_sum8(sm);
#pragma unroll
    for (int t = 0; t < 8; ++t) { const float mean = sm[t] * (1.0f / 512.0f); float q = 0.f;
#pragma unroll
        for (int i = 0; i < 8; ++i) { acc[t][i] -= mean; q += acc[t][i] * acc[t][i]; }
        sq[t] = q; }
    wave_sum8(sq);
#pragma unroll
    for (int t = 0; t < 8; ++t) {
        const float rstd = rsqrtf(sq[t] * (1.0f / 512.0f) + EPS);
        float y[8];
#pragma unroll
        for (int i = 0; i < 8; ++i) { const float v = acc[t][i] * rstd * gg[i] + ee[i]; y[i] = siluf_(v); }
        *(v4u*)(((bf16*)(c.ws + WS_BO)) + (size_t)(r0 + t0 + t) * LBO + 512 + c0) = pack8(y);
    }
    __syncthreads();
}

__device__ __forceinline__ void qk_conv8(const bf16* p1, const float* wmc, int row, int seq_lo, int seq_hi, int col, float scale, float (&o)[8]) {
    float xm[8], x0[8], xp[8];
    const bool hm = row - 1 >= seq_lo, hp = row + 1 < seq_hi;
    const v4u r0_ = *(const v4u*)(p1 + (size_t)row * LP + C_QKM + col), rm_ = *(const v4u*)(p1 + (size_t)(hm ? row - 1 : row) * LP + C_QKM + col), rp_ = *(const v4u*)(p1 + (size_t)(hp ? row + 1 : row) * LP + C_QKM + col);
    unpack8(r0_, x0); unpack8(rm_, xm); unpack8(rp_, xp);
#pragma unroll
    for (int i = 0; i < 8; ++i) { xm[i] = hm ? xm[i] : 0.f; xp[i] = hp ? xp[i] : 0.f; }
    const f32x4 wa0 = *(const f32x4*)(wmc + col), wa1 = *(const f32x4*)(wmc + col + 4), wb0 = *(const f32x4*)(wmc + 1024 + col), wb1 = *(const f32x4*)(wmc + 1024 + col + 4), wc0 = *(const f32x4*)(wmc + 2048 + col), wc1 = *(const f32x4*)(wmc + 2048 + col + 4);
    const float wa[8] = {wa0.x, wa0.y, wa0.z, wa0.w, wa1.x, wa1.y, wa1.z, wa1.w}, wb[8] = {wb0.x, wb0.y, wb0.z, wb0.w, wb1.x, wb1.y, wb1.z, wb1.w}, wc[8] = {wc0.x, wc0.y, wc0.z, wc0.w, wc1.x, wc1.y, wc1.z, wc1.w};
#pragma unroll
    for (int i = 0; i < 8; ++i) { const float v = wa[i] * xm[i] + wb[i] * x0[i] + wc[i] * xp[i]; o[i] = siluf_(v) * scale; }
}
__device__ __forceinline__ void chunk_rows(int b, int jc, int& r0, int& seq_lo, int& seq_hi) {
    if (jc < 4) { seq_lo = ML + b * CTXL; seq_hi = seq_lo + CTXL; r0 = seq_lo + jc * 64; } else { seq_lo = b * SEQ; seq_hi = seq_lo + SEQ; r0 = seq_lo + (jc - 4) * 64; }
}
__device__ __forceinline__ void m1_unit(Ctx& c, int l, int b, int h, int jc) {
    TLW;
    const __attribute__((address_space(4))) Params& p = *c.p;
    LAS bf16* Vt = (LAS bf16*)c.lds;
    LAS bf16* Kt = (LAS bf16*)(c.lds + 18432);
    LAS float* wts = (LAS float*)(c.lds + 36864);
    const int tid = tid_, lane = lane_, w = wave_, lr = lane & 15, lg = lane >> 4;
    const bf16* p1 = ((bf16*)(c.ws + WS_P1));
    int r0, seq_lo, seq_hi; chunk_rows(b, jc, r0, seq_lo, seq_hi);
    const int chf = (b * 4 + h) * 2, chb = chf + 1, pf = jc, pb = jc < 4 ? 3 - jc : 71 - jc;
    if (w == 0) {
        const bf16* gp = p1 + (size_t)(r0 + lane) * LP + C_GM + h; const float* bm = ((const float*)(const __attribute__((address_space(1))) float*)p.in[I_BMG]) + l * 16 + h;
        const float i_f = bf2f(gp[0]) + bm[0], i_b = bf2f(gp[4]) + bm[4], lf_f = logsigf_(bf2f(gp[8]) + bm[8]), lf_b = logsigf_(bf2f(gp[12]) + bm[12]);
        const float cf = scan_add(lf_f, lane), cb = scan_add(lf_b, lane);
        const float bend_f = shi(cf, 63), bend_b = shi(cb, 63);
        const float g_f = bend_f - cf + i_f, g_b = (cb - lf_b) + i_b;
        const float mu_f = wave_max(g_f), mu_b = wave_max(g_b);
        wts[lane] = __expf(g_f - mu_f); wts[64 + lane] = __expf(g_b - mu_b);
        if (lane == 0) { float* be = ((float*)(c.ws + WS_BEND)); float* mu = ((float*)(c.ws + WS_MU)); be[chf * NCHUNK + pf] = bend_f; mu[chf * NCHUNK + pf] = mu_f; be[chb * NCHUNK + pb] = bend_b; mu[chb * NCHUNK + pb] = mu_b; }
    } else {
        const float* wmc = ((const float*)(const __attribute__((address_space(1))) float*)p.in[I_WMCONV]) + (size_t)l * 3 * 1024;
#pragma unroll
        for (int k_ = 0; k_ < 3; ++k_) { const int it0 = tid - 64 + k_ * 448; const bool ok = it0 < 1024; const int it = ok ? it0 : 1023;
            const int W = it >> 6, ln = it & 63, cg8 = ((ln >> 4) + 4 * (W & 3)) * 8, s = (ln & 15) + 16 * (W >> 2);
            const v4u vv = *(const v4u*)(p1 + (size_t)(r0 + s) * LP + C_VM + h * 128 + cg8);
            float k[8]; qk_conv8(p1, wmc, r0 + s, seq_lo, seq_hi, 512 + h * 128 + cg8, 0.08838834764831845f, k);
            if (!ok) continue;
            LAS bf16* d = Vt + cg8 * 72 + s;
            d[0] = (bf16)(vv.x & 0xffffu); d[72] = (bf16)(vv.x >> 16); d[144] = (bf16)(vv.y & 0xffffu); d[216] = (bf16)(vv.y >> 16);
            d[288] = (bf16)(vv.z & 0xffffu); d[360] = (bf16)(vv.z >> 16); d[432] = (bf16)(vv.w & 0xffffu); d[504] = (bf16)(vv.w >> 16);
            const v4u kk = pack8(k); LAS bf16* e = Kt + cg8 * 72 + s;
            e[0] = (bf16)(kk.x & 0xffffu); e[72] = (bf16)(kk.x >> 16); e[144] = (bf16)(kk.y & 0xffffu); e[216] = (bf16)(kk.y >> 16);
            e[288] = (bf16)(kk.z & 0xffffu); e[360] = (bf16)(kk.z >> 16); e[432] = (bf16)(kk.w & 0xffffu); e[504] = (bf16)(kk.w >> 16);
        }
    }
    __syncthreads();
    bf16x8 vaf[2], vab[2];
#pragma unroll
    for (int ks = 0; ks < 2; ++ks) {
        float vf[8]; unpack8(*(const LAS v4u*)(Vt + (16 * w + lr) * 72 + ks * 32 + lg * 8), vf);
        const f32x4 f0 = *(const LAS f32x4*)(wts + ks * 32 + lg * 8), f1 = *(const LAS f32x4*)(wts + ks * 32 + lg * 8 + 4), b0 = *(const LAS f32x4*)(wts + 64 + ks * 32 + lg * 8), b1 = *(const LAS f32x4*)(wts + 64 + ks * 32 + lg * 8 + 4);
        const float xf[8] = {vf[0] * f0.x, vf[1] * f0.y, vf[2] * f0.z, vf[3] * f0.w, vf[4] * f1.x, vf[5] * f1.y, vf[6] * f1.z, vf[7] * f1.w};
        const float xb[8] = {vf[0] * b0.x, vf[1] * b0.y, vf[2] * b0.z, vf[3] * b0.w, vf[4] * b1.x, vf[5] * b1.y, vf[6] * b1.z, vf[7] * b1.w};
        vaf[ks] = __builtin_bit_cast(bf16x8, pack8(xf)); vab[ks] = __builtin_bit_cast(bf16x8, pack8(xb));
    }
    bf16* stf = ((bf16*)(c.ws + WS_ST)) + ((size_t)chf * NCHUNK + pf) * 16384; bf16* stb = ((bf16*)(c.ws + WS_ST)) + ((size_t)chb * NCHUNK + pb) * 16384;
#pragma unroll
    for (int m = 0; m < 4; ++m) {
        f32x4 af[2], ab[2];
#pragma unroll
        for (int hh = 0; hh < 2; ++hh) { af[hh] = zero4(); ab[hh] = zero4();
            const int dkrow = 32 * m + 8 * (lr >> 2) + 4 * hh + (lr & 3);
#pragma unroll
            for (int ks = 0; ks < 2; ++ks) { const bf16x8 kb = *(const LAS bf16x8*)(Kt + dkrow * 72 + ks * 32 + lg * 8); af[hh] = MFMA16(kb, vaf[ks], af[hh]); ab[hh] = MFMA16(kb, vab[ks], ab[hh]); } }
        const float rf[8] = {af[0][0], af[0][1], af[0][2], af[0][3], af[1][0], af[1][1], af[1][2], af[1][3]}, rbk[8] = {ab[0][0], ab[0][1], ab[0][2], ab[0][3], ab[1][0], ab[1][1], ab[1][2], ab[1][3]};
        *(v4u*)(stf + (16 * w + lr) * 128 + 32 * m + 8 * lg) = pack8(rf); *(v4u*)(stb + (16 * w + lr) * 128 + 32 * m + 8 * lg) = pack8(rbk);
    }
    if (tid < 256) { const int dir = tid >> 7, dk = tid & 127; const LAS bf16* Kd = Kt + dk * 72; const LAS float* wd = wts + dir * 64; float sm = 0.f;
#pragma unroll 8
        for (int i = 0; i < 64; ++i) sm += bf2f(Kd[i]) * wd[i];
        ((float*)(c.ws + WS_NS))[((size_t)(dir ? chb : chf) * NCHUNK + (dir ? pb : pf)) * 128 + dk] = sm; }
    __syncthreads();
}
__device__ __forceinline__ void phase_m2(Ctx& c) {
    TLW;
    for (int gid = c.bid * 512 + tid_; gid < 32 * 4096; gid += c.nblk * 512) {
        const int ch = gid >> 12, e4 = gid & 4095;
        v2u* sp = (v2u*)(((bf16*)(c.ws + WS_ST)) + (size_t)ch * NCHUNK * 16384) + e4;
        f32x4* np = (f32x4*)(((float*)(c.ws + WS_NS)) + (size_t)ch * NCHUNK * 128) + (e4 & 31);
        const float* be = ((float*)(c.ws + WS_BEND)) + ch * NCHUNK; const float* mu = ((float*)(c.ws + WS_MU)) + ch * NCHUNK; float* ms = ((float*)(c.ws + WS_MS)) + ch * NCHUNK;
        const bool do_n = e4 < 32;
        float m = -1.0e30f; f32x4 cs = zero4(), nsv = zero4();
#pragma unroll 1
        for (int q0 = 0; q0 < NCHUNK - 1; q0 += 16) {
            v2u uv[16]; float bq[16], mq[16]; f32x4 nv[16];
#pragma unroll
            for (int i = 0; i < 16; ++i) if (q0 + i < NCHUNK - 1) { uv[i] = sp[(size_t)(q0 + i) * 4096]; bq[i] = be[q0 + i]; mq[i] = mu[q0 + i]; if (do_n) nv[i] = np[(q0 + i) * 32]; }
#pragma unroll
            for (int i = 0; i < 16; ++i) if (q0 + i < NCHUNK - 1) {
                const float mn = fmaxf(bq[i] + m, mq[i]), dec = __expf(bq[i] + m - mn), sc = __expf(mq[i] - mn);
                cs.x = dec * cs.x + sc * bf2f(uv[i].x & 0xffffu); cs.y = dec * cs.y + sc * bf2f(uv[i].x >> 16); cs.z = dec * cs.z + sc * bf2f(uv[i].y & 0xffffu); cs.w = dec * cs.w + sc * bf2f(uv[i].y >> 16);
                v2u o; o.x = pk2(cs.x, cs.y); o.y = pk2(cs.z, cs.w); sp[(size_t)(q0 + i) * 4096] = o;
                if (do_n) { nsv = nsv * dec + nv[i] * sc; np[(q0 + i) * 32] = nsv; }
                if (e4 == 0) ms[q0 + i] = mn;
                m = mn;
            }
        }
    }
}
__device__ __forceinline__ void m3_unit(Ctx& c, int l, int b, int h, int jc) {
    TLW;
    const __attribute__((address_space(4))) Params& p = *c.p;
    LAS bf16* Qs = (LAS bf16*)c.lds;
    LAS bf16* Ks = (LAS bf16*)(c.lds + 17408);
    LAS bf16* Vt = (LAS bf16*)(c.lds + 34816);
    LAS bf16* Cs = (LAS bf16*)(c.lds + 53248);
    LAS float* HB = (LAS float*)(c.lds + 53248);
    LAS bf16* Ps = (LAS bf16*)(c.lds + 122880) + wave_ * (16 * 72);
    LAS float* sca = (LAS float*)(c.lds + 141312);
    LAS float* nin = (LAS float*)(c.lds + 143360);
    const int tid = tid_, lane = lane_, w = wave_, lr = lane & 15, lg = lane >> 4;
    int r0, seq_lo, seq_hi; chunk_rows(b, jc, r0, seq_lo, seq_hi);
    const int chf = (b * 4 + h) * 2, chb = chf + 1, pf = jc, pb = jc < 4 ? 3 - jc : 71 - jc;
    if (w < 2) {
        const int dir = w, ch = dir ? chb : chf, pp = dir ? pb : pf;
        const bf16* gp = ((bf16*)(c.ws + WS_P1)) + (size_t)(r0 + lane) * LP + C_GM + h + 4 * dir; const float* bm = ((const float*)(const __attribute__((address_space(1))) float*)p.in[I_BMG]) + l * 16 + h + 4 * dir;
        const float ig = bf2f(gp[0]) + bm[0], lf = logsigf_(bf2f(gp[8]) + bm[8]);
        const float m_in = pp > 0 ? ((float*)(c.ws + WS_MS))[ch * NCHUNK + pp - 1] : -1.0e30f;
        const int sl = dir ? 63 - lane : lane;
        const float lfp = shi(lf, sl), igp = shi(ig, sl);
        const float bcum = scan_add(lfp, lane);
        const float beta = igp - bcum;
        const float pmx = scan_max(beta, lane);
        const float a_t = bcum + m_in, mt = fmaxf(a_t, bcum + pmx);
        const float alpha = bcum - mt, wint = __expf(a_t - mt), emt = __expf(-mt);
        LAS float* s = sca + dir * 256;
        s[sl] = alpha; s[64 + sl] = beta; s[128 + sl] = wint; s[192 + sl] = emt;
    }
    if (w >= 2) {
        const float* wmc = ((const float*)(const __attribute__((address_space(1))) float*)p.in[I_WMCONV]) + (size_t)l * 3 * 1024;
        const bf16* p1 = ((bf16*)(c.ws + WS_P1));
#pragma unroll
        for (int k_ = 0; k_ < 6; ++k_) { const int it0 = tid - 128 + k_ * 384; const bool ok = it0 < 2048; const int it = ok ? it0 : 2047;
            const int isk = it >> 10, s = (it >> 4) & 63, cg8 = (it & 15) * 8;
            float o[8]; qk_conv8(p1, wmc, r0 + s, seq_lo, seq_hi, isk * 512 + h * 128 + cg8, isk ? 0.08838834764831845f : 1.0f, o);
            if (ok) *(LAS v4u*)((isk ? Ks : Qs) + s * 136 + cg8) = pack8(o);
        }
#pragma unroll
        for (int k_ = 0; k_ < 3; ++k_) { const int it0 = tid - 128 + k_ * 384; const bool ok = it0 < 1024; const int it = ok ? it0 : 1023;
            const int W = it >> 6, ln = it & 63, cg8 = ((ln >> 4) + 4 * (W & 3)) * 8, s = (ln & 15) + 16 * (W >> 2);
            const v4u vv = *(const v4u*)(p1 + (size_t)(r0 + s) * LP + C_VM + h * 128 + cg8);
            if (!ok) continue;
            LAS bf16* d = Vt + cg8 * 72 + s;
            d[0] = (bf16)(vv.x & 0xffffu); d[72] = (bf16)(vv.x >> 16); d[144] = (bf16)(vv.y & 0xffffu); d[216] = (bf16)(vv.y >> 16);
            d[288] = (bf16)(vv.z & 0xffffu); d[360] = (bf16)(vv.z >> 16); d[432] = (bf16)(vv.w & 0xffffu); d[504] = (bf16)(vv.w >> 16);
        }
#pragma unroll
        for (int dir = 0; dir < 2; ++dir) {
            const int ch = dir ? chb : chf, pp = dir ? pb : pf;
            const v4u* src = (const v4u*)(((bf16*)(c.ws + WS_ST)) + ((size_t)ch * NCHUNK + (pp > 0 ? pp - 1 : 0)) * 16384);
#pragma unroll
            for (int k_ = 0; k_ < 6; ++k_) { const int it0 = tid - 128 + k_ * 384; const bool ok = it0 < 2048; const int it = ok ? it0 : 2047; const int dv = it >> 4, ck = (it & 15) * 8; v4u v = src[it]; if (pp <= 0) v = zero4u();
                if (ok) *(LAS v4u*)(Cs + dir * (128 * 136) + dv * 136 + ck) = v; }
        }
        if (tid - 128 < 256) { const int q = tid - 128, dir = q >> 7, k = q & 127, ch = dir ? chb : chf, pp = dir ? pb : pf; nin[q] = pp > 0 ? ((float*)(c.ws + WS_NS))[((size_t)ch * NCHUNK + pp - 1) * 128 + k] : 0.f; }
    }
    __syncthreads();
    const int dir = w >> 2, rb = w & 3;
    const LAS float* sd = sca + dir * 256;
    const int t = 16 * rb + lr;
    const float al = sd[t], wi = sd[128 + t], em = sd[192 + t];
    bf16x8 qa[4];
#pragma unroll
    for (int ks = 0; ks < 4; ++ks) qa[ks] = *(const LAS bf16x8*)(Qs + t * 136 + ks * 32 + lg * 8);
    f32x4 st[4]; float rs = 0.f;
#pragma unroll
    for (int nb = 0; nb < 4; ++nb) { f32x4 a = zero4();
#pragma unroll
        for (int ks = 0; ks < 4; ++ks) { const bf16x8 kb = *(const LAS bf16x8*)(Ks + (nb * 16 + lr) * 136 + ks * 32 + lg * 8); a = MFMA16(kb, qa[ks], a); }
        const f32x4 be = *(const LAS f32x4*)(sd + 64 + nb * 16 + lg * 4);
#pragma unroll
        for (int j = 0; j < 4; ++j) { const int s_ = nb * 16 + lg * 4 + j; const bool valid = dir ? (s_ >= t) : (s_ <= t);
            const float pv = valid ? a[j] * __expf(al + be[j]) : 0.f; rs += pv; a[j] = pv; }
        st[nb] = a; }
    bf16x8 pfr[2];
#pragma unroll
    for (int ks = 0; ks < 2; ++ks) pfr[ks] = __builtin_bit_cast(bf16x8, (v4u){pk2(st[2 * ks][0], st[2 * ks][1]), pk2(st[2 * ks][2], st[2 * ks][3]), pk2(st[2 * ks + 1][0], st[2 * ks + 1][1]), pk2(st[2 * ks + 1][2], st[2 * ks + 1][3])});
    f32x4 oacc[8];
#pragma unroll
    for (int db = 0; db < 8; ++db) { f32x4 a = zero4();
#pragma unroll
        for (int ks = 0; ks < 4; ++ks) { const bf16x8 cb = *(const LAS bf16x8*)(Cs + dir * (128 * 136) + (db * 16 + lr) * 136 + ks * 32 + lg * 8); a = MFMA16(cb, qa[ks], a); }
        a = a * wi;
#pragma unroll
        for (int ks = 0; ks < 2; ++ks) { const v2u a0 = *(const LAS v2u*)(Vt + (db * 16 + lr) * 72 + ks * 32 + lg * 4), a1 = *(const LAS v2u*)(Vt + (db * 16 + lr) * 72 + ks * 32 + 16 + lg * 4);
            a = MFMA16(__builtin_bit_cast(bf16x8, (v4u){a0.x, a0.y, a1.x, a1.y}), pfr[ks], a); }
        oacc[db] = a; }
    float qn = 0.f;
    { const LAS bf16* qr = Qs + t * 136 + lg * 32; const LAS float* nn = nin + dir * 128 + lg * 32;
#pragma unroll
      for (int k8 = 0; k8 < 4; ++k8) { float qf[8]; unpack8(*(const LAS v4u*)(qr + k8 * 8), qf);
#pragma unroll
          for (int i = 0; i < 8; ++i) qn += qf[i] * nn[k8 * 8 + i]; } }
    { const int ol = olane(); const float q1 = shi(qn, ol ^ 16), r1 = shi(rs, ol ^ 16); qn += q1; rs += r1; const float q2 = shi(qn, ol ^ 32), r2 = shi(rs, ol ^ 32); qn += q2; rs += r2; }
    const float inv = 1.0f / fmaxf(fabsf(wi * qn + rs), em);
    __syncthreads();
#pragma unroll
    for (int db = 0; db < 8; ++db) *(LAS f32x4*)(HB + dir * (64 * 132) + t * 132 + db * 16 + lg * 4) = oacc[db] * inv;
    __syncthreads();
    const float g0 = ((const float*)(const __attribute__((address_space(1))) float*)p.in[I_GMN])[l * 512 + h * 128 + 2 * lane], g1 = ((const float*)(const __attribute__((address_space(1))) float*)p.in[I_GMN])[l * 512 + h * 128 + 2 * lane + 1];
    float v0[8], v1[8], sm[8], sq[8];
#pragma unroll
    for (int tt = 0; tt < 8; ++tt) {
        const int t = 8 * w + tt;
        const unsigned ov = *(const unsigned*)(((bf16*)(c.ws + WS_P1)) + (size_t)(r0 + t) * LP + C_OM + h * 128 + 2 * lane);
        float a0 = HB[t * 132 + 2 * lane] + HB[64 * 132 + t * 132 + 2 * lane], a1 = HB[t * 132 + 2 * lane + 1] + HB[64 * 132 + t * 132 + 2 * lane + 1];
        a0 *= sigmoidf_(bf2f(ov & 0xffffu)); a1 *= sigmoidf_(bf2f(ov >> 16));
        v0[tt] = a0; v1[tt] = a1; sm[tt] = a0 + a1;
    }
    wave_sum8(sm);
#pragma unroll
    for (int tt = 0; tt < 8; ++tt) { const float mean = sm[tt] * (1.0f / 128.0f); v0[tt] -= mean; v1[tt] -= mean; sq[tt] = v0[tt] * v0[tt] + v1[tt] * v1[tt]; }
    wave_sum8(sq);
#pragma unroll
    for (int tt = 0; tt < 8; ++tt) { const float rstd = rsqrtf(sq[tt] * (1.0f / 128.0f) + EPS);
        *(unsigned*)(((bf16*)(c.ws + WS_BO)) + (size_t)(r0 + 8 * w + tt) * LBO + 1024 + h * 128 + 2 * lane) = pk2(v0[tt] * rstd * g0, v1[tt] * rstd * g1); }
    __syncthreads();
}


#ifdef DBGSCAN
__device__ __forceinline__ void scan16(Ctx& c, const bf16* p, size_t rows, int cols, int ld, int code) {
    TLW;
    const int c8 = cols / 8; const size_t n = rows * c8; bool bad = false;
    for (size_t i = (size_t)c.bid * 512 + tid_; i < n; i += (size_t)c.nblk * 512) { const size_t r = i / c8; const int cc = (int)(i % c8) * 8; const v4u v = *(const v4u*)(p + r * ld + cc);
        bad |= ((v.x & 0x7FFFu) > 0x4680u) | (((v.x >> 16) & 0x7FFFu) > 0x4680u) | ((v.y & 0x7FFFu) > 0x4680u) | (((v.y >> 16) & 0x7FFFu) > 0x4680u) | ((v.z & 0x7FFFu) > 0x4680u) | (((v.z >> 16) & 0x7FFFu) > 0x4680u) | ((v.w & 0x7FFFu) > 0x4680u) | (((v.w >> 16) & 0x7FFFu) > 0x4680u); }
    if (bad) atomicMin((int*)(c.ws + WS_DBG), code);
}
__device__ __forceinline__ void scan32(Ctx& c, const float* p, size_t n, int code) {
    TLW;
    bool bad = false;
    for (size_t i = (size_t)c.bid * 512 + tid_; i < n; i += (size_t)c.nblk * 512) { bad |= !(fabsf(p[i]) < 16384.0f); }
    if (bad) atomicMin((int*)(c.ws + WS_DBG), code);
}
__device__ __forceinline__ void dbg_scan(Ctx& c, int ph) {
    TLW;
    if (ph == 0) { if (c.bid == 0 && tid_ == 0) *(int*)(c.ws + WS_DBG) = 0x7fffffff; return; }
    if (ph >= NPHASE - 1) return;
    const int sp = (ph - 1) % 10, code = ph > 11 ? 56 + ph : 20 + ph * 4;
    if (sp == 0) { scan16(c, ((bf16*)(c.ws + WS_BO)), MT, 1024, 1024, code); scan16(c, ((bf16*)(c.ws + WS_WIN)), 7168, 1024, 1024, code + 1); scan16(c, ((bf16*)(c.ws + WS_WP)), 3072, 512, 512, code + 1);
        scan16(c, ((bf16*)(c.ws + WS_WO3)), 1024, 3072, 3072, code + 1); scan16(c, ((bf16*)(c.ws + WS_WGU)), 5632, 1024, 1024, code + 1); scan16(c, ((bf16*)(c.ws + WS_WD)), 1024, 2816, 2816, code + 1);
        scan32(c, (const float*)(c.ws + WS_MOD), 4 * 5 * 6144, code + 2); scan32(c, c.xl, (size_t)ML * DM, code + 3); scan32(c, (const float*)(c.ws + WS_XC), (size_t)MC * DM, code + 3); }
    else if (sp == 1) { scan16(c, ((bf16*)(c.ws + WS_P1)), MT, 4096, 4096, code); scan16(c, ((bf16*)(c.ws + WS_G)), MT, 3072, 3072, code + 1); }
    else if (sp == 2) { scan16(c, ((bf16*)(c.ws + WS_BO)), MT, 512, 1536, code); scan16(c, ((bf16*)(c.ws + WS_BO)) + 512, MT, 512, 1536, code + 1); scan16(c, ((bf16*)(c.ws + WS_ST)), 32 * 68 * 128, 128, 128, code + 2);
        scan32(c, (const float*)(c.ws + WS_NS), 32 * 68 * 128, code + 3); scan32(c, (const float*)(c.ws + WS_BEND), 32 * 68, code + 3); scan32(c, (const float*)(c.ws + WS_MU), 32 * 68, code + 3); }
    else if (sp == 3) { for (int ch = 0; ch < 32; ++ch) { scan16(c, ((bf16*)(c.ws + WS_ST)) + (size_t)ch * 68 * 16384, 67 * 128, 128, 128, code); scan32(c, (const float*)(c.ws + WS_NS) + ch * 68 * 128, 67 * 128, code + 1); scan32(c, (const float*)(c.ws + WS_MS) + ch * 68, 67, code + 2); } }
    else if (sp == 4) scan16(c, ((bf16*)(c.ws + WS_BO)) + 1024, MT, 512, 1536, code);
    else if (sp == 5) scan16(c, ((bf16*)(c.ws + WS_G)), MT, 3072, 3072, code);
    else if (sp == 6 || sp == 9) { scan32(c, c.xl, (size_t)ML * DM, code); scan32(c, (const float*)(c.ws + WS_XC), (size_t)MC * DM, code + 1); }
    else if (sp == 7) scan16(c, ((bf16*)(c.ws + WS_BO)), MT, 1024, 1024, code);
    else if (sp == 8) scan16(c, ((bf16*)(c.ws + WS_P1)), MT, 2816, 2816, code);
}
#endif
template <class Epi, class Sched = pg8::StaticOrder>
__device__ __forceinline__ void run_gemm(Ctx& c, const bf16* A, int lda, int mode, const bf16* Bt, int ldb, int M, int N, int K, const Epi& E) {
    pg8::Gemm g{A, Bt, M, N, K, lda, ldb, mode}; Sched S; S.init(M, N, c.nblk, c.bid);
    pg8::gemm_phase<Epi, Sched, true, true>(c.lds, g, S, E);
}

__global__ void __launch_bounds__(512, 2) mk_fwd(Params prm) {
    extern __shared__ __attribute__((aligned(16))) uchar lds_raw[];
    cg::grid_group grid = cg::this_grid();
    Ctx c; c.p = (const __attribute__((address_space(4))) Params*)__builtin_amdgcn_kernarg_segment_ptr(); c.lds = (LAS uchar*)lds_raw; c.bid = blockIdx.x; c.nblk = gridDim.x;
    { LAS unsigned* misc = (LAS unsigned*)(c.lds + MISC_OFF); if (threadIdx.x < 4) misc[threadIdx.x] = 0u; }
    __syncthreads();
    const XcdBarrier xbar = xcd_barrier_post((unsigned*)(prm.ws + WS_BAR), (volatile LAS unsigned*)(c.lds + MISC_OFF));
    for (int ph = prm.ph_lo; ph < prm.ph_hi; ++ph) {
        { const __attribute__((address_space(4))) Params* pp_ = (const __attribute__((address_space(4))) Params*)__builtin_amdgcn_kernarg_segment_ptr(); asm volatile("" : "+s"(pp_)); c.p = pp_; }
        { __attribute__((address_space(1))) uchar* w_ = (__attribute__((address_space(1))) uchar*)prm.ws; asm volatile("" : "+s"(w_)); c.ws = (uchar*)w_;
          __attribute__((address_space(1))) float* x_ = (__attribute__((address_space(1))) float*)prm.out; asm volatile("" : "+s"(x_)); c.xl = (float*)x_; }
        if (ph == 0) {
#ifndef NO_INIT
 phase_init(c);
#endif
 }
        else if (ph == NPHASE - 1) phase_final(c);
        else {
            const int l = (ph - 1) / 10, sp = (ph - 1) % 10; const bool wctx = l < DEPTH - 1; const int Mx = wctx ? MT : ML;
            if (sp == 0) {
#ifndef NO_CONV
 convert_weights(c, l);
#endif
 phase_norm(c, l, 0, MT, l > 0 ? (const float*)(c.ws + WS_G) : nullptr, 11, ((float*)(c.ws + WS_MOD)) + (size_t)(l > 0 ? l - 1 : 0) * 5 * 6144 + 4 * 6144 + 5120, l == 0 ? ((const float*)(const __attribute__((address_space(1))) float*)c.p->in[I_X]) : nullptr); }
            else if (sp == 1) { EpiP1G E{((bf16*)(c.ws + WS_P1)), ((bf16*)(c.ws + WS_G))}; run_gemm(c, ((bf16*)(c.ws + WS_BO)), DM, 0, ((bf16*)(c.ws + WS_WIN)), DM, MT, NINP, DM, E); }
            else if (sp == 2) {
                const int n_att = 256 + (wctx ? 16 : 0), n_m1 = 16 * NCHUNK, n_conv = Mx / 64;
                if (c.nblk == 256 && wctx) {
                    const int w_ = c.bid;
                    attn_unit4(c, l, w_ >> 6, (w_ >> 5) & 1, w_ & 31, false);
                    if (w_ < 16) attn_unit4(c, l, w_ >> 2, (w_ >> 1) & 1, w_ & 1, true);
                    conv_unit(c, l, w_);
                    if (w_ >= 16 && w_ < 32) conv_unit(c, l, 256 + (w_ - 16));
                    if (w_ < 32) { for (int m = w_; m < 64; m += 32) m1_unit(c, l, m / (4 * NCHUNK), (m / NCHUNK) & 3, m % NCHUNK); }
                    else { for (int m = 64 + (w_ - 32); m < n_m1; m += 224) m1_unit(c, l, m / (4 * NCHUNK), (m / NCHUNK) & 3, m % NCHUNK); }
                } else
                for (int u = c.bid; u < n_att + n_m1 + n_conv; u += c.nblk) {
                    if (u < n_att) { if (u < 256) attn_unit4(c, l, u >> 6, (u >> 5) & 1, u & 31, false); else { const int q = u - 256; attn_unit4(c, l, q >> 2, (q >> 1) & 1, q & 1, true); } }
                    else if (u < n_att + n_m1) { const int m = u - n_att; m1_unit(c, l, m / (4 * NCHUNK), (m / NCHUNK) & 3, m % NCHUNK); }
                    else conv_unit(c, l, u - n_att - n_m1);
                }
            }
            else if (sp == 3) {
#ifndef NO_M2
 phase_m2(c);
#endif
 }
            else if (sp == 4) {
                const int jlo = wctx ? 0 : 4, per = NCHUNK - jlo;
                #ifndef NO_M3
 for (int u = c.bid; u < 16 * per; u += c.nblk) m3_unit(c, l, u / (4 * per), (u / per) & 3, jlo + u % per);
#endif

            }
            else if (sp == 5) {
                { EpiMerge E{((const bf16*)(c.ws + WS_G)), ((bf16*)(c.ws + WS_P1))}; run_gemm<EpiMerge, pg8::Merge3Order>(c, ((bf16*)(c.ws + WS_BO)), LBO, 2, ((bf16*)(c.ws + WS_WP)), 512, ML, DM, 512, E); }
                if (wctx) { EpiGateMul E{((bf16*)(c.ws + WS_G)) + (size_t)ML * NG}; run_gemm(c, ((bf16*)(c.ws + WS_BO)) + (size_t)ML * LBO, LBO, 1, ((bf16*)(c.ws + WS_WP)), 512, MC, NG, 512, E); }
            }
            else if (sp == 6) {
                { EpiResid E{c.xl, ((float*)(c.ws + WS_XC)), ((float*)(c.ws + WS_MOD)) + (size_t)l * 5 * 6144 + 2048, l == 0 ? ((const float*)(const __attribute__((address_space(1))) float*)c.p->in[I_X]) : (const float*)c.xl}; run_gemm(c, ((bf16*)(c.ws + WS_P1)), DM, 0, ((bf16*)(c.ws + WS_WO3)), NG, ML, DM, DM, E); }
                if (wctx) { EpiPartial E{(float*)(c.ws + WS_P1 + 40 * MiB)}; run_gemm(c, ((bf16*)(c.ws + WS_G)) + (size_t)ML * NG, NG, 3, ((bf16*)(c.ws + WS_WO3)), NG, MC, DM * 12, 256, E); }
            }
            else if (sp == 7) phase_norm(c, l, 1, Mx, wctx ? (const float*)(c.ws + WS_P1 + 40 * MiB) : nullptr, 12, ((float*)(c.ws + WS_MOD)) + (size_t)l * 5 * 6144 + 4 * 6144 + 2048, nullptr);
            else if (sp == 8) { EpiSwiGLU E{((bf16*)(c.ws + WS_P1))}; run_gemm(c, ((bf16*)(c.ws + WS_BO)), DM, 0, ((bf16*)(c.ws + WS_WGU)), DM, Mx, 2 * DFF, DM, E); }
            else {
                { EpiResid E{c.xl, ((float*)(c.ws + WS_XC)), ((float*)(c.ws + WS_MOD)) + (size_t)l * 5 * 6144 + 5120, (const float*)c.xl}; run_gemm(c, ((bf16*)(c.ws + WS_P1)), DFF, 0, ((bf16*)(c.ws + WS_WD)), DFF, ML, DM, DFF, E); }
                if (wctx) { EpiPartial E{(float*)(c.ws + WS_G)}; run_gemm(c, ((bf16*)(c.ws + WS_P1)) + (size_t)ML * DFF, DFF, 3, ((bf16*)(c.ws + WS_WD)), DFF, MC, DM * 11, 256, E); }
            }
        }
        if (ph + 1 < prm.ph_hi) { asm volatile("s_waitcnt vmcnt(0) lgkmcnt(0)" ::: "memory"); __syncthreads(); if (ph == prm.ph_lo) grid.sync(); else { __attribute__((address_space(1))) unsigned* bp_ = (__attribute__((address_space(1))) unsigned*)(prm.ws + WS_BAR); asm volatile("" : "+s"(bp_)); XcdBarrier xb2; xb2.bar = (unsigned*)bp_; xb2.x = xbar.x; xb2.st = (volatile LAS unsigned*)(c.lds + MISC_OFF); xcd_barrier(xb2); }
#ifdef PROBE_SYNC2
            grid.sync();
#endif
#ifdef DBGSCAN
            dbg_scan(c, ph); asm volatile("s_waitcnt vmcnt(0) lgkmcnt(0)" ::: "memory"); __syncthreads(); grid.sync();
#endif
        }
    }
}

extern "C" void kernel_launch(void* const* d_in, const int* in_sizes, int n_in, void* d_out, int out_size, void* d_ws, size_t ws_size, hipStream_t stream) {
    static int grid = 0;
    if (grid == 0) {
        if (n_in != 25 || ws_size < WS_END) { fprintf(stderr, "kernel_launch: unexpected n_in %d / ws_size %zu (need %zu)\n", n_in, ws_size, (size_t)WS_END); grid = -1; return; }
        int dev = 0, cus = 0, per_cu = 0;
        hipGetDevice(&dev); hipDeviceGetAttribute(&cus, hipDeviceAttributeMultiprocessorCount, dev);
        if (hipFuncSetAttribute((const void*)mk_fwd, hipFuncAttributeMaxDynamicSharedMemorySize, LDS_BYTES) != hipSuccess) { fprintf(stderr, "kernel_launch: hipFuncSetAttribute failed\n"); }
        if (hipOccupancyMaxActiveBlocksPerMultiprocessor(&per_cu, (const void*)mk_fwd, 512, LDS_BYTES) != hipSuccess || per_cu < 1) { fprintf(stderr, "kernel_launch: occupancy query says %d\n", per_cu); per_cu = 1; }
        (void)hipGetLastError();
        grid = cus * 1;
        fprintf(stderr, "kernel_launch: grid %d (cus %d, per_cu %d)\n", grid, cus, per_cu);
    }
    if (grid < 0) return;
    if (hipMemsetAsync((char*)d_ws + WS_BAR, 0, BAR_BYTES, stream) != hipSuccess) fprintf(stderr, "kernel_launch: memset failed\n");
    Params prm{};
    for (int i = 0; i < 25; ++i) prm.in[i] = (const float*)d_in[i];
    prm.out = (float*)d_out; prm.ws = (uchar*)d_ws;
#if defined(MK_MULTI)
    for (int ph = 0; ph < NPHASE; ++ph) { prm.ph_lo = ph; prm.ph_hi = ph + 1; hipLaunchKernelGGL(mk_fwd, dim3(grid), dim3(512), LDS_BYTES, stream, prm); }
#else
    prm.ph_lo = 0; prm.ph_hi = NPHASE;
    void* args[] = {&prm};
    hipError_t e = hipLaunchCooperativeKernel((const void*)mk_fwd, dim3(grid), dim3(512), args, LDS_BYTES, stream);
    if (e != hipSuccess) fprintf(stderr, "kernel_launch: cooperative launch failed: %s (grid %d)\n", hipGetErrorString(e), grid);
#endif
}
```
